# Optimizing an MI355X kernel written in HIP

```python
import math
import jax, jax.numpy as jnp
from jax import lax
import numpy as np

D_MODEL = 1024
BATCH = 16
SEQ = 4096
DEPTH = 1

CHUNK = 64
LEFT_CHUNKS = 8
A_HEADS = 8
A_HEAD_DIM = 64
A_WIDTH = A_HEADS * A_HEAD_DIM
REL_CLIP = 128
B_HEADS = 4
B_HEAD_DIM = 128
B_WIDTH = B_HEADS * B_HEAD_DIM
CONV_K = 4
PEER_HEADS = 8
N_KEYS = 128
N_EXPERTS = N_KEYS * N_KEYS
PEER_TOPK = 16
D_KEY = 256
PEER_BLOCK = 128
EPS = 1e-6
IN_SIZES = [A_WIDTH, A_WIDTH, A_WIDTH, 2 * B_WIDTH, B_WIDTH, B_WIDTH, B_HEADS, B_HEADS, D_MODEL, D_MODEL]
IN_COLS = sum(IN_SIZES)

kernel_name = "hybrid_chunk_attn_mlstm_peer_block"


def rmsnorm(x, g):
    xf = x.astype(jnp.float32)
    y = xf * lax.rsqrt(jnp.mean(xf * xf, axis=-1, keepdims=True) + EPS)
    return (y * g.astype(jnp.float32)).astype(x.dtype)


def modulate(h, shift, scale):
    return h * (1.0 + scale[:, None, :]) + shift[:, None, :]


def causal_depthwise_conv(u, w, b):
    C = u.shape[-1]
    out = lax.conv_general_dilated(
        u, w[:, None, :].astype(u.dtype), window_strides=(1,), padding=[(CONV_K - 1, 0)],
        dimension_numbers=("NWC", "WIO", "NWC"), feature_group_count=C)
    return out + b


def chunk_band_attention(q, k, v, rel_bias):
    B, S, H, dh = q.shape
    nc = S // CHUNK
    pad = LEFT_CHUNKS * CHUNK
    band = pad + CHUNK
    kp = jnp.pad(k, ((0, 0), (pad, 0), (0, 0), (0, 0)))
    vp = jnp.pad(v, ((0, 0), (pad, 0), (0, 0), (0, 0)))
    qc = q.reshape(B, nc, CHUNK, H, dh).transpose(1, 0, 2, 3, 4)
    k_idx = jnp.arange(band)
    rel = jnp.clip(jnp.arange(CHUNK)[:, None] + pad - k_idx[None, :], -REL_CLIP, REL_CLIP) + REL_CLIP
    bias = rel_bias[:, rel].astype(jnp.float32)
    scale = dh ** -0.5

    def one_chunk(args):
        j, qj = args
        kj = lax.dynamic_slice_in_dim(kp, j * CHUNK, band, axis=1)
        vj = lax.dynamic_slice_in_dim(vp, j * CHUNK, band, axis=1)
        s = jnp.einsum("blhd,bkhd->bhlk", qj, kj).astype(jnp.float32) * scale + bias
        valid = (j * CHUNK + k_idx - pad) >= 0
        s = jnp.where(valid[None, None, None, :], s, -jnp.inf)
        p = jax.nn.softmax(s, axis=-1).astype(vj.dtype)
        return jnp.einsum("bhlk,bkhd->blhd", p, vj)

    out = lax.map(one_chunk, (jnp.arange(nc), qc))
    return out.transpose(1, 0, 2, 3, 4).reshape(B, S, H * dh)


def mlstm_chunkwise(q, k, v, i_pre, f_pre):
    B, S, H, d = q.shape
    nc = S // CHUNK
    k = k * (d ** -0.5)
    to_c = lambda t: t.reshape(B, nc, CHUNK, H, d).transpose(1, 0, 3, 2, 4)
    qc, kc, vc = to_c(q), to_c(k), to_c(v)
    li = i_pre.astype(jnp.float32).reshape(B, nc, CHUNK, H).transpose(1, 0, 3, 2)
    lf = jax.nn.log_sigmoid(f_pre.astype(jnp.float32)).reshape(B, nc, CHUNK, H).transpose(1, 0, 3, 2)
    a = jnp.cumsum(lf, axis=-1)
    A = a[..., -1]
    causal = jnp.tril(jnp.ones((CHUNK, CHUNK), dtype=bool))

    def step(carry, inp):
        C, n, m = carry
        qj, kj, vj, aj, Aj, lij = inp
        D = aj[..., :, None] - aj[..., None, :] + lij[..., None, :]
        D = jnp.where(causal, D, -jnp.inf)
        inter = aj + m[..., None]
        m_row = jnp.maximum(inter, jnp.max(D, axis=-1))
        w_inter = jnp.exp(inter - m_row)
        Wd = jnp.exp(D - m_row[..., None])
        qk = jnp.einsum("bhld,bhsd->bhls", qj, kj).astype(jnp.float32) * Wd
        num = w_inter[..., None] * jnp.einsum("bhld,bhde->bhle", qj, C) + jnp.einsum("bhls,bhse->bhle", qk, vj)
        den = w_inter * jnp.einsum("bhld,bhd->bhl", qj, n) + jnp.sum(qk, axis=-1)
        h = num / jnp.maximum(jnp.abs(den), jnp.exp(-m_row))[..., None]
        g = Aj[..., None] - aj + lij
        m_new = jnp.maximum(Aj + m, jnp.max(g, axis=-1))
        decay = jnp.exp(Aj + m - m_new)
        wk = jnp.exp(g - m_new[..., None])
        C_new = decay[..., None, None] * C + jnp.einsum("bhl,bhld,bhle->bhde", wk, kj, vj)
        n_new = decay[..., None] * n + jnp.einsum("bhl,bhld->bhd", wk, kj)
        return (C_new, n_new, m_new), h

    init = (jnp.zeros((B, H, d, d), jnp.float32), jnp.zeros((B, H, d), jnp.float32), jnp.zeros((B, H), jnp.float32))
    _, hs = lax.scan(step, init, (qc, kc, vc, a, A, li))
    return hs.transpose(1, 0, 3, 2, 4).reshape(B, S, H, d).astype(v.dtype)


def peer_ffn(h, w_pq, sub_keys, u_exp, v_exp):
    B, S, D = h.shape
    T = B * S
    hb = h.reshape(T // PEER_BLOCK, PEER_BLOCK, D)

    def block(xb):
        q = (xb @ w_pq).reshape(PEER_BLOCK, PEER_HEADS, 2, D_KEY // 2)
        s = jnp.einsum("thpd,hpnd->thpn", q, sub_keys).astype(jnp.float32)
        s_top, i_top = lax.top_k(s, PEER_TOPK)
        cand = (s_top[:, :, 0, :, None] + s_top[:, :, 1, None, :]).reshape(PEER_BLOCK, PEER_HEADS, PEER_TOPK * PEER_TOPK)
        best, ci = lax.top_k(cand, PEER_TOPK)
        i1 = jnp.take_along_axis(i_top[:, :, 0, :], ci // PEER_TOPK, axis=-1)
        i2 = jnp.take_along_axis(i_top[:, :, 1, :], ci % PEER_TOPK, axis=-1)
        e = i1 * N_KEYS + i2
        gate = jax.nn.softmax(best, axis=-1)
        u = u_exp[e]
        v = v_exp[e]
        act = jax.nn.gelu(jnp.einsum("thkd,td->thk", u, xb))
        return jnp.einsum("thk,thkd->td", (gate * act).astype(xb.dtype), v)

    return lax.map(block, hb).reshape(B, S, D)


def setup_inputs(seed: int = 0) -> dict:
    key = jax.random.key(seed)
    ks = jax.random.split(key, 24)
    nrm = lambda k, shape, s: jax.random.normal(k, shape, jnp.float32) * s
    L = DEPTH
    return {
        "x": nrm(ks[0], (BATCH, SEQ, D_MODEL), 1.0),
        "c": nrm(ks[1], (BATCH, D_MODEL), 1.0),
        "w_ada": nrm(ks[2], (L, D_MODEL, 6 * D_MODEL), 0.5 * D_MODEL ** -0.5),
        "b_ada": nrm(ks[3], (L, 6 * D_MODEL), 0.02),
        "norm1_g": 1.0 + nrm(ks[4], (L, D_MODEL), 0.02),
        "w_in": nrm(ks[5], (L, D_MODEL, IN_COLS), D_MODEL ** -0.5),
        "conv_w": nrm(ks[6], (L, CONV_K, 2 * B_WIDTH), CONV_K ** -0.5),
        "conv_b": nrm(ks[7], (L, 2 * B_WIDTH), 0.02),
        "b_igate": nrm(ks[8], (L, B_HEADS), 0.1),
        "b_fgate": jnp.linspace(3.0, 6.0, B_HEADS)[None, :] + nrm(ks[9], (L, B_HEADS), 0.1),
        "rel_bias": nrm(ks[10], (L, A_HEADS, 2 * REL_CLIP + 1), 0.1),
        "mlstm_norm_g": 1.0 + nrm(ks[11], (L, B_WIDTH), 0.02),
        "w_branch_a": nrm(ks[12], (L, A_WIDTH, D_MODEL), A_WIDTH ** -0.5),
        "w_branch_b": nrm(ks[13], (L, B_WIDTH, D_MODEL), B_WIDTH ** -0.5),
        "w_out": nrm(ks[14], (L, D_MODEL, D_MODEL), D_MODEL ** -0.5),
        "norm2_g": 1.0 + nrm(ks[15], (L, D_MODEL), 0.02),
        "w_peer_q": nrm(ks[16], (L, D_MODEL, PEER_HEADS * D_KEY), D_MODEL ** -0.5),
        "peer_sub_keys": nrm(ks[17], (L, PEER_HEADS, 2, N_KEYS, D_KEY // 2), (D_KEY // 2) ** -0.5),
        "peer_u": nrm(ks[18], (L, N_EXPERTS, D_MODEL), D_MODEL ** -0.5),
        "peer_v": nrm(ks[19], (L, N_EXPERTS, D_MODEL), 0.5),
        "final_g": 1.0 + nrm(ks[20], (D_MODEL,), 0.02),
    }


def reference(x, c, w_ada, b_ada, norm1_g, w_in, conv_w, conv_b, b_igate, b_fgate, rel_bias, mlstm_norm_g,
              w_branch_a, w_branch_b, w_out, norm2_g, w_peer_q, peer_sub_keys, peer_u, peer_v, final_g):
    B, S, _ = x.shape
    split_at = [int(s) for s in np.cumsum(IN_SIZES)[:-1]]
    for l in range(DEPTH):
        mod = jax.nn.silu(c) @ w_ada[l] + b_ada[l]
        sh1, sc1, gt1, sh2, sc2, gt2 = jnp.split(mod, 6, axis=-1)

        h = modulate(rmsnorm(x, norm1_g[l]), sh1, sc1)
        proj = h @ w_in[l]
        qa, ka, va, qkb, vb, ob, ib, fb, ga, gb = jnp.split(proj, split_at, axis=-1)
        qkb = jax.nn.silu(causal_depthwise_conv(qkb, conv_w[l], conv_b[l]))
        qb, kb = jnp.split(qkb, 2, axis=-1)
        heads_a = lambda t: t.reshape(B, S, A_HEADS, A_HEAD_DIM)
        heads_b = lambda t: t.reshape(B, S, B_HEADS, B_HEAD_DIM)
        y_a = chunk_band_attention(heads_a(qa), heads_a(ka), heads_a(va), rel_bias[l])
        hb = mlstm_chunkwise(heads_b(qb), heads_b(kb), heads_b(vb), ib + b_igate[l], fb + b_fgate[l])
        hb = rmsnorm(hb, mlstm_norm_g[l].reshape(B_HEADS, B_HEAD_DIM)).reshape(B, S, B_WIDTH)
        y_b = jax.nn.sigmoid(ob) * hb
        y = jax.nn.sigmoid(ga) * (y_a @ w_branch_a[l]) + jax.nn.sigmoid(gb) * (y_b @ w_branch_b[l])
        x = x + gt1[:, None, :] * (y @ w_out[l])

        h2 = modulate(rmsnorm(x, norm2_g[l]), sh2, sc2)
        x = x + gt2[:, None, :] * peer_ffn(h2, w_peer_q[l], peer_sub_keys[l], peer_u[l], peer_v[l])
    return rmsnorm(x, final_g)
```

```cpp
#include <hip/hip_runtime.h>
#include <cstdio>
#include <cstdint>
#include <cmath>
#define MK_ONE_LAUNCH 1
namespace pg8 {
#define PG8_LAS __attribute__((address_space(3)))
typedef unsigned short bf16_t;
typedef short bf16x8 __attribute__((ext_vector_type(8)));
typedef float f32x4 __attribute__((ext_vector_type(4)));
typedef unsigned u32x4 __attribute__((ext_vector_type(4)));
constexpr int BM = 256, BK = 64, HALF = 128, HTB = HALF * BK * 2  , STAGE_BYTES = 8 * HTB, NXCD = 8, WGM = 8;

__host__ __device__ __forceinline__ int lds_byte(int r, int c) { const int st = (r >> 4) * 2 + (c >> 5), rr = r & 15, cc = c & 31, ob = rr * 64 + cc * 2; return st * 1024 + (ob ^ (((ob >> 9) & 1) << 5)); }
__host__ __device__ __forceinline__ void stage_rc(int b, int& R, int& C) { const int st = b / 1024, sb = b % 1024, swz = sb ^ (((sb >> 9) & 1) << 5); R = (st >> 1) * 16 + swz / 64; C = (st & 1) * 32 + (swz % 64) / 2; }
__host__ __device__ __forceinline__ int perm32(int rho) { const int n = rho >> 4, i = rho & 15; return 8 * (i >> 2) + 4 * n + (i & 3); }

struct Unit { int pm, pn; };
struct Gemm { const bf16_t* A; const bf16_t* Bt; int M, N, K; };

struct StaticOrder {
    int nM, nN, nwg, G, c;
    __host__ __device__ void init(int M, int N, int G_, int c_) { nM = M / BM; nN = N / BM; nwg = nM * nN; G = G_; c = c_; }
    __host__ __device__ bool next(int i, Unit& u) const {
        const long L = (long)i * G + c; if (L >= nwg) return false;
        int wgid = (int)L; { const int q = nwg / NXCD, r = nwg % NXCD, xcd = wgid % NXCD, off = wgid / NXCD; wgid = (xcd < r ? xcd * (q + 1) : r * (q + 1) + (xcd - r) * q) + off; }
        const int nig = WGM * nN, gid = wgid / nig, fm = gid * WGM, gsz = (nM - fm) < WGM ? (nM - fm) : WGM;
        u.pm = fm + ((wgid % nig) % gsz); u.pn = (wgid % nig) / gsz; return true;
    }
    __device__ __forceinline__ void a_ready(const Unit&) const {}
    __device__ __forceinline__ void done(const Unit&) const {}
};
__device__ __forceinline__ unsigned cvt_pk_bf16(float lo, float hi) { unsigned r; asm volatile("v_cvt_pk_bf16_f32 %0, %1, %2" : "=v"(r) : "v"(lo), "v"(hi)); return r; }
template <class Epi, class Sched, bool ALIGN_EPI = false, bool SP2 = false>
__device__ __forceinline__ void gemm_phase(PG8_LAS unsigned char* lds, const Gemm g, const Sched& S, const Epi& E) {
    const int tid = threadIdx.x, wid = __builtin_amdgcn_readfirstlane(tid >> 6), lane = tid & 63, wr = wid >> 2, wc = wid & 3, fr = lane & 15, fq = lane >> 4;
    const int K = g.K, nt = K / BK;
    unsigned voffA[2], voffB[2];
#pragma unroll
    for (int i = 0; i < 2; ++i) { int R, C; stage_rc(tid * 16 + i * 8192, R, C); const int Rb = Epi::PERM ? ((R & ~31) + perm32(R & 31)) : R;
        voffA[i] = (unsigned)(R * K + C) * 2u; voffB[i] = (unsigned)(Rb * K + C) * 2u; }
    const size_t kstep = (size_t)(BK * 2);
    const size_t hstep = (size_t)HALF * K * 2;
    const size_t tstep = 2 * hstep;
    const unsigned ldsw = (unsigned)wid * 1024u;
    const int aoff = lds_byte(wr * 64 + fr, fq * 8), boff = lds_byte(wc * 32 + fr, fq * 8);
#define PG8_SA(b, h) (((b) * 2 + (h)) * HTB)
#define PG8_SB(b, h) ((4 + (b) * 2 + (h)) * HTB)
#define PG8_STAGE(bufoff, gbase, voff) do { _Pragma("unroll") for (int _i = 0; _i < 2; ++_i) \
        __builtin_amdgcn_global_load_lds((const unsigned*)((const char*)(gbase) + (voff)[_i]), (PG8_LAS unsigned*)(lds + (bufoff) + ldsw + _i * 8192), 16, 0, 0); } while (0)
#define PG8_LDA(dst, b, h) do { _Pragma("unroll") for (int m = 0; m < 4; ++m) _Pragma("unroll") for (int k = 0; k < 2; ++k) dst[m][k] = *(const PG8_LAS bf16x8*)(lds + PG8_SA(b, h) + aoff + m * 2048 + k * 1024); } while (0)
#define PG8_LDB(dst, b, h) do { _Pragma("unroll") for (int n = 0; n < 2; ++n) _Pragma("unroll") for (int k = 0; k < 2; ++k) dst[n][k] = *(const PG8_LAS bf16x8*)(lds + PG8_SB(b, h) + boff + n * 2048 + k * 1024); } while (0)
#define PG8_MMA(ai, bj, At, Bt) do { __builtin_amdgcn_s_setprio(1); _Pragma("unroll") for (int m = 0; m < 4; ++m) _Pragma("unroll") for (int n = 0; n < 2; ++n) _Pragma("unroll") for (int k = 0; k < 2; ++k) \
        acc[ai][bj][m][n] = __builtin_amdgcn_mfma_f32_16x16x32_bf16(Bt[n][k], At[m][k], acc[ai][bj][m][n], 0, 0, 0); __builtin_amdgcn_s_setprio(0); } while (0)
#define PG8_WAIT_V(n) asm volatile("s_waitcnt vmcnt(" #n ")" ::: "memory")
#define PG8_WAIT_L(n) asm volatile("s_waitcnt lgkmcnt(" #n ")" ::: "memory")
#define PG8_BAR __builtin_amdgcn_s_barrier()
#define PG8_SCHED __builtin_amdgcn_sched_barrier(0)
    Unit cur, nxt; int ui = 0;
    if (!S.next(0, cur)) return;
    f32x4 acc[2][2][4][2];
#pragma unroll
    for (int a = 0; a < 2; ++a)
#pragma unroll
        for (int b = 0; b < 2; ++b)
#pragma unroll
            for (int m = 0; m < 4; ++m)
#pragma unroll
                for (int n = 0; n < 2; ++n) acc[a][b][m][n] = (f32x4){0.f, 0.f, 0.f, 0.f};
    bf16x8 At[4][2], B0[2][2], B1[2][2];
    const char* cA = (const char*)g.A + (size_t)cur.pm * tstep; const char* cB = (const char*)g.Bt + (size_t)cur.pn * tstep;
    S.a_ready(cur);
    if constexpr (SP2) {
        PG8_STAGE(PG8_SB(0, 0), cB, voffB); PG8_STAGE(PG8_SB(0, 1), cB + hstep, voffB); PG8_STAGE(PG8_SA(0, 0), cA, voffA); PG8_STAGE(PG8_SA(0, 1), cA + hstep, voffA);
        if (wr == 1) PG8_BAR;
        PG8_WAIT_V(2); PG8_BAR;
        PG8_STAGE(PG8_SB(1, 0), cB + kstep, voffB); PG8_STAGE(PG8_SA(1, 0), cA + kstep, voffA); PG8_STAGE(PG8_SB(1, 1), cB + hstep + kstep, voffB);
        PG8_WAIT_V(6); PG8_BAR;
    } else {
        PG8_STAGE(PG8_SB(0, 0), cB, voffB); PG8_STAGE(PG8_SA(0, 0), cA, voffA); PG8_STAGE(PG8_SB(0, 1), cB + hstep, voffB); PG8_STAGE(PG8_SA(0, 1), cA + hstep, voffA);
        if (wr == 1) PG8_BAR;
        PG8_WAIT_V(4); PG8_BAR;
        PG8_STAGE(PG8_SB(1, 0), cB + kstep, voffB); PG8_STAGE(PG8_SA(1, 0), cA + kstep, voffA); PG8_STAGE(PG8_SB(1, 1), cB + hstep + kstep, voffB);
        PG8_WAIT_V(6); PG8_BAR;
    }
    for (;;) {
        const bool has_next = S.next(ui + 1, nxt);
        const char* nA = has_next ? (const char*)g.A + (size_t)nxt.pm * tstep : cA; const char* nB = has_next ? (const char*)g.Bt + (size_t)nxt.pn * tstep : cB;
        for (int t = 0; t < nt; t += 2) {
            const bool last = (t == nt - 2);
            const char* a1 = cA + (size_t)(t + 1) * kstep;
            const char* a2 = last ? nA : cA + (size_t)(t + 2) * kstep; const char* b2 = last ? nB : cB + (size_t)(t + 2) * kstep;
            const char* a3 = a2 + kstep; const char* b3 = b2 + kstep;
            if (last && has_next) S.a_ready(nxt);
            if constexpr (SP2) {
            PG8_LDB(B0, 0, 0); PG8_LDB(B1, 0, 1); PG8_SCHED; PG8_LDA(At, 0, 0); PG8_STAGE(PG8_SA(1, 1), a1 + hstep, voffA);
            PG8_WAIT_V(8); PG8_WAIT_L(0); PG8_BAR; PG8_MMA(0, 0, At, B0); PG8_MMA(0, 1, At, B1); PG8_BAR; PG8_SCHED;
            PG8_LDA(At, 0, 1); PG8_STAGE(PG8_SB(0, 0), b2, voffB); PG8_STAGE(PG8_SB(0, 1), b2 + hstep, voffB); PG8_STAGE(PG8_SA(0, 0), a2, voffA);
            PG8_WAIT_V(8); PG8_WAIT_L(0); PG8_BAR; PG8_MMA(1, 0, At, B0); PG8_MMA(1, 1, At, B1); PG8_BAR; PG8_SCHED;
            PG8_LDB(B0, 1, 0); PG8_LDB(B1, 1, 1); PG8_SCHED; PG8_LDA(At, 1, 0); PG8_STAGE(PG8_SA(0, 1), a2 + hstep, voffA);
            PG8_WAIT_V(8); PG8_WAIT_L(0); PG8_BAR; PG8_MMA(0, 0, At, B0); PG8_MMA(0, 1, At, B1); PG8_BAR; PG8_SCHED;
            PG8_LDA(At, 1, 1); PG8_STAGE(PG8_SB(1, 0), b3, voffB); PG8_STAGE(PG8_SB(1, 1), b3 + hstep, voffB); PG8_STAGE(PG8_SA(1, 0), a3, voffA);
            PG8_WAIT_V(8); PG8_WAIT_L(0); PG8_BAR; PG8_MMA(1, 0, At, B0); PG8_MMA(1, 1, At, B1); PG8_BAR; PG8_SCHED;
            } else {
            PG8_LDB(B0, 0, 0); PG8_SCHED; PG8_LDA(At, 0, 0); PG8_STAGE(PG8_SA(1, 1), a1 + hstep, voffA);
            PG8_WAIT_L(8); PG8_BAR; PG8_WAIT_L(0); PG8_MMA(0, 0, At, B0); PG8_BAR; PG8_SCHED;
            PG8_LDB(B1, 0, 1); PG8_STAGE(PG8_SB(0, 0), b2, voffB);
            PG8_BAR; PG8_WAIT_L(0); PG8_MMA(0, 1, At, B1); PG8_BAR;
            PG8_LDA(At, 0, 1); PG8_STAGE(PG8_SA(0, 0), a2, voffA);
            PG8_BAR; PG8_WAIT_L(0); PG8_MMA(1, 0, At, B0); PG8_BAR; PG8_SCHED;
            PG8_STAGE(PG8_SB(0, 1), b2 + hstep, voffB);
            PG8_WAIT_V(6); PG8_BAR; PG8_MMA(1, 1, At, B1); PG8_BAR;
            PG8_LDB(B0, 1, 0); PG8_SCHED; PG8_LDA(At, 1, 0); PG8_STAGE(PG8_SA(0, 1), a2 + hstep, voffA);
            PG8_WAIT_L(8); PG8_BAR; PG8_WAIT_L(0); PG8_MMA(0, 0, At, B0); PG8_BAR; PG8_SCHED;
            PG8_LDB(B1, 1, 1); PG8_STAGE(PG8_SB(1, 0), b3, voffB);
            PG8_BAR; PG8_WAIT_L(0); PG8_MMA(0, 1, At, B1); PG8_BAR;
            PG8_LDA(At, 1, 1); PG8_STAGE(PG8_SA(1, 0), a3, voffA);
            PG8_BAR; PG8_WAIT_L(0); PG8_MMA(1, 0, At, B0); PG8_BAR; PG8_SCHED;
            PG8_STAGE(PG8_SB(1, 1), b3 + hstep, voffB);
            PG8_WAIT_V(6); PG8_BAR; PG8_MMA(1, 1, At, B1); PG8_BAR;
            }
        }
        if constexpr (ALIGN_EPI) { if (wr == 0) PG8_BAR; }
        if constexpr (!Epi::AFTER_DRAIN) { E(acc, cur, wr, wc, fr, fq); S.done(cur); }
        if (!has_next) break;
#pragma unroll
        for (int a = 0; a < 2; ++a)
#pragma unroll
            for (int b = 0; b < 2; ++b)
#pragma unroll
                for (int m = 0; m < 4; ++m)
#pragma unroll
                    for (int n = 0; n < 2; ++n) acc[a][b][m][n] = (f32x4){0.f, 0.f, 0.f, 0.f};
        cur = nxt; cA = nA; cB = nB; ++ui;
        if constexpr (ALIGN_EPI) { if (wr == 1) PG8_BAR; }
    }
    PG8_WAIT_V(0);
    if constexpr (!ALIGN_EPI) { if (wr == 0) PG8_BAR; }
    PG8_BAR;
    if constexpr (Epi::AFTER_DRAIN) { E.fused(acc, cur, wr, wc, fr, fq, lds, wid, lane); S.done(cur); }
#undef PG8_SA
#undef PG8_SB
#undef PG8_STAGE
#undef PG8_LDA
#undef PG8_LDB
#undef PG8_MMA
#undef PG8_WAIT_V
#undef PG8_WAIT_L
#undef PG8_BAR
#undef PG8_SCHED
}
}
#define GAS __attribute__((address_space(1)))
#define LAS __attribute__((address_space(3)))
typedef unsigned short bf16;
typedef unsigned v4u __attribute__((ext_vector_type(4)));
typedef float f32x4 __attribute__((ext_vector_type(4)));
typedef short bf16x8 __attribute__((ext_vector_type(8)));
typedef GAS unsigned gu32;
typedef GAS unsigned long long gu64;
#define RLX_AGENT __ATOMIC_RELAXED, __HIP_MEMORY_SCOPE_AGENT
#define LDS_WAIT() asm volatile("s_waitcnt lgkmcnt(0)" ::: "memory")
#define VM_WAIT() asm volatile("s_waitcnt vmcnt(0)" ::: "memory")
__device__ __forceinline__ unsigned long long rt() { return __builtin_amdgcn_s_memrealtime(); }
__device__ __forceinline__ unsigned f2bf(float f) { unsigned u = __builtin_bit_cast(unsigned, f); return (u + 0x7fffu + ((u >> 16) & 1u)) >> 16; }
__device__ __forceinline__ unsigned pk2(float lo, float hi) { return f2bf(lo) | (f2bf(hi) << 16); }

#define XB_TMO      128
#define XB_XCNT(j)  (256  + 64 * (j))
#define XB_XSUB(j)  (1280 + 64 * (j))
#define XB_XGEN(j)  (2304 + 64 * (j))
#define XB_TOP      3328
#define XB_TOPGEN   3392
#define XCD_BAR_WORDS 3456
#define XB_SPIN_CAP (1u << 18)

__device__ __forceinline__ unsigned xb_ld(unsigned* p)              { return __hip_atomic_load(p, __ATOMIC_RELAXED, __HIP_MEMORY_SCOPE_AGENT); }
__device__ __forceinline__ unsigned xb_add(unsigned* p, unsigned v) { return __hip_atomic_fetch_add(p, v, __ATOMIC_RELAXED, __HIP_MEMORY_SCOPE_AGENT); }
__device__ __forceinline__ unsigned xb_xcc_id() { return (unsigned)__builtin_amdgcn_s_getreg((3 << 11) | 20) & 0xFu; }
#define XB_SPIN(cond, bar) do { unsigned _sp = 0; while (cond) { __builtin_amdgcn_s_sleep(1); \
    if ((++_sp & 255u) == 0u) { if (xb_ld(&(bar)[XB_TMO])) break; if (_sp > XB_SPIN_CAP) { atomicAdd(&(bar)[XB_TMO], 1u); break; } } } } while (0)

struct XcdBarrier {
    unsigned* bar; unsigned x;
    volatile LAS unsigned* st;
};

__device__ __forceinline__ XcdBarrier xcd_barrier_post(unsigned* bar, volatile LAS unsigned* st) {
    XcdBarrier b; b.bar = bar; b.x = xb_xcc_id(); b.st = st;
    if (threadIdx.x == 0) (void)xb_add(&bar[XB_XCNT(b.x)], 1u);
    return b;
}
__device__ __forceinline__ void xcd_barrier_complete(unsigned* bar, unsigned x, unsigned& nloc, unsigned& nx) {
    const unsigned G = gridDim.x * gridDim.y * gridDim.z;
    unsigned sum, cnt, mine, sp = 0u;
    for (;;) {
        sum = 0u; cnt = 0u; mine = 0u;
#pragma unroll
        for (unsigned j = 0; j < 16; ++j) { const unsigned c = xb_ld(&bar[XB_XCNT(j)]); sum += c; cnt += (c > 0u) ? 1u : 0u; mine = (j == x) ? c : mine; }
        if (sum == G) break;
        __builtin_amdgcn_s_sleep(1);
        if ((++sp & 255u) == 0u) { if (xb_ld(&bar[XB_TMO])) break; if (sp > XB_SPIN_CAP) { atomicAdd(&bar[XB_TMO], 1u); break; } }
    }
    nloc = mine > 0u ? mine : 1u; nx = cnt > 0u ? cnt : 1u;
}

__device__ __forceinline__ void xcd_barrier(const XcdBarrier& b) {
    asm volatile("s_waitcnt vmcnt(0)" ::: "memory");
    __syncthreads();
    if (threadIdx.x == 0) {
        unsigned* bar = b.bar;
        __builtin_amdgcn_s_waitcnt(0);
        unsigned nloc = b.st[0], nx = b.st[1];
        if (nloc == 0u) { xcd_barrier_complete(bar, b.x, nloc, nx); b.st[0] = nloc; b.st[1] = nx; }
        const unsigned old = xb_add(&bar[XB_XSUB(b.x)], 1u);
        const unsigned gen = old / nloc;
        if (old + 1u == (gen + 1u) * nloc) {
            __builtin_amdgcn_fence(__ATOMIC_RELEASE, "agent");
            asm volatile("s_waitcnt vmcnt(0)" ::: "memory");
            const unsigned og = xb_add(&bar[XB_TOP], 1u);
            const unsigned tg = og / nx;
            if (og + 1u == (tg + 1u) * nx) xb_add(&bar[XB_TOPGEN], 1u);
            else XB_SPIN(xb_ld(&bar[XB_TOPGEN]) == tg, bar);
            __builtin_amdgcn_fence(__ATOMIC_ACQUIRE, "agent");
            xb_add(&bar[XB_XGEN(b.x)], 1u);
            asm volatile("s_waitcnt vmcnt(0)" ::: "memory");
        } else {
            XB_SPIN(xb_ld(&bar[XB_XGEN(b.x)]) == gen, bar);
            __builtin_amdgcn_fence(__ATOMIC_ACQUIRE, "agent");
            asm volatile("s_waitcnt vmcnt(0)" ::: "memory");
        }
    }
    __syncthreads();
}

constexpr int NB = 16, SEQ = 4096, DM = 1024, T = NB * SEQ;
constexpr int NPROJ = 5632;
constexpr int IN_COLS = 5640;
constexpr float EPS = 1e-6f;
constexpr int NWAVES = 8;

constexpr size_t MiB = 1u << 20;
constexpr size_t WS_CTL = 0, CTL_ZERO_BYTES = 1 * MiB;
constexpr size_t WS_MOD = 1 * MiB;
constexpr size_t WS_W8 = 2 * MiB;
constexpr size_t WS_WIN = 4 * MiB;
constexpr size_t WS_WA = 15 * MiB;
constexpr size_t WS_WB = 16 * MiB;
constexpr size_t WS_WOUT = 17 * MiB;
constexpr size_t WS_WPQ = 19 * MiB;
constexpr size_t WS_SUBK = 23 * MiB;
constexpr size_t WS_U = 24 * MiB;
constexpr size_t WS_V = 56 * MiB;
constexpr size_t WS_GATES = 88 * MiB;
constexpr size_t WS_ROUTE = 90 * MiB;
constexpr size_t WS_H1 = 128 * MiB;
constexpr size_t WS_YA = 128 * MiB, WS_YB = 192 * MiB, WS_H2 = 128 * MiB;
constexpr size_t WS_QKVA = 256 * MiB;
constexpr size_t WS_Y = 256 * MiB;
constexpr size_t WS_QKB = 448 * MiB;
constexpr size_t WS_VB = 576 * MiB;
constexpr size_t WS_OB = 640 * MiB;
constexpr size_t WS_GAB = 704 * MiB;
constexpr size_t WS_PQ = 704 * MiB;
constexpr size_t WS_END = 960 * MiB;
constexpr int CW_BAR = 4096;

constexpr int LDS_BYTES = 151552;
constexpr int MISC_OFF = 147456;

struct Args { const float* in[21]; float* out; unsigned char* ws; int ph_lo, ph_hi, li, pad; };

struct Frame {
    unsigned char* lds;
    int tid, lane, wave, G, gw, NGW;
    const float* in[21]; float* out; unsigned char* ws;
};

__device__ __forceinline__ float bf2f(unsigned short h) { return __builtin_bit_cast(float, (unsigned)h << 16); }
__device__ __forceinline__ float bflo(unsigned w) { return __builtin_bit_cast(float, w << 16); }
__device__ __forceinline__ float bfhi(unsigned w) { return __builtin_bit_cast(float, w & 0xffff0000u); }
typedef __bf16 bf16x2_t __attribute__((ext_vector_type(2)));
__device__ __forceinline__ float dot2c(float acc, unsigned a, unsigned b) { return __builtin_amdgcn_fdot2_f32_bf16(__builtin_bit_cast(bf16x2_t, a), __builtin_bit_cast(bf16x2_t, b), acc, false); }
__device__ __forceinline__ float wave_sum(float v) {
#pragma unroll
    for (int o = 1; o < 64; o <<= 1) v += __shfl_xor(v, o);
    return v;
}
__device__ __forceinline__ float wave_max(float v) {
#pragma unroll
    for (int o = 1; o < 64; o <<= 1) v = fmaxf(v, __shfl_xor(v, o));
    return v;
}
__device__ __forceinline__ float sigmoidf_(float v) { return 1.0f / (1.0f + __expf(-v)); }

enum { EPI_ROUTE = 1, EPI_MERGE_A = 2, EPI_MERGE_B = 3, EPI_OUTPROJ = 4, EPI_PQ = 5 };
template <int MODE> struct Epi {
    static constexpr bool PERM = true, AFTER_DRAIN = false;
    unsigned char* ws; const float* x; float* out;
    __device__ __forceinline__ void operator()(const pg8::f32x4 (&acc)[2][2][4][2], const pg8::Unit& u, int wr, int wc, int fr, int fq) const {
        using pg8::f32x4; using pg8::u32x4; using pg8::cvt_pk_bf16;
        const int row0 = u.pm * 256 + wr * 64 + fr;
        const int colw = wc * 32 + 8 * fq;
        unsigned short* obase = nullptr; int ldc = 0, coff = 0; bool sig = false;
        if (MODE == EPI_ROUTE) {
            const int pn = u.pn;
            if (pn < 6) { obase = (unsigned short*)(ws + WS_QKVA); ldc = 1536; coff = 256 * pn; }
            else if (pn < 10) { obase = (unsigned short*)(ws + WS_QKB); ldc = 1024; coff = 256 * (pn - 6); }
            else if (pn < 12) { obase = (unsigned short*)(ws + WS_VB); ldc = 512; coff = 256 * (pn - 10); }
            else if (pn < 14) { obase = (unsigned short*)(ws + WS_OB); ldc = 512; coff = 256 * (pn - 12); sig = true; }
            else { obase = (unsigned short*)(ws + WS_GAB); ldc = 2048; coff = 256 * (pn - 14); sig = true; }
        } else if (MODE == EPI_MERGE_A || MODE == EPI_MERGE_B) { obase = (unsigned short*)(ws + WS_Y); ldc = 1024; coff = 256 * u.pn; }
        else if (MODE == EPI_PQ) { obase = (unsigned short*)(ws + WS_PQ); ldc = 2048; coff = 256 * u.pn; }
        else { coff = 256 * u.pn; }
#pragma unroll
        for (int ai = 0; ai < 2; ++ai)
#pragma unroll
            for (int m = 0; m < 4; ++m) {
                const int row = row0 + ai * 128 + m * 16;
#pragma unroll
                for (int bj = 0; bj < 2; ++bj) {
                    const int col = coff + bj * 128 + colw;
                    f32x4 v0 = acc[ai][bj][m][0], v1 = acc[ai][bj][m][1];
                    if (MODE == EPI_ROUTE) {
                        if (sig) {
#pragma unroll
                            for (int e = 0; e < 4; ++e) { v0[e] = sigmoidf_(v0[e]); v1[e] = sigmoidf_(v1[e]); }
                        }
                    } else if (MODE == EPI_MERGE_A || MODE == EPI_MERGE_B) {
                        const u32x4 g = *(const u32x4*)((const unsigned short*)(ws + WS_GAB) + (size_t)row * 2048 + (MODE == EPI_MERGE_B ? 1024 : 0) + col);
                        v0[0] *= bflo(g.x); v0[1] *= bfhi(g.x); v0[2] *= bflo(g.y); v0[3] *= bfhi(g.y);
                        v1[0] *= bflo(g.z); v1[1] *= bfhi(g.z); v1[2] *= bflo(g.w); v1[3] *= bfhi(g.w);
                        if (MODE == EPI_MERGE_B) {
                            const u32x4 y = *(const u32x4*)(obase + (size_t)row * ldc + col);
                            v0[0] += bflo(y.x); v0[1] += bfhi(y.x); v0[2] += bflo(y.y); v0[3] += bfhi(y.y);
                            v1[0] += bflo(y.z); v1[1] += bfhi(y.z); v1[2] += bflo(y.w); v1[3] += bfhi(y.w);
                        }
                    }
                    if (MODE == EPI_OUTPROJ) {
                        const int b = row >> 12;
                        const float* gt = (const float*)(ws + WS_MOD) + b * 6144 + 2048 + col;
                        const float* xr = x + (size_t)row * 1024 + col;
                        const f32x4 g0 = *(const f32x4*)gt, g1 = *(const f32x4*)(gt + 4), x0 = *(const f32x4*)xr, x1 = *(const f32x4*)(xr + 4);
                        float* o = out + (size_t)row * 1024 + col;
                        *(f32x4*)o = x0 + g0 * v0; *(f32x4*)(o + 4) = x1 + g1 * v1;
                    } else {
                        u32x4 w; w.x = cvt_pk_bf16(v0[0], v0[1]); w.y = cvt_pk_bf16(v0[2], v0[3]); w.z = cvt_pk_bf16(v1[0], v1[1]); w.w = cvt_pk_bf16(v1[2], v1[3]);
                        *(u32x4*)(obase + (size_t)row * ldc + col) = w;
                    }
                }
            }
    }
};

__device__ __forceinline__ void p0_transpose_item(const float* W, int K, int N, int pitch, unsigned short* WT, int row_off, float* scr, int item, int lane) {
    const int nblk = N / 32, kb = item / nblk, nb = item % nblk, k0 = 64 * kb, n0 = 32 * nb;
#pragma unroll 8
    for (int i = 0; i < 32; ++i) { const int kk = 2 * i + (lane >> 5); scr[kk * 33 + (lane & 31)] = W[(size_t)(k0 + kk) * pitch + n0 + (lane & 31)]; }
    LDS_WAIT(); asm volatile("" ::: "memory");
    const int c = lane & 7;
#pragma unroll
    for (int j = 0; j < 4; ++j) { const int n = (lane >> 3) + 8 * j; const float* s = scr + (8 * c) * 33 + n;
        v4u o; o.x = pk2(s[0 * 33], s[1 * 33]); o.y = pk2(s[2 * 33], s[3 * 33]); o.z = pk2(s[4 * 33], s[5 * 33]); o.w = pk2(s[6 * 33], s[7 * 33]);
        *(v4u*)(WT + (size_t)(row_off + n0 + n) * K + k0 + 8 * c) = o; }
    LDS_WAIT(); asm volatile("" ::: "memory");
}
__device__ __forceinline__ void p0_cvt_item(const float* src, unsigned short* dst, size_t item, int lane) {
    const f32x4* s = (const f32x4*)(src + item * 512) + lane * 2;
    const f32x4 a = s[0], b = s[1];
    v4u o; o.x = pk2(a.x, a.y); o.y = pk2(a.z, a.w); o.z = pk2(b.x, b.y); o.w = pk2(b.z, b.w);
    *((v4u*)(dst + item * 512) + lane) = o;
}
__device__ __forceinline__ void p0_prologue(Frame& F) {
    if (blockIdx.x < 96) {
        float* sc = (float*)F.lds;
        float* red = (float*)(F.lds + 65536);
        const float* c = F.in[1]; const float* w_ada = F.in[2]; const float* b_ada = F.in[3];
        for (int i = F.tid; i < 16 * 1024; i += 512) { const float v = c[i]; sc[i] = v / (1.0f + __expf(-v)); }
        __syncthreads();
        const int n = blockIdx.x * 64 + F.lane;
        float acc[16];
#pragma unroll
        for (int b = 0; b < 16; ++b) acc[b] = 0.f;
        for (int k = F.wave * 128; k < F.wave * 128 + 128; ++k) {
            const float wv = w_ada[(size_t)k * 6144 + n];
#pragma unroll
            for (int b = 0; b < 16; ++b) acc[b] += sc[b * 1024 + k] * wv;
        }
#pragma unroll
        for (int b = 0; b < 16; ++b) red[(F.wave * 16 + b) * 64 + F.lane] = acc[b];
        __syncthreads();
        float* MOD = (float*)(F.ws + WS_MOD);
        for (int idx = F.tid; idx < 16 * 64; idx += 512) { const int b = idx >> 6, l = idx & 63; float s = b_ada[blockIdx.x * 64 + l];
#pragma unroll
            for (int w = 0; w < 8; ++w) s += red[(w * 16 + b) * 64 + l];
            MOD[b * 6144 + blockIdx.x * 64 + l] = s; }
        __syncthreads();
    }
    float* scr = (float*)(F.lds + F.wave * 16384);
    constexpr int I_IN1 = 16 * 112, I_IN2 = 16 * 64, I_A = 8 * 32, I_B = 8 * 32, I_O = 16 * 32, I_PQ = 16 * 64;
    constexpr int NT_ITEMS = I_IN1 + I_IN2 + I_A + I_B + I_O + I_PQ;
    for (int it = F.gw; it < NT_ITEMS; it += F.NGW) {
        int r = it;
        if (r < I_IN1) { p0_transpose_item(F.in[5], 1024, 3584, IN_COLS, (unsigned short*)(F.ws + WS_WIN), 0, scr, r, F.lane); continue; } r -= I_IN1;
        if (r < I_IN2) { p0_transpose_item(F.in[5] + 3592, 1024, 2048, IN_COLS, (unsigned short*)(F.ws + WS_WIN), 3584, scr, r, F.lane); continue; } r -= I_IN2;
        if (r < I_A) { p0_transpose_item(F.in[12], 512, 1024, 1024, (unsigned short*)(F.ws + WS_WA), 0, scr, r, F.lane); continue; } r -= I_A;
        if (r < I_B) { p0_transpose_item(F.in[13], 512, 1024, 1024, (unsigned short*)(F.ws + WS_WB), 0, scr, r, F.lane); continue; } r -= I_B;
        if (r < I_O) { p0_transpose_item(F.in[14], 1024, 1024, 1024, (unsigned short*)(F.ws + WS_WOUT), 0, scr, r, F.lane); continue; } r -= I_O;
        p0_transpose_item(F.in[16], 1024, 2048, 2048, (unsigned short*)(F.ws + WS_WPQ), 0, scr, r, F.lane);
    }
    constexpr size_t C_SUBK = 262144 / 512, C_UV = (size_t)16384 * 1024 / 512;
    for (size_t it = F.gw; it < C_SUBK + 2 * C_UV; it += F.NGW) {
        size_t r = it;
        if (r < C_SUBK) { p0_cvt_item(F.in[17], (unsigned short*)(F.ws + WS_SUBK), r, F.lane); continue; } r -= C_SUBK;
        if (r < C_UV) { p0_cvt_item(F.in[18], (unsigned short*)(F.ws + WS_U), r, F.lane); continue; } r -= C_UV;
        p0_cvt_item(F.in[19], (unsigned short*)(F.ws + WS_V), r, F.lane);
    }
    { float* W8 = (float*)(F.ws + WS_W8); const int g = blockIdx.x * 512 + F.tid; if (g < 8192) { const int j = g >> 10, k = g & 1023; W8[g] = F.in[5][(size_t)k * IN_COLS + 3584 + j]; } }
}

template <bool WITH_GATES>
__device__ __forceinline__ void norm_mod_rows(Frame& F, const float* xin, const float* gvec, int sh_off, int sc_off, unsigned short* hout) {
    const float* MOD = (const float*)(F.ws + WS_MOD);
    const float* W8 = (const float*)(F.ws + WS_W8);
    for (int row = F.gw; row < T; row += F.NGW) {
        const int b = row >> 12;
        const f32x4* xr = (const f32x4*)(xin + (size_t)row * 1024) + F.lane;
        f32x4 v[4]; float s = 0.f;
#pragma unroll
        for (int j = 0; j < 4; ++j) { v[j] = xr[64 * j]; s += (v[j].x * v[j].x + v[j].y * v[j].y) + (v[j].z * v[j].z + v[j].w * v[j].w); }
        const float rstd = rsqrtf(wave_sum(s) * (1.0f / 1024.0f) + EPS);
        float gd[8];
#pragma unroll
        for (int q = 0; q < 8; ++q) gd[q] = 0.f;
        unsigned long long* o8 = (unsigned long long*)(hout + (size_t)row * 1024) + F.lane;
#pragma unroll
        for (int j = 0; j < 4; ++j) {
            const int k4 = F.lane + 64 * j;
            const f32x4 g = ((const f32x4*)gvec)[k4], sc = ((const f32x4*)(MOD + b * 6144 + sc_off))[k4], sh = ((const f32x4*)(MOD + b * 6144 + sh_off))[k4];
            f32x4 h = (v[j] * rstd) * g; h = h * (sc + 1.0f) + sh;
            if (WITH_GATES) {
#pragma unroll
                for (int q = 0; q < 8; ++q) { const f32x4 w = ((const f32x4*)(W8 + q * 1024))[k4]; gd[q] += (h.x * w.x + h.y * w.y) + (h.z * w.z + h.w * w.w); }
            }
            o8[64 * j] = (unsigned long long)pk2(h.x, h.y) | ((unsigned long long)pk2(h.z, h.w) << 32);
        }
        if (WITH_GATES) {
#pragma unroll
            for (int q = 0; q < 8; ++q) gd[q] = wave_sum(gd[q]);
            if (F.lane == 0) { float* G = (float*)(F.ws + WS_GATES) + (size_t)row * 8;
#pragma unroll
                for (int q = 0; q < 8; ++q) G[q] = gd[q] + (q < 4 ? F.in[8][q] : F.in[9][q - 4]); }
        }
    }
}

__device__ __forceinline__ void attn_ref_item(Frame& F, int t, int h) {
    const unsigned short* QKVA = (const unsigned short*)(F.ws + WS_QKVA);
    const float* rel_bias = F.in[10];
    const int lane = F.lane, b = t >> 12, pos = t & 4095, j = pos >> 6;
    const v4u* qrow = (const v4u*)(QKVA + (size_t)t * 1536 + h * 64);
    v4u qv[8];
#pragma unroll
    for (int i = 0; i < 8; ++i) qv[i] = qrow[i];
    float s[9]; float m = -INFINITY;
#pragma unroll
    for (int c = 0; c < 9; ++c) {
        const int kc = j - 8 + c; s[c] = -INFINITY;
        if (kc >= 0) {
            const int kpos = kc * 64 + lane;
            const v4u* krow = (const v4u*)(QKVA + (size_t)(b * 4096 + kpos) * 1536 + 512 + h * 64);
            float d = 0.f;
#pragma unroll
            for (int i = 0; i < 8; ++i) { const v4u kv = krow[i]; d = dot2c(d, qv[i].x, kv.x); d = dot2c(d, qv[i].y, kv.y); d = dot2c(d, qv[i].z, kv.z); d = dot2c(d, qv[i].w, kv.w); }
            int rel = pos - kpos; rel = rel > 128 ? 128 : rel;
            s[c] = d * 0.125f + rel_bias[h * 257 + rel + 128];
            m = fmaxf(m, s[c]);
        }
    }
    m = wave_max(m);
    float l = 0.f;
#pragma unroll
    for (int c = 0; c < 9; ++c) { s[c] = (j - 8 + c >= 0) ? __expf(s[c] - m) : 0.f; l += s[c]; }
    l = wave_sum(l);
    float o = 0.f;
#pragma unroll
    for (int c = 0; c < 9; ++c) {
        const int kc = j - 8 + c;
        if (kc >= 0) {
            const unsigned short* vcol = QKVA + (size_t)(b * 4096 + kc * 64) * 1536 + 1024 + h * 64 + lane;
#pragma unroll 8
            for (int kk = 0; kk < 64; ++kk) { const float pk = __shfl(s[c], kk); o += pk * bf2f(vcol[(size_t)kk * 1536]); }
        }
    }
    ((unsigned short*)(F.ws + WS_YA))[(size_t)t * 512 + h * 64 + lane] = (unsigned short)f2bf(o / l);
}

__device__ __forceinline__ void mlstm_ref_unit(Frame& F, int b, int h) {
    const unsigned short* QKB = (const unsigned short*)(F.ws + WS_QKB);
    const unsigned short* VB = (const unsigned short*)(F.ws + WS_VB);
    const unsigned short* OB = (const unsigned short*)(F.ws + WS_OB);
    const float* GATES = (const float*)(F.ws + WS_GATES);
    const float* conv_w = F.in[6]; const float* conv_b = F.in[7]; const float* ng = F.in[11];
    float* qs = (float*)F.lds; float* ks = qs + 128; float* vs = ks + 128; float* sc = vs + 128;
    float* part = sc + 16;
    float* red = part + 512;
    const int tid = F.tid, e = tid & 127, dq = tid >> 7;
    float C[32];
#pragma unroll
    for (int i = 0; i < 32; ++i) C[i] = 0.f;
    float nst = 0.f;
    float cw[4] = {0.f, 0.f, 0.f, 0.f}; float cb = 0.f; int ccol = 0;
    if (tid < 256) { ccol = (tid < 128 ? 0 : 512) + h * 128 + (tid & 127);
#pragma unroll
        for (int j = 0; j < 4; ++j) cw[j] = conv_w[j * 1024 + ccol]; cb = conv_b[ccol]; }
    const float gsc = ng[h * 128 + e];
    for (int tok = 0; tok < SEQ; ++tok) {
        const size_t t = (size_t)b * SEQ + tok;
        if (tid < 256) {
            float a = cb;
#pragma unroll
            for (int j = 0; j < 4; ++j) { const int tt = tok - 3 + j; if (tt >= 0) a += cw[j] * bf2f(QKB[((size_t)b * SEQ + tt) * 1024 + ccol]); }
            a = a / (1.0f + __expf(-a));
            if (tid < 128) qs[tid] = a; else ks[tid - 128] = a * 0.08838834764831845f;
        } else if (tid < 384) { vs[tid - 256] = bf2f(VB[t * 512 + h * 128 + (tid - 256)]); }
        else if (tid == 384) { sc[0] = sigmoidf_(GATES[t * 8 + 4 + h]); sc[1] = __expf(GATES[t * 8 + h]); }
        __syncthreads();
        const float fg = sc[0], ig = sc[1], ve = vs[e];
        float acc = 0.f;
#pragma unroll
        for (int i = 0; i < 32; ++i) { const int d = dq * 32 + i; C[i] = fg * C[i] + (ig * ks[d]) * ve; acc += qs[d] * C[i]; }
        part[dq * 128 + e] = acc;
        if (tid < 128) { nst = fg * nst + ig * ks[tid]; const float qn = wave_sum(qs[tid] * nst); if (F.lane == 0) red[F.wave] = qn; }
        __syncthreads();
        float hv = 0.f;
        if (tid < 128) { const float num = (part[e] + part[128 + e]) + (part[256 + e] + part[384 + e]); const float den = red[0] + red[1];
            hv = num / fmaxf(fabsf(den), 1.0f); const float ss = wave_sum(hv * hv); if (F.lane == 0) red[2 + F.wave] = ss; }
        __syncthreads();
        if (tid < 128) { const float rstd = rsqrtf((red[2] + red[3]) * (1.0f / 128.0f) + EPS);
            const float y = hv * rstd * gsc * bf2f(OB[t * 512 + h * 128 + e]);
            ((unsigned short*)(F.ws + WS_YB))[t * 512 + h * 128 + e] = (unsigned short)f2bf(y); }
        __syncthreads();
    }
}

__device__ __forceinline__ void argmax_step(float& bv, int& bi) {
#pragma unroll
    for (int o = 1; o < 64; o <<= 1) { const float ov = __shfl_xor(bv, o); const int oi = __shfl_xor(bi, o); if (ov > bv || (ov == bv && oi < bi)) { bv = ov; bi = oi; } }
}
__device__ __forceinline__ void peer_route_ref(Frame& F) {
    const unsigned short* PQ = (const unsigned short*)(F.ws + WS_PQ);
    const unsigned short* SUBK = (const unsigned short*)(F.ws + WS_SUBK);
    unsigned* ROUTE = (unsigned*)(F.ws + WS_ROUTE);
    unsigned char* wl = F.lds + F.wave * 8192;
    unsigned short* ql = (unsigned short*)wl;
    float* tv = (float*)(wl + 4096);
    int* ti = (int*)(wl + 4096 + 1024);
    const int lane = F.lane;
    for (int t = F.gw; t < T; t += F.NGW) {
        { const v4u* src = (const v4u*)(PQ + (size_t)t * 2048); v4u* dst = (v4u*)ql;
#pragma unroll
          for (int i = 0; i < 4; ++i) dst[lane + 64 * i] = src[lane + 64 * i]; }
        LDS_WAIT(); asm volatile("" ::: "memory");
        for (int g = 0; g < 16; ++g) {
            const v4u* k0 = (const v4u*)(SUBK + (size_t)(g * 128 + lane) * 128);
            const v4u* k1 = (const v4u*)(SUBK + (size_t)(g * 128 + 64 + lane) * 128);
            const v4u* qg = (const v4u*)(ql + g * 128);
            float s0 = 0.f, s1 = 0.f;
#pragma unroll 4
            for (int ch = 0; ch < 16; ++ch) { const v4u q = qg[ch], a = k0[ch], c = k1[ch];
                s0 = dot2c(s0, q.x, a.x); s0 = dot2c(s0, q.y, a.y); s0 = dot2c(s0, q.z, a.z); s0 = dot2c(s0, q.w, a.w);
                s1 = dot2c(s1, q.x, c.x); s1 = dot2c(s1, q.y, c.y); s1 = dot2c(s1, q.z, c.z); s1 = dot2c(s1, q.w, c.w); }
            float myv = 0.f; int myi = 0;
            for (int it = 0; it < 16; ++it) {
                float bv; int bi; if (s0 >= s1) { bv = s0; bi = lane; } else { bv = s1; bi = lane + 64; }
                argmax_step(bv, bi);
                if (it == lane) { myv = bv; myi = bi; }
                if (bi == lane) s0 = -INFINITY; if (bi == lane + 64) s1 = -INFINITY;
            }
            if (lane < 16) { tv[g * 16 + lane] = myv; ti[g * 16 + lane] = myi; }
        }
        LDS_WAIT(); asm volatile("" ::: "memory");
        for (int h = 0; h < 8; ++h) {
            float cv[4];
#pragma unroll
            for (int r = 0; r < 4; ++r) cv[r] = tv[(2 * h) * 16 + (lane >> 2)] + tv[(2 * h + 1) * 16 + 4 * (lane & 3) + r];
            float myv = -INFINITY; int myc = 0;
            for (int it = 0; it < 16; ++it) {
                float bv = cv[0]; int bi = 4 * lane;
#pragma unroll
                for (int r = 1; r < 4; ++r) if (cv[r] > bv) { bv = cv[r]; bi = 4 * lane + r; }
                argmax_step(bv, bi);
                if (it == lane) { myv = bv; myc = bi; }
#pragma unroll
                for (int r = 0; r < 4; ++r) if (bi == 4 * lane + r) cv[r] = -INFINITY;
            }
            const float mx = __shfl(myv, 0);
            float ex = lane < 16 ? __expf(myv - mx) : 0.f;
            const float sum = wave_sum(ex);
            if (lane < 16) { const int e = ti[(2 * h) * 16 + (myc >> 4)] * 128 + ti[(2 * h + 1) * 16 + (myc & 15)];
                ROUTE[(size_t)t * 128 + h * 16 + lane] = ((unsigned)e << 16) | f2bf(ex / sum); }
        }
        LDS_WAIT(); asm volatile("" ::: "memory");
    }
}

__device__ __forceinline__ float gelu_tanh(float x) { const float z = 0.7978845608028654f * (x + 0.044715f * x * x * x); const float th = 1.0f - 2.0f / (1.0f + __expf(2.0f * z)); return 0.5f * x * (1.0f + th); }
__device__ __forceinline__ void peer_gather(Frame& F) {
    const unsigned short* H2 = (const unsigned short*)(F.ws + WS_H2);
    const unsigned short* U = (const unsigned short*)(F.ws + WS_U);
    const unsigned short* V = (const unsigned short*)(F.ws + WS_V);
    const unsigned* ROUTE = (const unsigned*)(F.ws + WS_ROUTE);
    const float* MOD = (const float*)(F.ws + WS_MOD);
    const float* fg = F.in[20];
    float* pp = (float*)(F.lds + F.wave * (64 * 65 * 4));
    const int lane = F.lane;
    for (int t = F.gw; t < T; t += F.NGW) {
        const int b = t >> 12;
        const v4u ha = ((const v4u*)(H2 + (size_t)t * 1024))[lane], hb = ((const v4u*)(H2 + (size_t)t * 1024))[64 + lane];
        const unsigned r0 = ROUTE[(size_t)t * 128 + lane], r1 = ROUTE[(size_t)t * 128 + 64 + lane];
        float coef0, coef1;
#pragma unroll
        for (int half = 0; half < 2; ++half) {
            const unsigned rr = half ? r1 : r0;
            for (int k = 0; k < 64; k += 4) {
                v4u ua[4], ub[4];
#pragma unroll
                for (int q = 0; q < 4; ++q) { const unsigned id = __builtin_amdgcn_readlane(rr, k + q) >> 16; const v4u* row = (const v4u*)(U + (size_t)id * 1024); ua[q] = row[lane]; ub[q] = row[64 + lane]; }
#pragma unroll
                for (int q = 0; q < 4; ++q) { float d = 0.f;
                    d = dot2c(d, ua[q].x, ha.x); d = dot2c(d, ua[q].y, ha.y); d = dot2c(d, ua[q].z, ha.z); d = dot2c(d, ua[q].w, ha.w);
                    d = dot2c(d, ub[q].x, hb.x); d = dot2c(d, ub[q].y, hb.y); d = dot2c(d, ub[q].z, hb.z); d = dot2c(d, ub[q].w, hb.w);
                    pp[(k + q) * 65 + lane] = d; }
            }
            LDS_WAIT(); asm volatile("" ::: "memory");
            float tot = 0.f;
#pragma unroll 8
            for (int i = 0; i < 64; ++i) tot += pp[lane * 65 + i];
            LDS_WAIT(); asm volatile("" ::: "memory");
            const float cf = bflo(rr) * gelu_tanh(tot);
            if (half) coef1 = cf; else coef0 = cf;
        }
        float o[16];
#pragma unroll
        for (int i = 0; i < 16; ++i) o[i] = 0.f;
#pragma unroll
        for (int half = 0; half < 2; ++half) {
            const unsigned rr = half ? r1 : r0; const float cfv = half ? coef1 : coef0;
            for (int k = 0; k < 64; k += 4) {
                v4u va[4], vb[4]; float cs[4];
#pragma unroll
                for (int q = 0; q < 4; ++q) { const unsigned id = __builtin_amdgcn_readlane(rr, k + q) >> 16; cs[q] = __builtin_bit_cast(float, __builtin_amdgcn_readlane(__builtin_bit_cast(unsigned, cfv), k + q));
                    const v4u* row = (const v4u*)(V + (size_t)id * 1024); va[q] = row[lane]; vb[q] = row[64 + lane]; }
#pragma unroll
                for (int q = 0; q < 4; ++q) { const float c = cs[q];
                    o[0] += c * bflo(va[q].x); o[1] += c * bfhi(va[q].x); o[2] += c * bflo(va[q].y); o[3] += c * bfhi(va[q].y);
                    o[4] += c * bflo(va[q].z); o[5] += c * bfhi(va[q].z); o[6] += c * bflo(va[q].w); o[7] += c * bfhi(va[q].w);
                    o[8] += c * bflo(vb[q].x); o[9] += c * bfhi(vb[q].x); o[10] += c * bflo(vb[q].y); o[11] += c * bfhi(vb[q].y);
                    o[12] += c * bflo(vb[q].z); o[13] += c * bfhi(vb[q].z); o[14] += c * bflo(vb[q].w); o[15] += c * bfhi(vb[q].w); }
            }
        }
        float* xrow = F.out + (size_t)t * 1024;
        const float* gt2 = MOD + b * 6144 + 5120;
        float x2[16]; float ss = 0.f;
#pragma unroll
        for (int c4 = 0; c4 < 4; ++c4) { const int e0 = (c4 < 2 ? 8 * lane + 4 * c4 : 512 + 8 * lane + 4 * (c4 - 2));
            const f32x4 xv = *(const f32x4*)(xrow + e0), gv = *(const f32x4*)(gt2 + e0);
#pragma unroll
            for (int i = 0; i < 4; ++i) { const float v = xv[i] + gv[i] * o[4 * c4 + i]; x2[4 * c4 + i] = v; ss += v * v; } }
        const float rstd = rsqrtf(wave_sum(ss) * (1.0f / 1024.0f) + EPS);
#pragma unroll
        for (int c4 = 0; c4 < 4; ++c4) { const int e0 = (c4 < 2 ? 8 * lane + 4 * c4 : 512 + 8 * lane + 4 * (c4 - 2));
            const f32x4 gv = *(const f32x4*)(fg + e0); f32x4 ov;
#pragma unroll
            for (int i = 0; i < 4; ++i) ov[i] = x2[4 * c4 + i] * rstd * gv[i];
            *(f32x4*)(xrow + e0) = ov; }
    }
}

constexpr int N_PHASES = 11;
#ifndef MK_ONE_LAUNCH
#define MK_ONE_LAUNCH 0
#endif
__global__ void __launch_bounds__(NWAVES * 64, 2) fwd_kernel(Args args) {
    extern __shared__ __attribute__((aligned(16))) unsigned char lds[];
    Frame F;
    F.lds = lds; F.tid = threadIdx.x; F.lane = F.tid & 63; F.wave = __builtin_amdgcn_readfirstlane(F.tid >> 6);
    F.G = gridDim.x; F.gw = blockIdx.x * NWAVES + F.wave; F.NGW = F.G * NWAVES;
#pragma unroll
    for (int i = 0; i < 21; ++i) F.in[i] = args.in[i];
    F.out = args.out; F.ws = args.ws;
    LAS unsigned char* ldsl = (LAS unsigned char*)lds;
    volatile LAS unsigned* MISC = (volatile LAS unsigned*)(ldsl + MISC_OFF);
    for (int u = F.tid; u < (LDS_BYTES - MISC_OFF) / 4; u += NWAVES * 64) ((LAS unsigned*)(ldsl + MISC_OFF))[u] = 0u;
    __syncthreads();
    unsigned* ctl = (unsigned*)(F.ws + WS_CTL);
    XcdBarrier bar; bar.bar = ctl + CW_BAR; bar.x = 0; bar.st = nullptr;
    const bool one = (args.ph_hi - args.ph_lo) > 1;
    if (one) bar = xcd_barrier_post(ctl + CW_BAR, MISC + 8);
    const int lo = args.ph_lo, hi = args.ph_hi;
#define IN(k) (lo <= (k) && (k) < hi)
#define SEAM(k) do { if (IN(k) && IN((k) + 1)) xcd_barrier(bar); } while (0)
    if (IN(0)) { p0_prologue(F); } SEAM(0);
    if (IN(1)) { norm_mod_rows<true>(F, F.in[0], F.in[4], 0, 1024, (unsigned short*)(F.ws + WS_H1)); } SEAM(1);
    if (IN(2)) { pg8::Gemm g{(const pg8::bf16_t*)(F.ws + WS_H1), (const pg8::bf16_t*)(F.ws + WS_WIN), T, NPROJ, 1024}; pg8::StaticOrder S; S.init(T, NPROJ, F.G, (int)blockIdx.x);
        Epi<EPI_ROUTE> E{F.ws, F.in[0], F.out}; pg8::gemm_phase<Epi<EPI_ROUTE>, pg8::StaticOrder, true, true>(ldsl, g, S, E); } SEAM(2);
    if (IN(3)) {
        if (blockIdx.x < 64) mlstm_ref_unit(F, blockIdx.x >> 2, blockIdx.x & 3);
        else { const int nw = (F.G - 64) * NWAVES, w0 = (blockIdx.x - 64) * NWAVES + F.wave; for (int it = w0; it < T * 8; it += nw) attn_ref_item(F, it >> 3, it & 7); }
    } SEAM(3);
    if (IN(4)) { pg8::Gemm g{(const pg8::bf16_t*)(F.ws + WS_YA), (const pg8::bf16_t*)(F.ws + WS_WA), T, 1024, 512}; pg8::StaticOrder S; S.init(T, 1024, F.G, (int)blockIdx.x);
        Epi<EPI_MERGE_A> E{F.ws, F.in[0], F.out}; pg8::gemm_phase<Epi<EPI_MERGE_A>, pg8::StaticOrder, true, true>(ldsl, g, S, E); } SEAM(4);
    if (IN(5)) { pg8::Gemm g{(const pg8::bf16_t*)(F.ws + WS_YB), (const pg8::bf16_t*)(F.ws + WS_WB), T, 1024, 512}; pg8::StaticOrder S; S.init(T, 1024, F.G, (int)blockIdx.x);
        Epi<EPI_MERGE_B> E{F.ws, F.in[0], F.out}; pg8::gemm_phase<Epi<EPI_MERGE_B>, pg8::StaticOrder, true, true>(ldsl, g, S, E); } SEAM(5);
    if (IN(6)) { pg8::Gemm g{(const pg8::bf16_t*)(F.ws + WS_Y), (const pg8::bf16_t*)(F.ws + WS_WOUT), T, 1024, 1024}; pg8::StaticOrder S; S.init(T, 1024, F.G, (int)blockIdx.x);
        Epi<EPI_OUTPROJ> E{F.ws, F.in[0], F.out}; pg8::gemm_phase<Epi<EPI_OUTPROJ>, pg8::StaticOrder, true, true>(ldsl, g, S, E); } SEAM(6);
    if (IN(7)) { norm_mod_rows<false>(F, F.out, F.in[15], 3072, 4096, (unsigned short*)(F.ws + WS_H2)); } SEAM(7);
    if (IN(8)) { pg8::Gemm g{(const pg8::bf16_t*)(F.ws + WS_H2), (const pg8::bf16_t*)(F.ws + WS_WPQ), T, 2048, 1024}; pg8::StaticOrder S; S.init(T, 2048, F.G, (int)blockIdx.x);
        Epi<EPI_PQ> E{F.ws, F.in[0], F.out}; pg8::gemm_phase<Epi<EPI_PQ>, pg8::StaticOrder, true, true>(ldsl, g, S, E); } SEAM(8);
    if (IN(9)) { peer_route_ref(F); } SEAM(9);
    if (IN(10)) { peer_gather(F); }
#ifdef DBG_DUMP
    if (hi < N_PHASES) { xcd_barrier(bar);
        for (int t = F.gw; t < T; t += F.NGW) { float* o = F.out + (size_t)t * 1024;
            for (int c = F.lane; c < 1024; c += 64) { float v = 0.f;
                if (DBG_DUMP == 8) v = bf2f(((const unsigned short*)(F.ws + WS_H2))[(size_t)t * 1024 + c]);
                if (DBG_DUMP == 9) v = bf2f(((const unsigned short*)(F.ws + WS_PQ))[(size_t)t * 2048 + c]) + 3.0f * bf2f(((const unsigned short*)(F.ws + WS_PQ))[(size_t)t * 2048 + 1024 + c]);
                if (DBG_DUMP == 10) v = (float)(((const unsigned*)(F.ws + WS_ROUTE))[(size_t)t * 128 + (c & 127)] >> ((c & 128) ? 16 : 0) & 0xffff) * (1.0f / 4096.0f);
                o[c] = v; } } }
#endif
#undef IN
#undef SEAM
}

extern "C" void kernel_launch(void* const* d_in, const int* in_sizes, int n_in, void* d_out, int out_size, void* d_ws, size_t ws_size, hipStream_t stream) {
    static int grid = 0;
    if (grid == 0) {
        if (n_in != 21 || out_size != T * DM || ws_size < WS_END) { fprintf(stderr, "kernel_launch: unexpected shapes (n_in %d, out %d, ws %zu); nothing launched\n", n_in, out_size, ws_size); grid = -1; return; }
        int dev = 0, cus = 0;
        if (hipGetDevice(&dev) != hipSuccess || hipDeviceGetAttribute(&cus, hipDeviceAttributeMultiprocessorCount, dev) != hipSuccess) { grid = -1; return; }
        if (hipFuncSetAttribute((const void*)fwd_kernel, hipFuncAttributeMaxDynamicSharedMemorySize, LDS_BYTES) != hipSuccess) { fprintf(stderr, "kernel_launch: hipFuncSetAttribute failed\n"); grid = -1; return; }
        int per_cu = 0;
        if (hipOccupancyMaxActiveBlocksPerMultiprocessor(&per_cu, (const void*)fwd_kernel, NWAVES * 64, LDS_BYTES) != hipSuccess || per_cu < 1) fprintf(stderr, "kernel_launch: occupancy query reports %d\n", per_cu);
        (void)hipGetLastError();
        grid = cus;
    }
    if (grid < 0) return;
    (void)hipMemsetAsync((char*)d_ws + WS_CTL, 0, CTL_ZERO_BYTES, stream);
    Args a{};
    for (int i = 0; i < 21; ++i) a.in[i] = (const float*)d_in[i];
    a.out = (float*)d_out; a.ws = (unsigned char*)d_ws;
#if MK_ONE_LAUNCH
#ifndef DBG_STOP
#define DBG_STOP N_PHASES
#endif
    a.ph_lo = 0; a.ph_hi = DBG_STOP; a.li = 0;
    hipLaunchKernelGGL(fwd_kernel, dim3(grid), dim3(NWAVES * 64), LDS_BYTES, stream, a);
#else
    for (int li = 0; li < N_PHASES; ++li) { a.ph_lo = li; a.ph_hi = li + 1; a.li = li; hipLaunchKernelGGL(fwd_kernel, dim3(grid), dim3(NWAVES * 64), LDS_BYTES, stream, a); }
#endif
}
```

```cpp
#include <hip/hip_runtime.h>
#include <cstdio>
#include <cstdint>
#include <cmath>
#define MK_ONE_LAUNCH 1
namespace pg8 {
#define PG8_LAS __attribute__((address_space(3)))
typedef unsigned short bf16_t;
typedef short bf16x8 __attribute__((ext_vector_type(8)));
typedef float f32x4 __attribute__((ext_vector_type(4)));
typedef unsigned u32x4 __attribute__((ext_vector_type(4)));
typedef int pg8_v4i __attribute__((ext_vector_type(4)));
typedef int pg8_v8i __attribute__((ext_vector_type(8)));
constexpr int BM = 256, BK = 64, HALF = 128, HTB = HALF * BK * 2  , STAGE_BYTES = 8 * HTB, NXCD = 8, WGM = 8;

__host__ __device__ __forceinline__ int lds_byte(int r, int c) { const int st = (r >> 4) * 2 + (c >> 5), rr = r & 15, cc = c & 31, ob = rr * 64 + cc * 2; return st * 1024 + (ob ^ (((ob >> 9) & 1) << 5)); }
__host__ __device__ __forceinline__ void stage_rc(int b, int& R, int& C) { const int st = b / 1024, sb = b % 1024, swz = sb ^ (((sb >> 9) & 1) << 5); R = (st >> 1) * 16 + swz / 64; C = (st & 1) * 32 + (swz % 64) / 2; }
__host__ __device__ __forceinline__ int perm32(int rho) { const int n = rho >> 4, i = rho & 15; return 8 * (i >> 2) + 4 * n + (i & 3); }

struct Unit { int pm, pn, half; };
struct Gemm { const bf16_t* A; const bf16_t* Bt; int M, N, K; const bf16_t* A2 = nullptr; const bf16_t* Bt2 = nullptr; };

struct StaticOrder {
    int nM, nN, nwg, G, c;
    __host__ __device__ void init(int M, int N, int G_, int c_) { nM = M / BM; nN = N / BM; nwg = nM * nN; G = G_; c = c_; }
    __host__ __device__ bool next(int i, Unit& u) const {
        const long L = (long)i * G + c; if (L >= nwg) return false;
        int wgid = (int)L; { const int q = nwg / NXCD, r = nwg % NXCD, xcd = wgid % NXCD, off = wgid / NXCD; wgid = (xcd < r ? xcd * (q + 1) : r * (q + 1) + (xcd - r) * q) + off; }
        const int nig = WGM * nN, gid = wgid / nig, fm = gid * WGM, gsz = (nM - fm) < WGM ? (nM - fm) : WGM;
        u.pm = fm + ((wgid % nig) % gsz); u.pn = (wgid % nig) / gsz; u.half = 0; return true;
    }
    __device__ __forceinline__ void a_ready(const Unit&) const {}
    __device__ __forceinline__ void done(const Unit&) const {}
};
struct TwoPassOrder {
    StaticOrder so;
    __host__ __device__ void init(int M, int N, int G_, int c_) { so.init(M, N, G_, c_); }
    __host__ __device__ bool next(int i, Unit& u) const { if (!so.next(i >> 1, u)) return false; u.half = i & 1; return true; }
    __device__ __forceinline__ void a_ready(const Unit&) const {}
    __device__ __forceinline__ void done(const Unit&) const {}
};
__device__ __forceinline__ unsigned cvt_pk_bf16(float lo, float hi) { unsigned r; asm volatile("v_cvt_pk_bf16_f32 %0, %1, %2" : "=v"(r) : "v"(lo), "v"(hi)); return r; }
template <class Epi, class Sched, bool ALIGN_EPI = false, bool SP2 = false, bool FP8 = false>
__device__ __forceinline__ void gemm_phase(PG8_LAS unsigned char* lds, const Gemm g, const Sched& S, const Epi& E) {
    const int tid = threadIdx.x, wid = __builtin_amdgcn_readfirstlane(tid >> 6), lane = tid & 63, wr = wid >> 2, wc = wid & 3, fr = lane & 15, fq = lane >> 4;
    const int K = g.K, nt = K / BK;
    unsigned voffA[2], voffB[2];
#pragma unroll
    for (int i = 0; i < 2; ++i) { int R, C; stage_rc(tid * 16 + i * 8192, R, C); const int Rb = Epi::PERM ? ((R & ~31) + perm32(R & 31)) : R;
        voffA[i] = (unsigned)(R * K + C) * 2u; voffB[i] = (unsigned)(Rb * K + C) * 2u; }
    const size_t kstep = (size_t)(BK * 2);
    const size_t hstep = (size_t)HALF * K * 2;
    const size_t tstep = 2 * hstep;
    const unsigned ldsw = (unsigned)wid * 1024u;
    const int aoff = lds_byte(wr * 64 + fr, fq * 8), boff = lds_byte(wc * 32 + fr, fq * 8);
#define PG8_SA(b, h) (((b) * 2 + (h)) * HTB)
#define PG8_SB(b, h) ((4 + (b) * 2 + (h)) * HTB)
#define PG8_STAGE(bufoff, gbase, voff) do { _Pragma("unroll") for (int _i = 0; _i < 2; ++_i) \
        __builtin_amdgcn_global_load_lds((const unsigned*)((const char*)(gbase) + (voff)[_i]), (PG8_LAS unsigned*)(lds + (bufoff) + ldsw + _i * 8192), 16, 0, 0); } while (0)
#define PG8_LDA(dst, b, h) do { _Pragma("unroll") for (int m = 0; m < 4; ++m) dst[m] = PG8_CAT(*(const PG8_LAS bf16x8*)(lds + PG8_SA(b, h) + aoff + m * 2048), *(const PG8_LAS bf16x8*)(lds + PG8_SA(b, h) + aoff + m * 2048 + 1024)); } while (0)
#define PG8_LDB(dst, b, h) do { _Pragma("unroll") for (int n = 0; n < 2; ++n) dst[n] = PG8_CAT(*(const PG8_LAS bf16x8*)(lds + PG8_SB(b, h) + boff + n * 2048), *(const PG8_LAS bf16x8*)(lds + PG8_SB(b, h) + boff + n * 2048 + 1024)); } while (0)
#define PG8_CAT(x, y) __builtin_shufflevector(__builtin_bit_cast(pg8_v4i, x), __builtin_bit_cast(pg8_v4i, y), 0, 1, 2, 3, 4, 5, 6, 7)
#define PG8_HALF(v, k) __builtin_bit_cast(bf16x8, __builtin_shufflevector(v, v, 4 * (k), 4 * (k) + 1, 4 * (k) + 2, 4 * (k) + 3))
#define PG8_MMA(ai, bj, At, Bt) do { __builtin_amdgcn_s_setprio(1); \
        if constexpr (FP8) { _Pragma("unroll") for (int m = 0; m < 4; ++m) _Pragma("unroll") for (int n = 0; n < 2; ++n) \
            asm volatile("v_mfma_f32_16x16x128_f8f6f4 %0, %1, %2, %0" : "+v"(acc[ai][bj][m][n]) : "v"(Bt[n]), "v"(At[m])); } \
        else { _Pragma("unroll") for (int m = 0; m < 4; ++m) _Pragma("unroll") for (int n = 0; n < 2; ++n) { \
            acc[ai][bj][m][n] = __builtin_amdgcn_mfma_f32_16x16x32_bf16(PG8_HALF(Bt[n], 0), PG8_HALF(At[m], 0), acc[ai][bj][m][n], 0, 0, 0); \
            acc[ai][bj][m][n] = __builtin_amdgcn_mfma_f32_16x16x32_bf16(PG8_HALF(Bt[n], 1), PG8_HALF(At[m], 1), acc[ai][bj][m][n], 0, 0, 0); } } \
        __builtin_amdgcn_s_setprio(0); } while (0)
#define PG8_WAIT_V(n) asm volatile("s_waitcnt vmcnt(" #n ")" ::: "memory")
#define PG8_WAIT_L(n) asm volatile("s_waitcnt lgkmcnt(" #n ")" ::: "memory")
#define PG8_BAR __builtin_amdgcn_s_barrier()
#define PG8_SCHED __builtin_amdgcn_sched_barrier(0)
    Unit cur, nxt; int ui = 0;
    if (!S.next(0, cur)) return;
    f32x4 acc[2][2][4][2];
#pragma unroll
    for (int a = 0; a < 2; ++a)
#pragma unroll
        for (int b = 0; b < 2; ++b)
#pragma unroll
            for (int m = 0; m < 4; ++m)
#pragma unroll
                for (int n = 0; n < 2; ++n) acc[a][b][m][n] = (f32x4){0.f, 0.f, 0.f, 0.f};
    pg8_v8i At[4], B0[2], B1[2];
    const char* cA = (const char*)((Epi::TWO_PASS && cur.half) ? g.A2 : g.A) + (size_t)cur.pm * tstep; const char* cB = (const char*)((Epi::TWO_PASS && cur.half) ? g.Bt2 : g.Bt) + (size_t)cur.pn * tstep;
    S.a_ready(cur);
    if constexpr (SP2) {
        PG8_STAGE(PG8_SB(0, 0), cB, voffB); PG8_STAGE(PG8_SB(0, 1), cB + hstep, voffB); PG8_STAGE(PG8_SA(0, 0), cA, voffA); PG8_STAGE(PG8_SA(0, 1), cA + hstep, voffA);
        if (wr == 1) PG8_BAR;
        PG8_WAIT_V(2); PG8_BAR;
        PG8_STAGE(PG8_SB(1, 0), cB + kstep, voffB); PG8_STAGE(PG8_SA(1, 0), cA + kstep, voffA); PG8_STAGE(PG8_SB(1, 1), cB + hstep + kstep, voffB);
        PG8_WAIT_V(6); PG8_BAR;
    } else {
        PG8_STAGE(PG8_SB(0, 0), cB, voffB); PG8_STAGE(PG8_SA(0, 0), cA, voffA); PG8_STAGE(PG8_SB(0, 1), cB + hstep, voffB); PG8_STAGE(PG8_SA(0, 1), cA + hstep, voffA);
        if (wr == 1) PG8_BAR;
        PG8_WAIT_V(4); PG8_BAR;
        PG8_STAGE(PG8_SB(1, 0), cB + kstep, voffB); PG8_STAGE(PG8_SA(1, 0), cA + kstep, voffA); PG8_STAGE(PG8_SB(1, 1), cB + hstep + kstep, voffB);
        PG8_WAIT_V(6); PG8_BAR;
    }
    for (;;) {
        const bool has_next = S.next(ui + 1, nxt);
        const char* nA = has_next ? (const char*)((Epi::TWO_PASS && nxt.half) ? g.A2 : g.A) + (size_t)nxt.pm * tstep : cA; const char* nB = has_next ? (const char*)((Epi::TWO_PASS && nxt.half) ? g.Bt2 : g.Bt) + (size_t)nxt.pn * tstep : cB;
        for (int t = 0; t < nt; t += 2) {
            const bool last = (t == nt - 2);
            const char* a1 = cA + (size_t)(t + 1) * kstep;
            const char* a2 = last ? nA : cA + (size_t)(t + 2) * kstep; const char* b2 = last ? nB : cB + (size_t)(t + 2) * kstep;
            const char* a3 = a2 + kstep; const char* b3 = b2 + kstep;
            if (last && has_next) S.a_ready(nxt);
            if constexpr (SP2) {
            PG8_LDB(B0, 0, 0); PG8_LDB(B1, 0, 1); PG8_SCHED; PG8_LDA(At, 0, 0); PG8_STAGE(PG8_SA(1, 1), a1 + hstep, voffA);
            PG8_WAIT_V(8); PG8_WAIT_L(0); PG8_BAR; PG8_MMA(0, 0, At, B0); PG8_MMA(0, 1, At, B1); PG8_BAR; PG8_SCHED;
            PG8_LDA(At, 0, 1); PG8_STAGE(PG8_SB(0, 0), b2, voffB); PG8_STAGE(PG8_SB(0, 1), b2 + hstep, voffB); PG8_STAGE(PG8_SA(0, 0), a2, voffA);
            PG8_WAIT_V(8); PG8_WAIT_L(0); PG8_BAR; PG8_MMA(1, 0, At, B0); PG8_MMA(1, 1, At, B1); PG8_BAR; PG8_SCHED;
            PG8_LDB(B0, 1, 0); PG8_LDB(B1, 1, 1); PG8_SCHED; PG8_LDA(At, 1, 0); PG8_STAGE(PG8_SA(0, 1), a2 + hstep, voffA);
            PG8_WAIT_V(8); PG8_WAIT_L(0); PG8_BAR; PG8_MMA(0, 0, At, B0); PG8_MMA(0, 1, At, B1); PG8_BAR; PG8_SCHED;
            PG8_LDA(At, 1, 1); PG8_STAGE(PG8_SB(1, 0), b3, voffB); PG8_STAGE(PG8_SB(1, 1), b3 + hstep, voffB); PG8_STAGE(PG8_SA(1, 0), a3, voffA);
            PG8_WAIT_V(8); PG8_WAIT_L(0); PG8_BAR; PG8_MMA(1, 0, At, B0); PG8_MMA(1, 1, At, B1); PG8_BAR; PG8_SCHED;
            } else {
            PG8_LDB(B0, 0, 0); PG8_SCHED; PG8_LDA(At, 0, 0); PG8_STAGE(PG8_SA(1, 1), a1 + hstep, voffA);
            PG8_WAIT_L(8); PG8_BAR; PG8_WAIT_L(0); PG8_MMA(0, 0, At, B0); PG8_BAR; PG8_SCHED;
            PG8_LDB(B1, 0, 1); PG8_STAGE(PG8_SB(0, 0), b2, voffB);
            PG8_BAR; PG8_WAIT_L(0); PG8_MMA(0, 1, At, B1); PG8_BAR;
            PG8_LDA(At, 0, 1); PG8_STAGE(PG8_SA(0, 0), a2, voffA);
            PG8_BAR; PG8_WAIT_L(0); PG8_MMA(1, 0, At, B0); PG8_BAR; PG8_SCHED;
            PG8_STAGE(PG8_SB(0, 1), b2 + hstep, voffB);
            PG8_WAIT_V(6); PG8_BAR; PG8_MMA(1, 1, At, B1); PG8_BAR;
            PG8_LDB(B0, 1, 0); PG8_SCHED; PG8_LDA(At, 1, 0); PG8_STAGE(PG8_SA(0, 1), a2 + hstep, voffA);
            PG8_WAIT_L(8); PG8_BAR; PG8_WAIT_L(0); PG8_MMA(0, 0, At, B0); PG8_BAR; PG8_SCHED;
            PG8_LDB(B1, 1, 1); PG8_STAGE(PG8_SB(1, 0), b3, voffB);
            PG8_BAR; PG8_WAIT_L(0); PG8_MMA(0, 1, At, B1); PG8_BAR;
            PG8_LDA(At, 1, 1); PG8_STAGE(PG8_SA(1, 0), a3, voffA);
            PG8_BAR; PG8_WAIT_L(0); PG8_MMA(1, 0, At, B0); PG8_BAR; PG8_SCHED;
            PG8_STAGE(PG8_SB(1, 1), b3 + hstep, voffB);
            PG8_WAIT_V(6); PG8_BAR; PG8_MMA(1, 1, At, B1); PG8_BAR;
            }
        }
        if constexpr (FP8) asm volatile("s_nop 15\n\ts_nop 15" ::: "memory");
        if constexpr (ALIGN_EPI) { if (wr == 0) PG8_BAR; }
        bool keep_acc = false;
        if constexpr (Epi::TWO_PASS) { if (cur.half == 0) { E.mid(acc, cur, wr, wc, fr, fq); keep_acc = true; } else { E(acc, cur, wr, wc, fr, fq); } }
        else if constexpr (!Epi::AFTER_DRAIN) { E(acc, cur, wr, wc, fr, fq); S.done(cur); }
        if (!has_next) break;
        if (!keep_acc)
#pragma unroll
        for (int a = 0; a < 2; ++a)
#pragma unroll
            for (int b = 0; b < 2; ++b)
#pragma unroll
                for (int m = 0; m < 4; ++m)
#pragma unroll
                    for (int n = 0; n < 2; ++n) acc[a][b][m][n] = (f32x4){0.f, 0.f, 0.f, 0.f};
        cur = nxt; cA = nA; cB = nB; ++ui;
        if constexpr (ALIGN_EPI) { if (wr == 1) PG8_BAR; }
    }
    PG8_WAIT_V(0);
    if constexpr (!ALIGN_EPI) { if (wr == 0) PG8_BAR; }
    PG8_BAR;
    if constexpr (Epi::AFTER_DRAIN) { E.fused(acc, cur, wr, wc, fr, fq, lds, wid, lane); S.done(cur); }
#undef PG8_SA
#undef PG8_SB
#undef PG8_STAGE
#undef PG8_LDA
#undef PG8_LDB
#undef PG8_MMA
#undef PG8_CAT
#undef PG8_HALF
#undef PG8_WAIT_V
#undef PG8_WAIT_L
#undef PG8_BAR
#undef PG8_SCHED
}
}
#define GAS __attribute__((address_space(1)))
#define LAS __attribute__((address_space(3)))
typedef unsigned short bf16;
typedef unsigned v4u __attribute__((ext_vector_type(4)));
typedef float f32x4 __attribute__((ext_vector_type(4)));
typedef short bf16x8 __attribute__((ext_vector_type(8)));
typedef GAS unsigned gu32;
typedef GAS unsigned long long gu64;
#define RLX_AGENT __ATOMIC_RELAXED, __HIP_MEMORY_SCOPE_AGENT
#define LDS_WAIT() asm volatile("s_waitcnt lgkmcnt(0)" ::: "memory")
#define VM_WAIT() asm volatile("s_waitcnt vmcnt(0)" ::: "memory")
__device__ __forceinline__ unsigned long long rt() { return __builtin_amdgcn_s_memrealtime(); }
__device__ __forceinline__ unsigned f2bf(float f) { unsigned u = __builtin_bit_cast(unsigned, f); return (u + 0x7fffu + ((u >> 16) & 1u)) >> 16; }
__device__ __forceinline__ unsigned pk2(float lo, float hi) { return f2bf(lo) | (f2bf(hi) << 16); }

#define XB_TMO      128
#define XB_XCNT(j)  (256  + 64 * (j))
#define XB_XSUB(j)  (1280 + 64 * (j))
#define XB_XGEN(j)  (2304 + 64 * (j))
#define XB_TOP      3328
#define XB_TOPGEN   3392
#define XCD_BAR_WORDS 3456
#define XB_SPIN_CAP (1u << 18)

__device__ __forceinline__ unsigned xb_ld(unsigned* p)              { return __hip_atomic_load(p, __ATOMIC_RELAXED, __HIP_MEMORY_SCOPE_AGENT); }
__device__ __forceinline__ unsigned xb_add(unsigned* p, unsigned v) { return __hip_atomic_fetch_add(p, v, __ATOMIC_RELAXED, __HIP_MEMORY_SCOPE_AGENT); }
__device__ __forceinline__ unsigned xb_xcc_id() { return (unsigned)__builtin_amdgcn_s_getreg((3 << 11) | 20) & 0xFu; }
#define XB_SPIN(cond, bar) do { unsigned _sp = 0; while (cond) { __builtin_amdgcn_s_sleep(1); \
    if ((++_sp & 255u) == 0u) { if (xb_ld(&(bar)[XB_TMO])) break; if (_sp > XB_SPIN_CAP) { atomicAdd(&(bar)[XB_TMO], 1u); break; } } } } while (0)

struct XcdBarrier {
    unsigned* bar; unsigned x;
    volatile LAS unsigned* st;
};

__device__ __forceinline__ XcdBarrier xcd_barrier_post(unsigned* bar, volatile LAS unsigned* st) {
    XcdBarrier b; b.bar = bar; b.x = xb_xcc_id(); b.st = st;
    if (threadIdx.x == 0) (void)xb_add(&bar[XB_XCNT(b.x)], 1u);
    return b;
}
__device__ __forceinline__ void xcd_barrier_complete(unsigned* bar, unsigned x, unsigned& nloc, unsigned& nx) {
    const unsigned G = gridDim.x * gridDim.y * gridDim.z;
    unsigned sum, cnt, mine, sp = 0u;
    for (;;) {
        sum = 0u; cnt = 0u; mine = 0u;
#pragma unroll
        for (unsigned j = 0; j < 16; ++j) { const unsigned c = xb_ld(&bar[XB_XCNT(j)]); sum += c; cnt += (c > 0u) ? 1u : 0u; mine = (j == x) ? c : mine; }
        if (sum == G) break;
        __builtin_amdgcn_s_sleep(1);
        if ((++sp & 255u) == 0u) { if (xb_ld(&bar[XB_TMO])) break; if (sp > XB_SPIN_CAP) { atomicAdd(&bar[XB_TMO], 1u); break; } }
    }
    nloc = mine > 0u ? mine : 1u; nx = cnt > 0u ? cnt : 1u;
}

__device__ __forceinline__ void xcd_barrier(const XcdBarrier& b) {
    asm volatile("s_waitcnt vmcnt(0)" ::: "memory");
    __syncthreads();
    if (threadIdx.x == 0) {
        unsigned* bar = b.bar;
        __builtin_amdgcn_s_waitcnt(0);
        unsigned nloc = b.st[0], nx = b.st[1];
        if (nloc == 0u) { xcd_barrier_complete(bar, b.x, nloc, nx); b.st[0] = nloc; b.st[1] = nx; }
        const unsigned old = xb_add(&bar[XB_XSUB(b.x)], 1u);
        const unsigned gen = old / nloc;
        if (old + 1u == (gen + 1u) * nloc) {
            __builtin_amdgcn_fence(__ATOMIC_RELEASE, "agent");
            asm volatile("s_waitcnt vmcnt(0)" ::: "memory");
            const unsigned og = xb_add(&bar[XB_TOP], 1u);
            const unsigned tg = og / nx;
            if (og + 1u == (tg + 1u) * nx) xb_add(&bar[XB_TOPGEN], 1u);
            else XB_SPIN(xb_ld(&bar[XB_TOPGEN]) == tg, bar);
            __builtin_amdgcn_fence(__ATOMIC_ACQUIRE, "agent");
            xb_add(&bar[XB_XGEN(b.x)], 1u);
            asm volatile("s_waitcnt vmcnt(0)" ::: "memory");
        } else {
            XB_SPIN(xb_ld(&bar[XB_XGEN(b.x)]) == gen, bar);
            __builtin_amdgcn_fence(__ATOMIC_ACQUIRE, "agent");
            asm volatile("s_waitcnt vmcnt(0)" ::: "memory");
        }
    }
    __syncthreads();
}

#ifndef PEER_FP8
#define PEER_FP8 1
#endif
#ifndef FP4_BF16_SWAP
#define FP4_BF16_SWAP 1
#endif
#ifndef ML_SPLIT
#define ML_SPLIT 1
#endif
#ifndef PEER_PIPE
#define PEER_PIPE 1
#endif
#ifndef PEER_GB
#define PEER_GB 16
#endif
#ifndef PEER_SWEEP
#define PEER_SWEEP 0
#endif
#ifndef PEER_FP4
#define PEER_FP4 1
#endif
#ifndef DBG_TQ
#define DBG_TQ 1000ull
#endif
#ifndef DBG_IDMASK
#define DBG_IDMASK 0xffffu
#endif
#ifndef SW_SORT_MAX
#define SW_SORT_MAX 512
#endif
constexpr int NB = 16, SEQ = 4096, DM = 1024, T = NB * SEQ;
#ifndef PROJ_ALL_FP8
#define PROJ_ALL_FP8 1
#endif
constexpr int NPROJ_ALL = 5632;
constexpr int NPROJ_B = 2048;
constexpr int NPROJ_Q = 3584;
constexpr float WQ_SCALE = 64.0f;
constexpr int IN_COLS = 5640;
constexpr float EPS = 1e-6f;
constexpr int NWAVES = 8;

constexpr size_t MiB = 1u << 20;
constexpr size_t WS_CTL = 0, CTL_ZERO_BYTES = 1 * MiB;
constexpr size_t WS_MOD = 1 * MiB;
constexpr size_t WS_W8 = 2 * MiB;
constexpr size_t WS_WIN = 4 * MiB;
constexpr size_t WS_WINQ = 9 * MiB;
constexpr size_t WS_H1Q = 960 * MiB;
constexpr size_t WS_WA = 15 * MiB;
constexpr size_t WS_WB = 16 * MiB;
constexpr size_t WS_WOUT = 17 * MiB;
constexpr size_t WS_WPQ = 19 * MiB;
constexpr size_t WS_SUBK = 23 * MiB;
constexpr size_t WS_U = 24 * MiB;
constexpr size_t WS_V = 56 * MiB;
constexpr size_t WS_USC = 40 * MiB, WS_VSC = 41 * MiB;
constexpr size_t WS_GATES = 88 * MiB;
constexpr size_t WS_ROUTE = 90 * MiB;
constexpr size_t WS_H1 = 128 * MiB;
constexpr size_t WS_QKC = 128 * MiB;
constexpr size_t WS_YA = 448 * MiB, WS_YB = 512 * MiB, WS_H2 = 128 * MiB;
constexpr size_t WS_QKVA = 256 * MiB;
constexpr size_t WS_Y = 256 * MiB;
constexpr size_t WS_QKB = 448 * MiB;
constexpr size_t WS_VB = 576 * MiB;
constexpr size_t WS_OB = 640 * MiB;
constexpr size_t WS_GAB = 704 * MiB;
constexpr size_t WS_PQ = 704 * MiB;
constexpr size_t WS_X1 = 448 * MiB;
constexpr size_t WS_HIN = 960 * MiB;
constexpr size_t WS_GS = 4 * MiB;
constexpr size_t WS_DSUM = 10 * MiB;
constexpr size_t WS_AG = 11 * MiB + 512 * 1024;
constexpr size_t WS_MLFLAG = 512 * 1024;
constexpr size_t WS_COEF = 960 * MiB;
constexpr size_t WS_END = 992 * MiB;
constexpr int CW_BAR = 4096;

constexpr int LDS_BYTES = 151552;
constexpr int MISC_OFF = 147456;

struct Args { const float* in[21]; float* out; unsigned char* ws; int ph_lo, ph_hi, li, pad; };

struct Frame {
    unsigned char* lds;
    int tid, lane, wave, G, gw, NGW;
    const float* in[21]; float* out; unsigned char* ws;
};

__device__ __forceinline__ float bf2f(unsigned short h) { return __builtin_bit_cast(float, (unsigned)h << 16); }
__device__ __forceinline__ float bflo(unsigned w) { return __builtin_bit_cast(float, w << 16); }
__device__ __forceinline__ float bfhi(unsigned w) { return __builtin_bit_cast(float, w & 0xffff0000u); }
typedef __bf16 bf16x2_t __attribute__((ext_vector_type(2)));
__device__ __forceinline__ float dot2c(float acc, unsigned a, unsigned b) { return __builtin_amdgcn_fdot2_f32_bf16(__builtin_bit_cast(bf16x2_t, a), __builtin_bit_cast(bf16x2_t, b), acc, false); }
__device__ __forceinline__ float wave_sum(float v) {
#pragma unroll
    for (int o = 1; o < 64; o <<= 1) v += __shfl_xor(v, o);
    return v;
}
__device__ __forceinline__ float wave_max(float v) {
#pragma unroll
    for (int o = 1; o < 64; o <<= 1) v = fmaxf(v, __shfl_xor(v, o));
    return v;
}
typedef float f32x2_t __attribute__((ext_vector_type(2)));
typedef float f32x16 __attribute__((ext_vector_type(16)));
__device__ __forceinline__ unsigned cvtpk(float lo, float hi) { f32x2_t v = {lo, hi}; bf16x2_t b = __builtin_convertvector(v, bf16x2_t); return __builtin_bit_cast(unsigned, b); }
__device__ __forceinline__ float sigmoidf_(float v) { return 1.0f / (1.0f + __expf(-v)); }

#define DPPF(oldv, v, ctrl, rmask) __builtin_bit_cast(float, __builtin_amdgcn_update_dpp(__builtin_bit_cast(int, (float)(oldv)), __builtin_bit_cast(int, (float)(v)), ctrl, rmask, 0xf, false))
__device__ __forceinline__ float scan_sum64(float v) {
    v += DPPF(0.f, v, 0x111, 0xf); v += DPPF(0.f, v, 0x112, 0xf); v += DPPF(0.f, v, 0x114, 0xf); v += DPPF(0.f, v, 0x118, 0xf);
    v += DPPF(0.f, v, 0x142, 0xa); v += DPPF(0.f, v, 0x143, 0xc);
    return v;
}
__device__ __forceinline__ float scan_max64(float v) {
    v = fmaxf(v, DPPF(-INFINITY, v, 0x111, 0xf)); v = fmaxf(v, DPPF(-INFINITY, v, 0x112, 0xf)); v = fmaxf(v, DPPF(-INFINITY, v, 0x114, 0xf)); v = fmaxf(v, DPPF(-INFINITY, v, 0x118, 0xf));
    v = fmaxf(v, DPPF(-INFINITY, v, 0x142, 0xa)); v = fmaxf(v, DPPF(-INFINITY, v, 0x143, 0xc));
    return v;
}
__device__ __forceinline__ float lane63(float v) { return __builtin_bit_cast(float, __builtin_amdgcn_readlane(__builtin_bit_cast(int, v), 63)); }
__device__ __forceinline__ float wave_sum_u(float v) { return lane63(scan_sum64(v)); }

enum { EPI_ROUTE = 1, EPI_MERGE_A = 2, EPI_MERGE_B = 3, EPI_OUTPROJ = 4, EPI_PQ = 5, EPI_MERGE = 6 };
template <int MODE> struct Epi {
    static constexpr bool PERM = true, AFTER_DRAIN = false, TWO_PASS = (MODE == EPI_MERGE);
    unsigned char* ws; const float* x; float* out; int part = 0;
    __device__ __forceinline__ void mid(pg8::f32x4 (&acc)[2][2][4][2], const pg8::Unit& u, int wr, int wc, int fr, int fq) const {
        using pg8::u32x4;
        const int row0 = u.pm * 256 + wr * 64 + fr, colw = 256 * u.pn + wc * 32 + 8 * fq;
#pragma unroll
        for (int ai = 0; ai < 2; ++ai)
#pragma unroll
            for (int m = 0; m < 4; ++m) {
                const int row = row0 + ai * 128 + m * 16;
#pragma unroll
                for (int bj = 0; bj < 2; ++bj) {
                    typedef unsigned u32x2_t __attribute__((ext_vector_type(2)));
                    const unsigned char* gp = (const unsigned char*)(ws + WS_GAB) + (size_t)row * 2048 + colw + bj * 128;
                    const u32x2_t ga = *(const u32x2_t*)gp, gb = *(const u32x2_t*)(gp + 1024);
                    const f32x2_t a0 = __builtin_amdgcn_cvt_pk_f32_fp8(ga.x, false), a1 = __builtin_amdgcn_cvt_pk_f32_fp8(ga.x, true), a2 = __builtin_amdgcn_cvt_pk_f32_fp8(ga.y, false), a3 = __builtin_amdgcn_cvt_pk_f32_fp8(ga.y, true);
                    const f32x2_t b0 = __builtin_amdgcn_cvt_pk_f32_fp8(gb.x, false), b1 = __builtin_amdgcn_cvt_pk_f32_fp8(gb.x, true), b2 = __builtin_amdgcn_cvt_pk_f32_fp8(gb.y, false), b3 = __builtin_amdgcn_cvt_pk_f32_fp8(gb.y, true);
                    acc[ai][bj][m][0][0] *= a0.x * __builtin_amdgcn_rcpf(b0.x); acc[ai][bj][m][0][1] *= a0.y * __builtin_amdgcn_rcpf(b0.y);
                    acc[ai][bj][m][0][2] *= a1.x * __builtin_amdgcn_rcpf(b1.x); acc[ai][bj][m][0][3] *= a1.y * __builtin_amdgcn_rcpf(b1.y);
                    acc[ai][bj][m][1][0] *= a2.x * __builtin_amdgcn_rcpf(b2.x); acc[ai][bj][m][1][1] *= a2.y * __builtin_amdgcn_rcpf(b2.y);
                    acc[ai][bj][m][1][2] *= a3.x * __builtin_amdgcn_rcpf(b3.x); acc[ai][bj][m][1][3] *= a3.y * __builtin_amdgcn_rcpf(b3.y);
                }
            }
    }
    __device__ __forceinline__ void operator()(const pg8::f32x4 (&acc)[2][2][4][2], const pg8::Unit& u, int wr, int wc, int fr, int fq) const {
        using pg8::f32x4; using pg8::u32x4; using pg8::cvt_pk_bf16;
        const int row0 = u.pm * 256 + wr * 64 + fr;
        const int colw = wc * 32 + 8 * fq;
        unsigned short* obase = nullptr; int ldc = 0, coff = 0; bool sig = false, gab8 = false; float qsc = 1.0f;
        if (MODE == EPI_ROUTE) {
            const int pn = u.pn;
            if (part == 2) {
                qsc = 1.0f / WQ_SCALE;
                if (pn < 6) { obase = (unsigned short*)(ws + WS_QKVA); ldc = 1536; coff = 256 * pn; }
                else if (pn < 10) { obase = (unsigned short*)(ws + WS_QKB); ldc = 1024; coff = 256 * (pn - 6); }
                else if (pn < 12) { obase = (unsigned short*)(ws + WS_VB); ldc = 512; coff = 256 * (pn - 10); }
                else if (pn < 14) { obase = (unsigned short*)(ws + WS_OB); ldc = 512; coff = 256 * (pn - 12); sig = true; }
                else { obase = (unsigned short*)(ws + WS_GAB); ldc = 2048; coff = 256 * (pn - 14); sig = true; gab8 = true; }
            } else if (part == 0) {
                if (pn < 4) { obase = (unsigned short*)(ws + WS_QKVA); ldc = 1536; coff = 256 * pn; }
                else { obase = (unsigned short*)(ws + WS_QKB); ldc = 1024; coff = 256 * (pn - 4); }
            } else {
                qsc = 1.0f / WQ_SCALE;
                if (pn < 2) { obase = (unsigned short*)(ws + WS_QKVA); ldc = 1536; coff = 1024 + 256 * pn; }
                else if (pn < 4) { obase = (unsigned short*)(ws + WS_VB); ldc = 512; coff = 256 * (pn - 2); }
                else if (pn < 6) { obase = (unsigned short*)(ws + WS_OB); ldc = 512; coff = 256 * (pn - 4); sig = true; }
                else { obase = (unsigned short*)(ws + WS_GAB); ldc = 2048; coff = 256 * (pn - 6); sig = true; gab8 = true; }
            }
        } else if (MODE == EPI_MERGE_A || MODE == EPI_MERGE_B || MODE == EPI_MERGE) { obase = (unsigned short*)(ws + WS_Y); ldc = 1024; coff = 256 * u.pn; }
        else if (MODE == EPI_PQ) { obase = (unsigned short*)(ws + WS_PQ); ldc = 2048; coff = 256 * u.pn; }
        else { coff = 256 * u.pn; }
#pragma unroll
        for (int ai = 0; ai < 2; ++ai)
#pragma unroll
            for (int m = 0; m < 4; ++m) {
                const int row = row0 + ai * 128 + m * 16;
#pragma unroll
                for (int bj = 0; bj < 2; ++bj) {
                    const int col = coff + bj * 128 + colw;
                    f32x4 v0 = acc[ai][bj][m][0], v1 = acc[ai][bj][m][1];
                    if (MODE == EPI_ROUTE) {
                        v0 = v0 * qsc; v1 = v1 * qsc;
                        if (sig) {
#pragma unroll
                            for (int e = 0; e < 4; ++e) { v0[e] = sigmoidf_(v0[e]); v1[e] = sigmoidf_(v1[e]); }
                        }
                    } else if (MODE == EPI_MERGE) {
                        typedef unsigned u32x2_t __attribute__((ext_vector_type(2)));
                        const u32x2_t g = *(const u32x2_t*)((const unsigned char*)(ws + WS_GAB) + (size_t)row * 2048 + 1024 + col);
                        const f32x2_t b0 = __builtin_amdgcn_cvt_pk_f32_fp8(g.x, false), b1 = __builtin_amdgcn_cvt_pk_f32_fp8(g.x, true), b2 = __builtin_amdgcn_cvt_pk_f32_fp8(g.y, false), b3 = __builtin_amdgcn_cvt_pk_f32_fp8(g.y, true);
                        v0[0] *= b0.x; v0[1] *= b0.y; v0[2] *= b1.x; v0[3] *= b1.y;
                        v1[0] *= b2.x; v1[1] *= b2.y; v1[2] *= b3.x; v1[3] *= b3.y;
                    } else if (MODE == EPI_MERGE_A || MODE == EPI_MERGE_B) {
                        const u32x4 g = *(const u32x4*)((const unsigned short*)(ws + WS_GAB) + (size_t)row * 2048 + (MODE == EPI_MERGE_B ? 1024 : 0) + col);
                        v0[0] *= bflo(g.x); v0[1] *= bfhi(g.x); v0[2] *= bflo(g.y); v0[3] *= bfhi(g.y);
                        v1[0] *= bflo(g.z); v1[1] *= bfhi(g.z); v1[2] *= bflo(g.w); v1[3] *= bfhi(g.w);
                        if (MODE == EPI_MERGE_B) {
                            const u32x4 y = *(const u32x4*)(obase + (size_t)row * ldc + col);
                            v0[0] += bflo(y.x); v0[1] += bfhi(y.x); v0[2] += bflo(y.y); v0[3] += bfhi(y.y);
                            v1[0] += bflo(y.z); v1[1] += bfhi(y.z); v1[2] += bflo(y.w); v1[3] += bfhi(y.w);
                        }
                    }
                    if (MODE == EPI_OUTPROJ) {
                        const int b = row >> 12;
                        const float* gt = (const float*)(ws + WS_MOD) + b * 6144 + 2048 + col;
                        const float* xr = x + (size_t)row * 1024 + col;
                        const f32x4 g0 = *(const f32x4*)gt, g1 = *(const f32x4*)(gt + 4), x0 = *(const f32x4*)xr, x1 = *(const f32x4*)(xr + 4);
                        const f32x4 r0 = x0 + g0 * v0, r1 = x1 + g1 * v1;
                        u32x4 w; w.x = cvtpk(r0[0], r0[1]); w.y = cvtpk(r0[2], r0[3]); w.z = cvtpk(r1[0], r1[1]); w.w = cvtpk(r1[2], r1[3]);
                        *(u32x4*)((unsigned short*)(ws + WS_X1) + (size_t)row * 1024 + col) = w;
                    } else if (MODE == EPI_ROUTE && gab8) {
                        typedef unsigned u32x2_t __attribute__((ext_vector_type(2)));
#pragma unroll
                        for (int e = 0; e < 4; ++e) { v0[e] = fmaxf(v0[e], 0.015625f); v1[e] = fmaxf(v1[e], 0.015625f); }
                        int p0 = __builtin_amdgcn_cvt_pk_fp8_f32(v0[0], v0[1], 0, false); p0 = __builtin_amdgcn_cvt_pk_fp8_f32(v0[2], v0[3], p0, true);
                        int p1 = __builtin_amdgcn_cvt_pk_fp8_f32(v1[0], v1[1], 0, false); p1 = __builtin_amdgcn_cvt_pk_fp8_f32(v1[2], v1[3], p1, true);
                        *(u32x2_t*)((unsigned char*)obase + (size_t)row * 2048 + col) = (u32x2_t){(unsigned)p0, (unsigned)p1};
                    } else {
                        u32x4 w; w.x = cvt_pk_bf16(v0[0], v0[1]); w.y = cvt_pk_bf16(v0[2], v0[3]); w.z = cvt_pk_bf16(v1[0], v1[1]); w.w = cvt_pk_bf16(v1[2], v1[3]);
                        *(u32x4*)(obase + (size_t)row * ldc + col) = w;
                    }
                }
            }
    }
};

__device__ __forceinline__ void p0_transpose_item(const float* W, int K, int N, int pitch, unsigned short* WT, int row_off, float* scr, int item, int lane) {
    const int nblk = N / 32, kb = item / nblk, nb = item % nblk, k0 = 64 * kb, n0 = 32 * nb;
#pragma unroll 8
    for (int i = 0; i < 32; ++i) { const int kk = 2 * i + (lane >> 5); scr[kk * 33 + (lane & 31)] = W[(size_t)(k0 + kk) * pitch + n0 + (lane & 31)]; }
    LDS_WAIT(); asm volatile("" ::: "memory");
    const int c = lane & 7;
#pragma unroll
    for (int j = 0; j < 4; ++j) { const int n = (lane >> 3) + 8 * j; const float* s = scr + (8 * c) * 33 + n;
        v4u o; o.x = pk2(s[0 * 33], s[1 * 33]); o.y = pk2(s[2 * 33], s[3 * 33]); o.z = pk2(s[4 * 33], s[5 * 33]); o.w = pk2(s[6 * 33], s[7 * 33]);
        *(v4u*)(WT + (size_t)(row_off + n0 + n) * K + k0 + 8 * c) = o; }
    LDS_WAIT(); asm volatile("" ::: "memory");
}

__device__ __forceinline__ void p0_transpose_item_fp8(const float* W, int K, int N, int pitch, unsigned char* WT8, int row_off, float* scr, int item, int lane, float scale) {
    const int nblk = N / 32, kb = item / nblk, nb = item % nblk, k0 = 64 * kb, n0 = 32 * nb;
#pragma unroll 8
    for (int i = 0; i < 32; ++i) { const int kk = 2 * i + (lane >> 5); scr[kk * 33 + (lane & 31)] = W[(size_t)(k0 + kk) * pitch + n0 + (lane & 31)] * scale; }
    LDS_WAIT(); asm volatile("" ::: "memory");
    const int c = lane & 7;
#pragma unroll
    for (int j = 0; j < 4; ++j) { const int n = (lane >> 3) + 8 * j; const float* sp = scr + (8 * c) * 33 + n;
        typedef unsigned u32x2_t __attribute__((ext_vector_type(2)));
        int p0 = __builtin_amdgcn_cvt_pk_fp8_f32(sp[0 * 33], sp[1 * 33], 0, false); p0 = __builtin_amdgcn_cvt_pk_fp8_f32(sp[2 * 33], sp[3 * 33], p0, true);
        int p1 = __builtin_amdgcn_cvt_pk_fp8_f32(sp[4 * 33], sp[5 * 33], 0, false); p1 = __builtin_amdgcn_cvt_pk_fp8_f32(sp[6 * 33], sp[7 * 33], p1, true);
        *(u32x2_t*)(WT8 + (size_t)(row_off + n0 + n) * K + k0 + 8 * c) = (u32x2_t){(unsigned)p0, (unsigned)p1}; }
    LDS_WAIT(); asm volatile("" ::: "memory");
}
__device__ __forceinline__ void p0_cvt_item(const float* src, unsigned short* dst, size_t item, int lane) {
    const f32x4* s = (const f32x4*)(src + item * 512) + lane * 2;
    const f32x4 a = s[0], b = s[1];
    v4u o; o.x = pk2(a.x, a.y); o.y = pk2(a.z, a.w); o.z = pk2(b.x, b.y); o.w = pk2(b.z, b.w);
    *((v4u*)(dst + item * 512) + lane) = o;
}

__device__ __forceinline__ void p0_fp8_row(const float* src, unsigned char* dst, float* sc, int row, int lane) {
    const f32x4* sp = (const f32x4*)(src + (size_t)row * 1024) + lane * 4;
    f32x4 v[4]; float mx = 0.f;
#pragma unroll
    for (int j = 0; j < 4; ++j) { v[j] = sp[j]; mx = fmaxf(mx, fmaxf(fmaxf(fabsf(v[j].x), fabsf(v[j].y)), fmaxf(fabsf(v[j].z), fabsf(v[j].w)))); }
    mx = wave_max(mx);
    const float scale = mx > 0.f ? 240.0f / mx : 1.0f;
    if (lane == 0) sc[row] = mx > 0.f ? mx * (1.0f / 240.0f) : 1.0f;
    v4u o; unsigned w[4];
#pragma unroll
    for (int j = 0; j < 4; ++j) { int p = __builtin_amdgcn_cvt_pk_fp8_f32(v[j].x * scale, v[j].y * scale, 0, false); p = __builtin_amdgcn_cvt_pk_fp8_f32(v[j].z * scale, v[j].w * scale, p, true); w[j] = (unsigned)p; }
    o.x = w[0]; o.y = w[1]; o.z = w[2]; o.w = w[3];
    *((v4u*)(dst + (size_t)row * 1024) + lane) = o;
}

__device__ __forceinline__ void p0_fp4_row(const float* src, unsigned char* dst, float* sc, int row, int lane) {
    const f32x4* sp = (const f32x4*)(src + (size_t)row * 1024) + lane * 4;
    f32x4 v[4]; float mx = 0.f;
#pragma unroll
    for (int j = 0; j < 4; ++j) { v[j] = sp[j]; mx = fmaxf(mx, fmaxf(fmaxf(fabsf(v[j].x), fabsf(v[j].y)), fmaxf(fabsf(v[j].z), fabsf(v[j].w)))); }
    mx = wave_max(mx);
    const float scale = mx > 0.f ? 6.0f / mx : 1.0f;
    if (lane == 0) sc[row] = mx > 0.f ? mx * (1.0f / 6.0f) : 1.0f;
    unsigned w0 = 0u, w1 = 0u;
    w0 = __builtin_amdgcn_cvt_scalef32_pk_fp4_f32(w0, v[0].x * scale, v[0].y * scale, 1.0f, 0); w0 = __builtin_amdgcn_cvt_scalef32_pk_fp4_f32(w0, v[0].z * scale, v[0].w * scale, 1.0f, 1);
    w0 = __builtin_amdgcn_cvt_scalef32_pk_fp4_f32(w0, v[1].x * scale, v[1].y * scale, 1.0f, 2); w0 = __builtin_amdgcn_cvt_scalef32_pk_fp4_f32(w0, v[1].z * scale, v[1].w * scale, 1.0f, 3);
    w1 = __builtin_amdgcn_cvt_scalef32_pk_fp4_f32(w1, v[2].x * scale, v[2].y * scale, 1.0f, 0); w1 = __builtin_amdgcn_cvt_scalef32_pk_fp4_f32(w1, v[2].z * scale, v[2].w * scale, 1.0f, 1);
    w1 = __builtin_amdgcn_cvt_scalef32_pk_fp4_f32(w1, v[3].x * scale, v[3].y * scale, 1.0f, 2); w1 = __builtin_amdgcn_cvt_scalef32_pk_fp4_f32(w1, v[3].z * scale, v[3].w * scale, 1.0f, 3);
    typedef unsigned u32x2_t __attribute__((ext_vector_type(2)));
    *((u32x2_t*)(dst + (size_t)row * 512) + lane) = (u32x2_t){w0, w1};
}
__device__ __forceinline__ void p0_prologue(Frame& F) {
    if (blockIdx.x < 96) {
        float* sc = (float*)F.lds;
        float* red = (float*)(F.lds + 65536);
        const float* c = F.in[1]; const float* w_ada = F.in[2]; const float* b_ada = F.in[3];
        for (int i = F.tid; i < 16 * 1024; i += 512) { const float v = c[i]; sc[i] = v / (1.0f + __expf(-v)); }
        __syncthreads();
        const int n = blockIdx.x * 64 + F.lane;
        float acc[16];
#pragma unroll
        for (int b = 0; b < 16; ++b) acc[b] = 0.f;
        for (int k0 = F.wave * 128; k0 < F.wave * 128 + 128; k0 += 16) {
            float wv[16];
#pragma unroll
            for (int i = 0; i < 16; ++i) wv[i] = w_ada[(size_t)(k0 + i) * 6144 + n];
#pragma unroll
            for (int i = 0; i < 16; ++i)
#pragma unroll
                for (int b = 0; b < 16; ++b) acc[b] += sc[b * 1024 + k0 + i] * wv[i];
        }
#pragma unroll
        for (int b = 0; b < 16; ++b) red[(F.wave * 16 + b) * 64 + F.lane] = acc[b];
        __syncthreads();
        float* MOD = (float*)(F.ws + WS_MOD);
        for (int idx = F.tid; idx < 16 * 64; idx += 512) { const int b = idx >> 6, l = idx & 63; float s = b_ada[blockIdx.x * 64 + l];
#pragma unroll
            for (int w = 0; w < 8; ++w) s += red[(w * 16 + b) * 64 + l];
            MOD[b * 6144 + blockIdx.x * 64 + l] = s; }
        __syncthreads();
    }
    float* scr = (float*)(F.lds + F.wave * 16384);
#if PROJ_ALL_FP8
    for (int it = F.gw; it < 16 * 112 + 16 * 64; it += F.NGW) {
        if (it < 16 * 112) p0_transpose_item_fp8(F.in[5], 1024, 3584, IN_COLS, F.ws + WS_WINQ, 0, scr, it, F.lane, WQ_SCALE);
        else p0_transpose_item_fp8(F.in[5] + 3592, 1024, 2048, IN_COLS, F.ws + WS_WINQ, 3584, scr, it - 16 * 112, F.lane, WQ_SCALE);
    }
#else
    constexpr int I_B = 16 * 32, I_Q1 = 16 * 16, I_Q4 = 16 * 64;
    for (int it = F.gw; it < 2 * I_B + 3 * I_Q1 + I_Q4; it += F.NGW) {
        int r = it;
        if (r < I_B) { p0_transpose_item(F.in[5], 1024, 1024, IN_COLS, (unsigned short*)(F.ws + WS_WIN), 0, scr, r, F.lane); continue; } r -= I_B;
        if (r < I_B) { p0_transpose_item(F.in[5] + 1536, 1024, 1024, IN_COLS, (unsigned short*)(F.ws + WS_WIN), 1024, scr, r, F.lane); continue; } r -= I_B;
        if (r < I_Q1) { p0_transpose_item_fp8(F.in[5] + 1024, 1024, 512, IN_COLS, F.ws + WS_WINQ, 0, scr, r, F.lane, WQ_SCALE); continue; } r -= I_Q1;
        if (r < I_Q1) { p0_transpose_item_fp8(F.in[5] + 2560, 1024, 512, IN_COLS, F.ws + WS_WINQ, 512, scr, r, F.lane, WQ_SCALE); continue; } r -= I_Q1;
        if (r < I_Q1) { p0_transpose_item_fp8(F.in[5] + 3072, 1024, 512, IN_COLS, F.ws + WS_WINQ, 1024, scr, r, F.lane, WQ_SCALE); continue; } r -= I_Q1;
        p0_transpose_item_fp8(F.in[5] + 3592, 1024, 2048, IN_COLS, F.ws + WS_WINQ, 1536, scr, r, F.lane, WQ_SCALE);
    }
#endif
    { float* W8 = (float*)(F.ws + WS_W8); const int g = blockIdx.x * 512 + F.tid; if (g < 8192) { const int j = g >> 10, k = g & 1023; W8[g] = F.in[5][(size_t)k * IN_COLS + 3584 + j]; } }
}

__device__ __forceinline__ void late_weight_copies(Frame& F, int w0, int nw) {
    float* scr = (float*)(F.lds + F.wave * 16384);
    constexpr int I_A = 8 * 32, I_B = 8 * 32, I_O = 16 * 32, I_PQ = 16 * 64;
    for (int it = w0; it < I_A + I_B + I_O + I_PQ; it += nw) {
        int r = it;
        if (r < I_A) { p0_transpose_item(F.in[12], 512, 1024, 1024, (unsigned short*)(F.ws + WS_WA), 0, scr, r, F.lane); continue; } r -= I_A;
        if (r < I_B) { p0_transpose_item(F.in[13], 512, 1024, 1024, (unsigned short*)(F.ws + WS_WB), 0, scr, r, F.lane); continue; } r -= I_B;
        if (r < I_O) { p0_transpose_item(F.in[14], 1024, 1024, 1024, (unsigned short*)(F.ws + WS_WOUT), 0, scr, r, F.lane); continue; } r -= I_O;
        p0_transpose_item(F.in[16], 1024, 2048, 2048, (unsigned short*)(F.ws + WS_WPQ), 0, scr, r, F.lane);
    }
    for (int it = w0; it < 262144 / 512; it += nw) p0_cvt_item(F.in[17], (unsigned short*)(F.ws + WS_SUBK), (size_t)it, F.lane);
    for (int it = w0; it < 2 * 16384; it += nw) {
        if (it < 16384) p0_fp4_row(F.in[18], F.ws + WS_U, (float*)(F.ws + WS_USC), it, F.lane);
        else p0_fp4_row(F.in[19], F.ws + WS_V, (float*)(F.ws + WS_VSC), it - 16384, F.lane);
    }
}

template <bool WITH_GATES, bool BF16_IN = false>
__device__ __forceinline__ void norm_mod_rows(Frame& F, const float* xin, const float* gvec, int sh_off, int sc_off, unsigned short* hout) {
    const float* MOD = (const float*)(F.ws + WS_MOD);
    const float* W8 = (const float*)(F.ws + WS_W8);
    LAS float* w8l = (LAS float*)F.lds;
    if (WITH_GATES) { for (int i = F.tid; i < 8192; i += 512) w8l[i] = W8[i]; __syncthreads(); }
    const int RPW = T / F.NGW;
    const int row0 = F.gw * RPW, b = row0 >> 12;
    LAS f32x4* GmL = (LAS f32x4*)(w8l + 8192); LAS f32x4* ShL = GmL + 256;
    if (F.tid < 256) { const f32x4 g = ((const f32x4*)gvec)[F.tid], sc = ((const f32x4*)(MOD + b * 6144 + sc_off))[F.tid]; GmL[F.tid] = g * (sc + 1.0f); ShL[F.tid] = ((const f32x4*)(MOD + b * 6144 + sh_off))[F.tid]; }
    __syncthreads();
    for (int rg = 0; rg < RPW; rg += 4) {
        f32x4 v[4][4];
#pragma unroll
        for (int r = 0; r < 4; ++r) {
            if (BF16_IN) { typedef unsigned u32x2_t __attribute__((ext_vector_type(2)));
                const u32x2_t* xr = (const u32x2_t*)((const unsigned short*)xin + (size_t)(row0 + rg + r) * 1024) + F.lane;
#pragma unroll
                for (int j = 0; j < 4; ++j) { const u32x2_t w = xr[64 * j]; v[r][j] = (f32x4){bflo(w.x), bfhi(w.x), bflo(w.y), bfhi(w.y)}; }
            } else { const f32x4* xr = (const f32x4*)(xin + (size_t)(row0 + rg + r) * 1024) + F.lane;
#pragma unroll
                for (int j = 0; j < 4; ++j) v[r][j] = xr[64 * j]; } }
#pragma unroll
        for (int r = 0; r < 4; ++r) {
            __builtin_amdgcn_sched_barrier(0);
            const int row = row0 + rg + r;
            float s = 0.f;
#pragma unroll
            for (int j = 0; j < 4; ++j) s += (v[r][j].x * v[r][j].x + v[r][j].y * v[r][j].y) + (v[r][j].z * v[r][j].z + v[r][j].w * v[r][j].w);
            const float rstd = rsqrtf(wave_sum_u(s) * (1.0f / 1024.0f) + EPS);
            float gd[8];
#pragma unroll
            for (int q = 0; q < 8; ++q) gd[q] = 0.f;
            unsigned long long* o8 = (unsigned long long*)(hout + (size_t)row * 1024) + F.lane;
#pragma unroll
            for (int j = 0; j < 4; ++j) {
                const int k4 = F.lane + 64 * j;
                const f32x4 h = (v[r][j] * rstd) * GmL[k4] + ShL[k4];
                if (WITH_GATES) {
#pragma unroll
                    for (int q = 0; q < 8; ++q) { const f32x4 w = ((const LAS f32x4*)(w8l + q * 1024))[k4]; gd[q] += (h.x * w.x + h.y * w.y) + (h.z * w.z + h.w * w.w); }
                }
                if (!(WITH_GATES && PROJ_ALL_FP8)) o8[64 * j] = (unsigned long long)pk2(h.x, h.y) | ((unsigned long long)pk2(h.z, h.w) << 32);
                if (WITH_GATES) { int p8 = __builtin_amdgcn_cvt_pk_fp8_f32(h.x, h.y, 0, false); p8 = __builtin_amdgcn_cvt_pk_fp8_f32(h.z, h.w, p8, true);
                    ((unsigned*)(F.ws + WS_H1Q + (size_t)row * 1024))[k4] = (unsigned)p8; }
            }
            if (WITH_GATES) {
#pragma unroll
                for (int q = 0; q < 8; ++q) gd[q] = wave_sum_u(gd[q]);
                if (F.lane == 0) { float* G = (float*)(F.ws + WS_GATES) + (size_t)row * 8;
#pragma unroll
                    for (int q = 0; q < 8; ++q) G[q] = gd[q] + (q < 4 ? F.in[8][q] : F.in[9][q - 4]); }
            }
        }
    }
}

__device__ __forceinline__ void attn_ref_item(Frame& F, int t, int h) {
    const unsigned short* QKVA = (const unsigned short*)(F.ws + WS_QKVA);
    const float* rel_bias = F.in[10];
    const int lane = F.lane, b = t >> 12, pos = t & 4095, j = pos >> 6;
    const v4u* qrow = (const v4u*)(QKVA + (size_t)t * 1536 + h * 64);
    v4u qv[8];
#pragma unroll
    for (int i = 0; i < 8; ++i) qv[i] = qrow[i];
    float s[9]; float m = -INFINITY;
#pragma unroll
    for (int c = 0; c < 9; ++c) {
        const int kc = j - 8 + c; s[c] = -INFINITY;
        if (kc >= 0) {
            const int kpos = kc * 64 + lane;
            const v4u* krow = (const v4u*)(QKVA + (size_t)(b * 4096 + kpos) * 1536 + 512 + h * 64);
            float d = 0.f;
#pragma unroll
            for (int i = 0; i < 8; ++i) { const v4u kv = krow[i]; d = dot2c(d, qv[i].x, kv.x); d = dot2c(d, qv[i].y, kv.y); d = dot2c(d, qv[i].z, kv.z); d = dot2c(d, qv[i].w, kv.w); }
            int rel = pos - kpos; rel = rel > 128 ? 128 : rel;
            s[c] = d * 0.125f + rel_bias[h * 257 + rel + 128];
            m = fmaxf(m, s[c]);
        }
    }
    m = wave_max(m);
    float l = 0.f;
#pragma unroll
    for (int c = 0; c < 9; ++c) { s[c] = (j - 8 + c >= 0) ? __expf(s[c] - m) : 0.f; l += s[c]; }
    l = wave_sum(l);
    float o = 0.f;
#pragma unroll
    for (int c = 0; c < 9; ++c) {
        const int kc = j - 8 + c;
        if (kc >= 0) {
            const unsigned short* vcol = QKVA + (size_t)(b * 4096 + kc * 64) * 1536 + 1024 + h * 64 + lane;
#pragma unroll 8
            for (int kk = 0; kk < 64; ++kk) { const float pk = __shfl(s[c], kk); o += pk * bf2f(vcol[(size_t)kk * 1536]); }
        }
    }
    ((unsigned short*)(F.ws + WS_YA))[(size_t)t * 512 + h * 64 + lane] = (unsigned short)f2bf(o / l);
}


constexpr int AT_KP = 144, AT_VP = 136;
constexpr int AT_K0 = 0, AT_V0 = 2 * 64 * AT_KP, AT_BIAS = AT_V0 + 2 * 64 * AT_VP;
__device__ __forceinline__ void attn_unit(Frame& F, int b, int h, int j0) {
    const unsigned short* QKVA = (const unsigned short*)(F.ws + WS_QKVA);
    LAS unsigned char* L = (LAS unsigned char*)F.lds;
    LAS float* biasL = (LAS float*)(L + AT_BIAS);
    const int tid = F.tid, lane = F.lane, wave = F.wave, hh = lane >> 5, q32 = lane & 31;
    const int c = j0 + (wave >> 1), qi = 32 * (wave & 1) + q32;
    const size_t tq = (size_t)b * SEQ + c * 64 + qi;
    constexpr float LOG2E = 1.4426950408889634f, C2 = 0.125f * LOG2E;
    if (tid < 257) biasL[tid] = F.in[10][h * 257 + tid] * LOG2E;
    bf16x8 qf[4];
#pragma unroll
    for (int s = 0; s < 4; ++s) qf[s] = *(const bf16x8*)(QKVA + tq * 1536 + h * 64 + 16 * s + 8 * hh);
    const int kc_lo = (j0 - 8 > 0) ? j0 - 8 : 0, nsteps = j0 + 3 - kc_lo + 1;
    const int skey = tid >> 3, sch = tid & 7;
    const unsigned short* ksrc = QKVA + ((size_t)b * SEQ + skey) * 1536 + 512 + h * 64 + sch * 8;
    v4u kreg = *(const v4u*)(ksrc + (size_t)kc_lo * 64 * 1536), vreg = *(const v4u*)(ksrc + (size_t)kc_lo * 64 * 1536 + 512);
    auto stage_write = [&](int buf) {
        *(LAS v4u*)(L + AT_K0 + buf * 64 * AT_KP + skey * AT_KP + sch * 16) = kreg;
        LAS unsigned short* vt = (LAS unsigned short*)(L + AT_V0 + buf * 64 * AT_VP) + skey;
        const unsigned w[4] = {vreg.x, vreg.y, vreg.z, vreg.w};
#pragma unroll
        for (int j = 0; j < 4; ++j) { vt[(8 * sch + 2 * j) * (AT_VP / 2)] = (unsigned short)(w[j] & 0xffffu); vt[(8 * sch + 2 * j + 1) * (AT_VP / 2)] = (unsigned short)(w[j] >> 16); }
    };
    stage_write(0);
    __syncthreads();
    float m_run = -INFINITY, l_run = 0.f;
    f32x16 o0 = {}, o1 = {};
    for (int i = 0; i < nsteps; ++i) {
        const int kc = kc_lo + i, buf = i & 1;
        if (i + 1 < nsteps) { kreg = *(const v4u*)(ksrc + (size_t)(kc + 1) * 64 * 1536); vreg = *(const v4u*)(ksrc + (size_t)(kc + 1) * 64 * 1536 + 512); }
        const int dch = c - kc;
        if (dch >= 0 && dch <= 8) {
            const LAS unsigned char* Kb = L + AT_K0 + buf * 64 * AT_KP + q32 * AT_KP + 16 * hh;
            f32x16 p0 = {}, p1 = {};
#pragma unroll
            for (int s = 0; s < 4; ++s) {
                const bf16x8 a0 = *(const LAS bf16x8*)(Kb + 32 * s), a1 = *(const LAS bf16x8*)(Kb + 32 * AT_KP + 32 * s);
                p0 = __builtin_amdgcn_mfma_f32_32x32x16_bf16(a0, qf[s], p0, 0, 0, 0);
                p1 = __builtin_amdgcn_mfma_f32_32x32x16_bf16(a1, qf[s], p1, 0, 0, 0);
            }
            float mx = -INFINITY;
            if (dch >= 3) {
                const float bc = biasL[256];
#pragma unroll
                for (int r = 0; r < 16; ++r) { p0[r] = p0[r] * C2 + bc; p1[r] = p1[r] * C2 + bc; mx = fmaxf(mx, fmaxf(p0[r], p1[r])); }
            } else {
                const int base = dch * 64 + qi - 4 * hh + 128;
#pragma unroll
                for (int r = 0; r < 16; ++r) { const int ki = (r & 3) + 8 * (r >> 2);
                    int i0 = base - ki, i1 = base - ki - 32; i0 = i0 > 256 ? 256 : i0; i1 = i1 > 256 ? 256 : i1;
                    p0[r] = p0[r] * C2 + biasL[i0]; p1[r] = p1[r] * C2 + biasL[i1]; mx = fmaxf(mx, fmaxf(p0[r], p1[r])); }
            }
            mx = fmaxf(mx, __shfl_xor(mx, 32));
            const float m_new = fmaxf(m_run, mx), alpha = __builtin_amdgcn_exp2f(m_run - m_new);
            m_run = m_new;
            float ls = 0.f;
#pragma unroll
            for (int r = 0; r < 16; ++r) { p0[r] = __builtin_amdgcn_exp2f(p0[r] - m_new); p1[r] = __builtin_amdgcn_exp2f(p1[r] - m_new); ls += p0[r] + p1[r]; }
            l_run = l_run * alpha + ls;
#pragma unroll
            for (int r = 0; r < 16; ++r) { o0[r] *= alpha; o1[r] *= alpha; }
            const LAS unsigned char* Vb = L + AT_V0 + buf * 64 * AT_VP + q32 * AT_VP + 8 * hh;
#pragma unroll
            for (int tt = 0; tt < 2; ++tt)
#pragma unroll
                for (int s = 0; s < 2; ++s) {
                    v4u pb;
                    if (tt == 0) { pb.x = cvtpk(p0[8 * s + 0], p0[8 * s + 1]); pb.y = cvtpk(p0[8 * s + 2], p0[8 * s + 3]); pb.z = cvtpk(p0[8 * s + 4], p0[8 * s + 5]); pb.w = cvtpk(p0[8 * s + 6], p0[8 * s + 7]); }
                    else { pb.x = cvtpk(p1[8 * s + 0], p1[8 * s + 1]); pb.y = cvtpk(p1[8 * s + 2], p1[8 * s + 3]); pb.z = cvtpk(p1[8 * s + 4], p1[8 * s + 5]); pb.w = cvtpk(p1[8 * s + 6], p1[8 * s + 7]); }
                    const bf16x8 bfrag = __builtin_bit_cast(bf16x8, pb);
                    const int koff = (32 * tt + 16 * s) * 2;
#pragma unroll
                    for (int et = 0; et < 2; ++et) {
                        typedef unsigned u32x2_t __attribute__((ext_vector_type(2)));
                        const u32x2_t lo = *(const LAS u32x2_t*)(Vb + et * 32 * AT_VP + koff), hi2 = *(const LAS u32x2_t*)(Vb + et * 32 * AT_VP + koff + 16);
                        v4u av; av.x = lo.x; av.y = lo.y; av.z = hi2.x; av.w = hi2.y;
                        const bf16x8 afrag = __builtin_bit_cast(bf16x8, av);
                        if (et == 0) o0 = __builtin_amdgcn_mfma_f32_32x32x16_bf16(afrag, bfrag, o0, 0, 0, 0);
                        else o1 = __builtin_amdgcn_mfma_f32_32x32x16_bf16(afrag, bfrag, o1, 0, 0, 0);
                    }
                }
        }
        if (i + 1 < nsteps) stage_write(buf ^ 1);
        __syncthreads();
    }
    const float lt = l_run + __shfl_xor(l_run, 32), inv = 1.0f / lt;
    unsigned short* yrow = (unsigned short*)(F.ws + WS_YA) + tq * 512 + h * 64 + 4 * hh;
#pragma unroll
    for (int g = 0; g < 4; ++g) {
        typedef unsigned u32x2_t __attribute__((ext_vector_type(2)));
        u32x2_t w0, w1;
        w0.x = cvtpk(o0[4 * g] * inv, o0[4 * g + 1] * inv); w0.y = cvtpk(o0[4 * g + 2] * inv, o0[4 * g + 3] * inv);
        w1.x = cvtpk(o1[4 * g] * inv, o1[4 * g + 1] * inv); w1.y = cvtpk(o1[4 * g + 2] * inv, o1[4 * g + 3] * inv);
        *(u32x2_t*)(yrow + 8 * g) = w0; *(u32x2_t*)(yrow + 32 + 8 * g) = w1;
    }
}


__device__ __forceinline__ void qk_conv_slice(Frame& F, int b, int h) {
    const unsigned short* QKB = (const unsigned short*)(F.ws + WS_QKB);
    unsigned short* QKC = (unsigned short*)(F.ws + WS_QKC);
    const int cg = F.tid & 31, cgp = (cg < 16 ? 16 * h + cg : 64 + 16 * h + (cg - 16));
    float wv[4][8], bv[8];
#pragma unroll
    for (int jj = 0; jj < 4; ++jj)
#pragma unroll
        for (int c = 0; c < 8; ++c) wv[jj][c] = F.in[6][jj * 1024 + 8 * cgp + c];
#pragma unroll
    for (int c = 0; c < 8; ++c) bv[c] = F.in[7][8 * cgp + c];
    const float osc = (cgp >= 64) ? 0.08838834764831845f : 1.0f;
    for (int rq4 = F.tid >> 5; rq4 < SEQ / 4; rq4 += 16) {
        const size_t r0 = (size_t)b * SEQ + rq4 * 4; const int pos0 = rq4 * 4;
        v4u rq[7];
#pragma unroll
        for (int r = 0; r < 7; ++r) rq[r] = (pos0 - 3 + r >= 0) ? *(const v4u*)(QKB + (r0 - 3 + r) * 1024 + 8 * cgp) : (v4u){0u, 0u, 0u, 0u};
#pragma unroll
        for (int i = 0; i < 4; ++i) {
            float o[8];
#pragma unroll
            for (int c = 0; c < 8; ++c) o[c] = bv[c];
#pragma unroll
            for (int jj = 0; jj < 4; ++jj) { const v4u u = rq[i + jj]; const unsigned w[4] = {u.x, u.y, u.z, u.w};
#pragma unroll
                for (int c2 = 0; c2 < 4; ++c2) { o[2 * c2] += wv[jj][2 * c2] * bflo(w[c2]); o[2 * c2 + 1] += wv[jj][2 * c2 + 1] * bfhi(w[c2]); } }
#pragma unroll
            for (int c = 0; c < 8; ++c) o[c] = osc * o[c] / (1.0f + __expf(-o[c]));
            v4u w; w.x = cvtpk(o[0], o[1]); w.y = cvtpk(o[2], o[3]); w.z = cvtpk(o[4], o[5]); w.w = cvtpk(o[6], o[7]);
            *(v4u*)(QKC + (r0 + i) * 1024 + 8 * cgp) = w;
        }
    }
    asm volatile("s_waitcnt vmcnt(0)" ::: "memory");
    __syncthreads();
}
__device__ __forceinline__ void qk_conv_pass(Frame& F) {
    const unsigned short* QKB = (const unsigned short*)(F.ws + WS_QKB);
    unsigned short* QKC = (unsigned short*)(F.ws + WS_QKC);
    const int gtid = blockIdx.x * 512 + F.tid, cgp = gtid & 127, NTH = F.G * 512;
    float wv[4][8], bv[8];
#pragma unroll
    for (int jj = 0; jj < 4; ++jj)
#pragma unroll
        for (int c = 0; c < 8; ++c) wv[jj][c] = F.in[6][jj * 1024 + 8 * cgp + c];
#pragma unroll
    for (int c = 0; c < 8; ++c) bv[c] = F.in[7][8 * cgp + c];
    const float osc = (cgp >= 64) ? 0.08838834764831845f : 1.0f;
    for (int it = gtid; it < (T / 4) * 128; it += NTH) {
        const int rq4 = it >> 7; const size_t r0 = (size_t)rq4 * 4; const int pos0 = (int)(r0 & 4095);
        v4u rq[7];
#pragma unroll
        for (int r = 0; r < 7; ++r) rq[r] = (pos0 - 3 + r >= 0) ? *(const v4u*)(QKB + (r0 - 3 + r) * 1024 + 8 * cgp) : (v4u){0u, 0u, 0u, 0u};
#pragma unroll
        for (int i = 0; i < 4; ++i) {
            float o[8];
#pragma unroll
            for (int c = 0; c < 8; ++c) o[c] = bv[c];
#pragma unroll
            for (int jj = 0; jj < 4; ++jj) { const v4u u = rq[i + jj]; const unsigned w[4] = {u.x, u.y, u.z, u.w};
#pragma unroll
                for (int c2 = 0; c2 < 4; ++c2) { o[2 * c2] += wv[jj][2 * c2] * bflo(w[c2]); o[2 * c2 + 1] += wv[jj][2 * c2 + 1] * bfhi(w[c2]); } }
#pragma unroll
            for (int c = 0; c < 8; ++c) o[c] = osc * o[c] / (1.0f + __expf(-o[c]));
            v4u w; w.x = cvtpk(o[0], o[1]); w.y = cvtpk(o[2], o[3]); w.z = cvtpk(o[4], o[5]); w.w = cvtpk(o[6], o[7]);
            *(v4u*)(QKC + (r0 + i) * 1024 + 8 * cgp) = w;
        }
    }
}


constexpr int ML_QS = 0, ML_KS = 17408, ML_KWS = 34816, ML_VS = 55296, ML_CT = 75776, ML_YT = 110592, ML_SC = 128000, ML_N = 130688, ML_HSQ = 131712, ML_NG = 132224, ML_QN = 132736;
constexpr int ML_SCF = 336;
constexpr int ML_P = 272, ML_PT = 320;
typedef short s16x4_t __attribute__((ext_vector_type(4)));
__device__ __forceinline__ bf16x8 tr_frag(const LAS unsigned char* tile, int pitch, int rowA, int rowB, int colblk, int lane) {
    const int q = (lane & 15) >> 2, p = lane & 3, ch = (lane >> 4) & 1;
    const LAS unsigned char* a = tile + (rowA + q) * pitch + (colblk + 16 * ch + 4 * p) * 2;
    const LAS unsigned char* c = tile + (rowB + q) * pitch + (colblk + 16 * ch + 4 * p) * 2;
    const s16x4_t lo = __builtin_bit_cast(s16x4_t, __builtin_amdgcn_ds_read_tr16_b64_v4i16((LAS s16x4_t*)a));
    const s16x4_t hi = __builtin_bit_cast(s16x4_t, __builtin_amdgcn_ds_read_tr16_b64_v4i16((LAS s16x4_t*)c));
    return (bf16x8){lo[0], lo[1], lo[2], lo[3], hi[0], hi[1], hi[2], hi[3]};
}
__device__ __forceinline__ void mlstm_unit(Frame& F, int b, int h) {
    LAS unsigned char* L = (LAS unsigned char*)F.lds;
    const unsigned short* VB = (const unsigned short*)(F.ws + WS_VB);
    const unsigned short* OB = (const unsigned short*)(F.ws + WS_OB);
    unsigned short* YB = (unsigned short*)(F.ws + WS_YB);
    const float* GATES = (const float*)(F.ws + WS_GATES);
    const float* ng = F.in[11];
    const int tid = F.tid, lane = F.lane, wave = F.wave, hh = lane >> 5, q32 = lane & 31;
    const int et = wave >> 1, lt = wave & 1, eb = wave & 3, dbp = wave >> 2;
    LAS float* SC = (LAS float*)(L + ML_SC);
    LAS float* NV = (LAS float*)(L + ML_N);
    LAS float* HSQ = (LAS float*)(L + ML_HSQ);
    for (int i = tid; i < 34816 / 4; i += 512) ((LAS unsigned*)(L + ML_CT))[i] = 0u;
    if (tid < 256) NV[tid] = 0.f;
    if (tid < 128) { HSQ[tid] = 0.f; ((LAS float*)(L + ML_NG))[tid] = ng[h * 128 + tid]; }
    f32x16 accC0 = {}, accC1 = {};
    float m_state = 0.f;
    const int sl = tid >> 3, sp = tid & 7;
    const size_t rowb = (size_t)b * SEQ;
    const unsigned short* QKC = (const unsigned short*)(F.ws + WS_QKC);
    const unsigned short* qsrc = QKC + h * 128 + 8 * sp;
    const unsigned short* vsrc = VB + h * 128 + 8 * sp;
    const int fr = tid >> 4, fc = tid & 15;
    v4u rq[2], rk[2], rv[2], rob[2]; float gi = 0.f, gf = 0.f;
#if ML_SPLIT
    v4u rpn[2], rpc[2]; float rdn = 0.f, rdc = 0.f;
    float rgn = 0.f, ran = 0.f, rac = 0.f, rmn = 0.f, rmc = 0.f;
    const float* GSu = (const float*)(F.ws + WS_GS) + (size_t)(b * 4 + h) * 64 * 256;
    float m_run = 0.f;
    const float AGa = ((const float*)(F.ws + WS_AG))[(size_t)(b * 4 + h) * 128 + 2 * lane], AGg = ((const float*)(F.ws + WS_AG))[(size_t)(b * 4 + h) * 128 + 2 * lane + 1];
    const unsigned short* HIN = (const unsigned short*)(F.ws + WS_HIN) + (size_t)(b * 4 + h) * 64 * 8192 + wave * 1024 + lane * 4;
    const unsigned* MLF = (const unsigned*)(F.ws + WS_MLFLAG) + (b * 4 + h) * 64;
    unsigned fnext = 0u;
    const float* DSUM = (const float*)(F.ws + WS_DSUM) + (size_t)(b * 4 + h) * 4096 + 32 * lt + q32;
#endif
    auto load_raw = [&](int j) {
        const size_t tr = rowb + 64 * j + sl;
#pragma unroll
        for (int i = 0; i < 2; ++i) { rq[i] = *(const v4u*)(qsrc + tr * 1024 + 64 * i); rk[i] = *(const v4u*)(qsrc + tr * 1024 + 512 + 64 * i); rv[i] = *(const v4u*)(vsrc + tr * 512 + 64 * i); }
#if !ML_SPLIT
        if (wave == 0) { const float* gp = GATES + (rowb + 64 * j + lane) * 8; gi = gp[h]; gf = gp[4 + h]; }
#endif
#if ML_SPLIT
        {
            typedef unsigned long long u64;
            if (fnext == 0u) { unsigned spins = 0; while (__hip_atomic_load(MLF + j, __ATOMIC_RELAXED, __HIP_MEMORY_SCOPE_AGENT) == 0u) { __builtin_amdgcn_s_sleep(4); if (++spins > (1u << 20)) break; } }
            asm volatile("" ::: "memory");
            const u64* r64 = (const u64*)(HIN + (size_t)j * 8192);
            const u64 a0 = __hip_atomic_load(r64 + 0, __ATOMIC_RELAXED, __HIP_MEMORY_SCOPE_AGENT), a1 = __hip_atomic_load(r64 + 64, __ATOMIC_RELAXED, __HIP_MEMORY_SCOPE_AGENT);
            const u64 a2 = __hip_atomic_load(r64 + 128, __ATOMIC_RELAXED, __HIP_MEMORY_SCOPE_AGENT), a3 = __hip_atomic_load(r64 + 192, __ATOMIC_RELAXED, __HIP_MEMORY_SCOPE_AGENT);
            rpn[0] = (v4u){(unsigned)a0, (unsigned)(a0 >> 32), (unsigned)a1, (unsigned)(a1 >> 32)}; rpn[1] = (v4u){(unsigned)a2, (unsigned)(a2 >> 32), (unsigned)a3, (unsigned)(a3 >> 32)};
            rdn = __hip_atomic_load(DSUM + j * 64, __ATOMIC_RELAXED, __HIP_MEMORY_SCOPE_AGENT);
            fnext = (j < 63) ? __hip_atomic_load(MLF + j + 1, __ATOMIC_RELAXED, __HIP_MEMORY_SCOPE_AGENT) : 1u;
        }
        rgn = GSu[j * 256 + 192 + (tid >> 3)]; ran = GSu[j * 256 + 128 + 32 * lt + q32]; rmn = GSu[j * 256 + 64 + 32 * lt + q32];
#endif
    };
    auto load_ob = [&](int j) {
#pragma unroll
        for (int i = 0; i < 2; ++i) rob[i] = *(const v4u*)(OB + (rowb + 64 * j + fr + 32 * i) * 512 + h * 128 + 8 * fc);
    };
    auto flush = [&](int j) {
#pragma unroll
        for (int i = 0; i < 2; ++i) { const int r = fr + 32 * i;
            const v4u y = *(const LAS v4u*)(L + ML_YT + r * ML_P + fc * 16); const v4u o = rob[i]; v4u w;
            w.x = cvtpk(bflo(y.x) * bflo(o.x), bfhi(y.x) * bfhi(o.x)); w.y = cvtpk(bflo(y.y) * bflo(o.y), bfhi(y.y) * bfhi(o.y));
            w.z = cvtpk(bflo(y.z) * bflo(o.z), bfhi(y.z) * bfhi(o.z)); w.w = cvtpk(bflo(y.w) * bflo(o.w), bfhi(y.w) * bfhi(o.w));
            *(v4u*)(YB + (rowb + 64 * j + r) * 512 + h * 128 + 8 * fc) = w; }
    };
    auto gates_compute = [&](int buf) {
        LAS float* sc = SC + buf * ML_SCF;
        const float li = gi, lf = fminf(gf, 0.f) - log1pf(__expf(-fabsf(gf)));
        const float a = scan_sum64(lf);
        const float A = lane63(a);
        const float g = A - a + li;
        const float gmax = lane63(scan_max64(g));
        const float m_new = fmaxf(A + m_state, gmax);
        const float ws = li - a;
        const float pm = scan_max64(ws);
        const float mrow = a + fmaxf(m_state, pm);
        sc[lane] = __expf(g - m_new); sc[64 + lane] = ws; sc[128 + lane] = a - mrow; sc[192 + lane] = __expf(a + m_state - mrow); sc[256 + lane] = __expf(-mrow);
        if (lane == 0) sc[320] = __expf(A + m_state - m_new);
        m_state = m_new;
    };
    load_raw(0);
#if !ML_SPLIT
    if (wave == 0) gates_compute(0);
#endif
    __syncthreads();
    for (int j = 0; j < 64; ++j) {
        const int cur = j & 1;
        LAS float* sc = SC + cur * ML_SCF;
        {
            LAS float* nq = NV + cur * 128;
            float qp = 0.f;
#pragma unroll
            for (int i = 0; i < 2; ++i) { const f32x4 n0 = *(const LAS f32x4*)(nq + 64 * i + 8 * sp), n1 = *(const LAS f32x4*)(nq + 64 * i + 8 * sp + 4);
                qp += bflo(rq[i].x) * n0.x + bfhi(rq[i].x) * n0.y + bflo(rq[i].y) * n0.z + bfhi(rq[i].y) * n0.w + bflo(rq[i].z) * n1.x + bfhi(rq[i].z) * n1.y + bflo(rq[i].w) * n1.z + bfhi(rq[i].w) * n1.w; }
            qp += __shfl_xor(qp, 1); qp += __shfl_xor(qp, 2); qp += __shfl_xor(qp, 4);
            if (sp == 0) ((LAS float*)(L + ML_QN))[sl] = qp;
        }
#if ML_SPLIT
        const float Aj = __builtin_bit_cast(float, __builtin_amdgcn_readlane(__builtin_bit_cast(int, AGa), j)), Gj = __builtin_bit_cast(float, __builtin_amdgcn_readlane(__builtin_bit_cast(int, AGg), j));
        const float m_new = fmaxf(Aj + m_run, Gj);
#endif
        {
#if ML_SPLIT
            const float wk = __expf(rgn - m_new);
#else
            const float wk = sc[sl];
#endif
#pragma unroll
            for (int i = 0; i < 2; ++i) {
                *(LAS v4u*)(L + ML_QS + sl * ML_P + (sp + 8 * i) * 16) = rq[i];
#if !ML_SPLIT
                *(LAS v4u*)(L + ML_KS + sl * ML_P + (sp + 8 * i) * 16) = rk[i];
#endif
                v4u kw; kw.x = cvtpk(bflo(rk[i].x) * wk, bfhi(rk[i].x) * wk); kw.y = cvtpk(bflo(rk[i].y) * wk, bfhi(rk[i].y) * wk); kw.z = cvtpk(bflo(rk[i].z) * wk, bfhi(rk[i].z) * wk); kw.w = cvtpk(bflo(rk[i].w) * wk, bfhi(rk[i].w) * wk);
                *(LAS v4u*)(L + ML_KWS + sl * ML_PT + (sp + 8 * i) * 16) = kw;
                *(LAS v4u*)(L + ML_VS + sl * ML_PT + (sp + 8 * i) * 16) = rv[i];
            }
        }
#if ML_SPLIT
        rpc[0] = rpn[0]; rpc[1] = rpn[1]; rdc = rdn; rac = ran; rmc = rmn;
#endif
        if (j < 63) load_raw(j + 1);
        if (j > 0) load_ob(j - 1);
        __syncthreads();
        const int l = 32 * lt + q32;
#if ML_SPLIT
        const float mrow = rac + fmaxf(m_run, rmc);
        const float wi_l = __expf(rac + m_run - mrow), fl_l = __expf(-mrow), decay = __expf(Aj + m_run - m_new);
        m_run = m_new;
#else
        const float u_l = sc[128 + l], wi_l = sc[192 + l], fl_l = sc[256 + l], decay = sc[320];
#endif
        LAS float* nold = NV + cur * 128; LAS float* nnew = NV + (cur ^ 1) * 128;
        const float qn = ((const LAS float*)(L + ML_QN))[l];
#if ML_SPLIT
        const LAS unsigned char* Qb = L + ML_QS + l * ML_P + 16 * hh;
        const float dsum = rdc;
        f32x16 accH = {};
        { const LAS unsigned char* Cb = L + ML_CT + (32 * et + q32) * ML_P + 16 * hh;
#pragma unroll
          for (int ks = 0; ks < 8; ++ks) accH = __builtin_amdgcn_mfma_f32_32x32x16_bf16(*(const LAS bf16x8*)(Cb + 32 * ks), *(const LAS bf16x8*)(Qb + 32 * ks), accH, 0, 0, 0); }
        { const unsigned pw[8] = {rpc[0].x, rpc[0].y, rpc[0].z, rpc[0].w, rpc[1].x, rpc[1].y, rpc[1].z, rpc[1].w};
#pragma unroll
          for (int r2 = 0; r2 < 8; ++r2) { accH[2 * r2] = accH[2 * r2] * wi_l + bflo(pw[r2]); accH[2 * r2 + 1] = accH[2 * r2 + 1] * wi_l + bfhi(pw[r2]); } }
#else
        const LAS unsigned char* Qb = L + ML_QS + l * ML_P + 16 * hh;
        float dsum = 0.f;
        v4u pb[2][2];
#pragma unroll
        for (int st = 0; st < 2; ++st) {
            if (st <= lt) {
                f32x16 sa = {};
                const LAS unsigned char* Kb = L + ML_KS + (32 * st + q32) * ML_P + 16 * hh;
#pragma unroll
                for (int ks = 0; ks < 8; ++ks) sa = __builtin_amdgcn_mfma_f32_32x32x16_bf16(*(const LAS bf16x8*)(Kb + 32 * ks), *(const LAS bf16x8*)(Qb + 32 * ks), sa, 0, 0, 0);
#pragma unroll
                for (int r = 0; r < 16; ++r) { const int sidx = 32 * st + (r & 3) + 8 * (r >> 2) + 4 * hh;
                    const float p = (sidx <= l) ? sa[r] * __expf(u_l + sc[64 + sidx]) : 0.f; sa[r] = p; dsum += p; }
#pragma unroll
                for (int s2 = 0; s2 < 2; ++s2) { pb[st][s2].x = cvtpk(sa[8 * s2 + 0], sa[8 * s2 + 1]); pb[st][s2].y = cvtpk(sa[8 * s2 + 2], sa[8 * s2 + 3]); pb[st][s2].z = cvtpk(sa[8 * s2 + 4], sa[8 * s2 + 5]); pb[st][s2].w = cvtpk(sa[8 * s2 + 6], sa[8 * s2 + 7]); }
            }
        }
        dsum += __shfl_xor(dsum, 32);
        f32x16 accH = {};
        { const LAS unsigned char* Cb = L + ML_CT + (32 * et + q32) * ML_P + 16 * hh;
#pragma unroll
          for (int ks = 0; ks < 8; ++ks) accH = __builtin_amdgcn_mfma_f32_32x32x16_bf16(*(const LAS bf16x8*)(Cb + 32 * ks), *(const LAS bf16x8*)(Qb + 32 * ks), accH, 0, 0, 0); }
#pragma unroll
        for (int r = 0; r < 16; ++r) accH[r] *= wi_l;
#pragma unroll
        for (int st = 0; st < 2; ++st) {
            if (st <= lt) {
#pragma unroll
                for (int s2 = 0; s2 < 2; ++s2) {
                    const int ra = 32 * st + 16 * s2 + 4 * hh;
                    accH = __builtin_amdgcn_mfma_f32_32x32x16_bf16(tr_frag(L + ML_VS, ML_PT, ra, ra + 8, 32 * et, lane), __builtin_bit_cast(bf16x8, pb[st][s2]), accH, 0, 0, 0);
                }
            }
        }
#endif
        { const float den = wi_l * qn + dsum, inv = 1.0f / fmaxf(fabsf(den), fl_l); float ssq = 0.f;
#pragma unroll
          for (int r = 0; r < 16; ++r) { accH[r] *= inv; ssq += accH[r] * accH[r]; }
          ssq += __shfl_xor(ssq, 32);
          if (hh == 0) atomicAdd((float*)(HSQ + cur * 64 + l), ssq); }
#pragma unroll
        for (int r = 0; r < 16; ++r) { accC0[r] *= decay; accC1[r] *= decay; }
#pragma unroll
        for (int ks = 0; ks < 4; ++ks) { const int ra = 16 * ks + 8 * hh;
            const bf16x8 bvv = tr_frag(L + ML_VS, ML_PT, ra, ra + 4, 32 * eb, lane);
            accC0 = __builtin_amdgcn_mfma_f32_32x32x16_bf16(tr_frag(L + ML_KWS, ML_PT, ra, ra + 4, 64 * dbp, lane), bvv, accC0, 0, 0, 0);
            accC1 = __builtin_amdgcn_mfma_f32_32x32x16_bf16(tr_frag(L + ML_KWS, ML_PT, ra, ra + 4, 64 * dbp + 32, lane), bvv, accC1, 0, 0, 0); }
        if (wave == 2) {
            float ps[8];
#pragma unroll
            for (int c = 0; c < 8; ++c) ps[c] = 0.f;
#pragma unroll
            for (int r = 0; r < 16; ++r) { const v4u k8 = *(const LAS v4u*)(L + ML_KWS + (16 * (lane >> 4) + r) * ML_PT + (lane & 15) * 16);
                ps[0] += bflo(k8.x); ps[1] += bfhi(k8.x); ps[2] += bflo(k8.y); ps[3] += bfhi(k8.y); ps[4] += bflo(k8.z); ps[5] += bfhi(k8.z); ps[6] += bflo(k8.w); ps[7] += bfhi(k8.w); }
#pragma unroll
            for (int c = 0; c < 8; ++c) { ps[c] += __shfl_xor(ps[c], 16); ps[c] += __shfl_xor(ps[c], 32); }
            if (lane < 16) {
#pragma unroll
                for (int c = 0; c < 8; ++c) nnew[8 * lane + c] = decay * nold[8 * lane + c] + ps[c]; }
        }
#if !ML_SPLIT
        if (wave == 0 && j < 63) gates_compute(cur ^ 1);
#endif
        if (j > 0) flush(j - 1);
        __syncthreads();
        {
            const float rstd = rsqrtf(HSQ[cur * 64 + l] * (1.0f / 128.0f) + EPS);
#pragma unroll
            for (int g4 = 0; g4 < 4; ++g4) {
                typedef unsigned u32x2_t __attribute__((ext_vector_type(2)));
                const int e0 = 32 * et + 8 * g4 + 4 * hh;
                const f32x4 gv = *(const LAS f32x4*)(L + ML_NG + e0 * 4);
                u32x2_t w;
                w.x = cvtpk(accH[4 * g4] * rstd * gv.x, accH[4 * g4 + 1] * rstd * gv.y);
                w.y = cvtpk(accH[4 * g4 + 2] * rstd * gv.z, accH[4 * g4 + 3] * rstd * gv.w);
                *(LAS u32x2_t*)(L + ML_YT + l * ML_P + e0 * 2) = w;
            }
#pragma unroll
            for (int g4 = 0; g4 < 4; ++g4) {
                typedef unsigned u32x2_t __attribute__((ext_vector_type(2)));
                u32x2_t w0, w1;
                w0.x = cvtpk(accC0[4 * g4], accC0[4 * g4 + 1]); w0.y = cvtpk(accC0[4 * g4 + 2], accC0[4 * g4 + 3]);
                w1.x = cvtpk(accC1[4 * g4], accC1[4 * g4 + 1]); w1.y = cvtpk(accC1[4 * g4 + 2], accC1[4 * g4 + 3]);
                *(LAS u32x2_t*)(L + ML_CT + (32 * eb + q32) * ML_P + (64 * dbp + 8 * g4 + 4 * hh) * 2) = w0;
                *(LAS u32x2_t*)(L + ML_CT + (32 * eb + q32) * ML_P + (64 * dbp + 32 + 8 * g4 + 4 * hh) * 2) = w1;
            }
            if (tid < 64) HSQ[(cur ^ 1) * 64 + tid] = 0.f;
        }
    }
    load_ob(63);
    __syncthreads();
    flush(63);
    __syncthreads();
}

__device__ __forceinline__ void mlstm_gate_stats(Frame& F) {
    const float* GATES = (const float*)(F.ws + WS_GATES);
    float* AG = (float*)(F.ws + WS_AG);
    const int lane = F.lane;
    for (int c = F.gw; c < 4096; c += F.NGW) {
        const int unit = c >> 6, j = c & 63, b = unit >> 2, h = unit & 3;
        const float* gp = GATES + ((size_t)b * SEQ + 64 * j + lane) * 8; const float gi = gp[h], gf = gp[4 + h];
        const float lf = fminf(gf, 0.f) - log1pf(__expf(-fabsf(gf)));
        const float a = scan_sum64(lf), A = lane63(a);
        const float g = A - a + gi, gmax = lane63(scan_max64(g));
        const float ws = gi - a, pm = scan_max64(ws);
        float* gs = (float*)(F.ws + WS_GS) + (size_t)c * 256;
        gs[lane] = ws; gs[64 + lane] = pm; gs[128 + lane] = a; gs[192 + lane] = g;
        if (lane == 0) { AG[2 * c] = A; AG[2 * c + 1] = gmax; }
    }
}
__device__ __forceinline__ void mlstm_intra_tasks(Frame& F) {
    LAS unsigned char* L = (LAS unsigned char*)F.lds;
    const unsigned short* VB = (const unsigned short*)(F.ws + WS_VB);
    const unsigned short* QKC = (const unsigned short*)(F.ws + WS_QKC);
    const float* GS = (const float*)(F.ws + WS_GS);
    const float* AGp = (const float*)(F.ws + WS_AG);
    const int tid = F.tid, lane = F.lane, wave = F.wave, hh = lane >> 5, q32 = lane & 31;
    const int et = wave >> 1, lt = wave & 1, l = 32 * lt + q32;
    LAS float* wsl = (LAS float*)(L + ML_SC);
    const int sl = tid >> 3, sp = tid & 7;
    const int PG = F.G - 64;
    int task = (int)blockIdx.x - 64;
    if (task < 0 || task >= 4096) return;
    v4u rq[2], rk[2], rv[2]; float rws = 0.f, rpm = 0.f;
    auto load_task = [&](int tk) { const int unit = tk & 63, j = tk >> 6, b = unit >> 2, h = unit & 3; const size_t tr = (size_t)b * SEQ + 64 * j + sl;
#pragma unroll
        for (int i = 0; i < 2; ++i) { rq[i] = *(const v4u*)(QKC + tr * 1024 + h * 128 + 8 * sp + 64 * i); rk[i] = *(const v4u*)(QKC + tr * 1024 + 512 + h * 128 + 8 * sp + 64 * i); rv[i] = *(const v4u*)(VB + tr * 512 + h * 128 + 8 * sp + 64 * i); }
        const float* gs = GS + (size_t)(unit * 64 + j) * 256; if (tid < 64) rws = gs[tid]; rpm = gs[64 + l]; };
    load_task(task);
    int unit_c = -1, jdone = 0; float m_state = 0.f, Ak = 0.f, Gk = 0.f;
    for (int it = 0; task < 4096; task += PG, ++it) {
        const int unit = task & 63, j = task >> 6, buf = it & 1;
        if (unit != unit_c) { unit_c = unit; jdone = 0; m_state = 0.f; Ak = AGp[(size_t)unit * 128 + 2 * lane]; Gk = AGp[(size_t)unit * 128 + 2 * lane + 1]; }
        for (; jdone < j; ++jdone) m_state = fmaxf(__builtin_bit_cast(float, __builtin_amdgcn_readlane(__builtin_bit_cast(int, Ak), jdone)) + m_state, __builtin_bit_cast(float, __builtin_amdgcn_readlane(__builtin_bit_cast(int, Gk), jdone)));
        const float u_l = -fmaxf(m_state, rpm);
#pragma unroll
        for (int i = 0; i < 2; ++i) {
            *(LAS v4u*)(L + ML_QS + sl * ML_P + (sp + 8 * i) * 16) = rq[i];
            *(LAS v4u*)(L + ML_KS + sl * ML_P + (sp + 8 * i) * 16) = rk[i];
            *(LAS v4u*)(L + ML_VS + sl * ML_PT + (sp + 8 * i) * 16) = rv[i];
        }
        if (tid < 64) wsl[buf * 64 + tid] = rws;
        if (task + PG < 4096) load_task(task + PG);
        __syncthreads();
        const LAS unsigned char* Qb = L + ML_QS + l * ML_P + 16 * hh;
        float dsum = 0.f;
        v4u pb[2][2];
#pragma unroll
        for (int st = 0; st < 2; ++st) {
            if (st <= lt) {
                f32x16 sa = {};
                const LAS unsigned char* Kb = L + ML_KS + (32 * st + q32) * ML_P + 16 * hh;
#pragma unroll
                for (int ks = 0; ks < 8; ++ks) sa = __builtin_amdgcn_mfma_f32_32x32x16_bf16(*(const LAS bf16x8*)(Kb + 32 * ks), *(const LAS bf16x8*)(Qb + 32 * ks), sa, 0, 0, 0);
#pragma unroll
                for (int g4 = 0; g4 < 4; ++g4) { const f32x4 w4 = *(const LAS f32x4*)(wsl + buf * 64 + 32 * st + 8 * g4 + 4 * hh);
                    const float wv[4] = {w4.x, w4.y, w4.z, w4.w};
#pragma unroll
                    for (int rr = 0; rr < 4; ++rr) { const int r = 4 * g4 + rr, sidx = 32 * st + rr + 8 * g4 + 4 * hh;
                        const float p = (sidx <= l) ? sa[r] * __expf(u_l + wv[rr]) : 0.f; sa[r] = p; dsum += p; } }
#pragma unroll
                for (int s2 = 0; s2 < 2; ++s2) { pb[st][s2].x = cvtpk(sa[8 * s2 + 0], sa[8 * s2 + 1]); pb[st][s2].y = cvtpk(sa[8 * s2 + 2], sa[8 * s2 + 3]); pb[st][s2].z = cvtpk(sa[8 * s2 + 4], sa[8 * s2 + 5]); pb[st][s2].w = cvtpk(sa[8 * s2 + 6], sa[8 * s2 + 7]); }
            }
        }
        dsum += __shfl_xor(dsum, 32);
        f32x16 accP = {};
#pragma unroll
        for (int st = 0; st < 2; ++st) {
            if (st <= lt) {
#pragma unroll
                for (int s2 = 0; s2 < 2; ++s2) {
                    const int ra = 32 * st + 16 * s2 + 4 * hh;
                    accP = __builtin_amdgcn_mfma_f32_32x32x16_bf16(tr_frag(L + ML_VS, ML_PT, ra, ra + 8, 32 * et, lane), __builtin_bit_cast(bf16x8, pb[st][s2]), accP, 0, 0, 0);
                }
            }
        }
        {
            unsigned short* rec = (unsigned short*)(F.ws + WS_HIN) + ((size_t)(unit * 64 + j) * 8 + wave) * 1024 + lane * 16;
            v4u w0, w1;
            w0.x = cvtpk(accP[0], accP[1]); w0.y = cvtpk(accP[2], accP[3]); w0.z = cvtpk(accP[4], accP[5]); w0.w = cvtpk(accP[6], accP[7]);
            w1.x = cvtpk(accP[8], accP[9]); w1.y = cvtpk(accP[10], accP[11]); w1.z = cvtpk(accP[12], accP[13]); w1.w = cvtpk(accP[14], accP[15]);
            typedef unsigned long long u64;
            u64* r64 = (u64*)((unsigned short*)(F.ws + WS_HIN) + ((size_t)(unit * 64 + j) * 8 + wave) * 1024) + lane;
            __hip_atomic_store(r64 + 0, (u64)w0.x | ((u64)w0.y << 32), __ATOMIC_RELAXED, __HIP_MEMORY_SCOPE_AGENT); __hip_atomic_store(r64 + 64, (u64)w0.z | ((u64)w0.w << 32), __ATOMIC_RELAXED, __HIP_MEMORY_SCOPE_AGENT);
            __hip_atomic_store(r64 + 128, (u64)w1.x | ((u64)w1.y << 32), __ATOMIC_RELAXED, __HIP_MEMORY_SCOPE_AGENT); __hip_atomic_store(r64 + 192, (u64)w1.z | ((u64)w1.w << 32), __ATOMIC_RELAXED, __HIP_MEMORY_SCOPE_AGENT);
            if (et == 0 && hh == 0) __hip_atomic_store((float*)(F.ws + WS_DSUM) + (size_t)(unit * 64 + j) * 64 + l, dsum, __ATOMIC_RELAXED, __HIP_MEMORY_SCOPE_AGENT);
        }
        asm volatile("s_waitcnt vmcnt(0)" ::: "memory");
        __syncthreads();
        if (tid == 0) __hip_atomic_store((unsigned*)(F.ws + WS_MLFLAG) + unit * 64 + j, 1u, __ATOMIC_RELAXED, __HIP_MEMORY_SCOPE_AGENT);
    }
}

__device__ __forceinline__ void mlstm_ref_unit(Frame& F, int b, int h) {
    const unsigned short* QKB = (const unsigned short*)(F.ws + WS_QKB);
    const unsigned short* VB = (const unsigned short*)(F.ws + WS_VB);
    const unsigned short* OB = (const unsigned short*)(F.ws + WS_OB);
    const float* GATES = (const float*)(F.ws + WS_GATES);
    const float* conv_w = F.in[6]; const float* conv_b = F.in[7]; const float* ng = F.in[11];
    float* qs = (float*)F.lds; float* ks = qs + 128; float* vs = ks + 128; float* sc = vs + 128;
    float* part = sc + 16;
    float* red = part + 512;
    const int tid = F.tid, e = tid & 127, dq = tid >> 7;
    float C[32];
#pragma unroll
    for (int i = 0; i < 32; ++i) C[i] = 0.f;
    float nst = 0.f;
    float cw[4] = {0.f, 0.f, 0.f, 0.f}; float cb = 0.f; int ccol = 0;
    if (tid < 256) { ccol = (tid < 128 ? 0 : 512) + h * 128 + (tid & 127);
#pragma unroll
        for (int j = 0; j < 4; ++j) cw[j] = conv_w[j * 1024 + ccol]; cb = conv_b[ccol]; }
    const float gsc = ng[h * 128 + e];
    for (int tok = 0; tok < SEQ; ++tok) {
        const size_t t = (size_t)b * SEQ + tok;
        if (tid < 256) {
            float a = cb;
#pragma unroll
            for (int j = 0; j < 4; ++j) { const int tt = tok - 3 + j; if (tt >= 0) a += cw[j] * bf2f(QKB[((size_t)b * SEQ + tt) * 1024 + ccol]); }
            a = a / (1.0f + __expf(-a));
            if (tid < 128) qs[tid] = a; else ks[tid - 128] = a * 0.08838834764831845f;
        } else if (tid < 384) { vs[tid - 256] = bf2f(VB[t * 512 + h * 128 + (tid - 256)]); }
        else if (tid == 384) { sc[0] = sigmoidf_(GATES[t * 8 + 4 + h]); sc[1] = __expf(GATES[t * 8 + h]); }
        __syncthreads();
        const float fg = sc[0], ig = sc[1], ve = vs[e];
        float acc = 0.f;
#pragma unroll
        for (int i = 0; i < 32; ++i) { const int d = dq * 32 + i; C[i] = fg * C[i] + (ig * ks[d]) * ve; acc += qs[d] * C[i]; }
        part[dq * 128 + e] = acc;
        if (tid < 128) { nst = fg * nst + ig * ks[tid]; const float qn = wave_sum(qs[tid] * nst); if (F.lane == 0) red[F.wave] = qn; }
        __syncthreads();
        float hv = 0.f;
        if (tid < 128) { const float num = (part[e] + part[128 + e]) + (part[256 + e] + part[384 + e]); const float den = red[0] + red[1];
            hv = num / fmaxf(fabsf(den), 1.0f); const float ss = wave_sum(hv * hv); if (F.lane == 0) red[2 + F.wave] = ss; }
        __syncthreads();
        if (tid < 128) { const float rstd = rsqrtf((red[2] + red[3]) * (1.0f / 128.0f) + EPS);
            const float y = hv * rstd * gsc * bf2f(OB[t * 512 + h * 128 + e]);
            ((unsigned short*)(F.ws + WS_YB))[t * 512 + h * 128 + e] = (unsigned short)f2bf(y); }
        __syncthreads();
    }
}

__device__ __forceinline__ void argmax_step(float& bv, int& bi) {
#pragma unroll
    for (int o = 1; o < 64; o <<= 1) { const float ov = __shfl_xor(bv, o); const int oi = __shfl_xor(bi, o); if (ov > bv || (ov == bv && oi < bi)) { bv = ov; bi = oi; } }
}
__device__ __forceinline__ void peer_route_ref(Frame& F) {
    const unsigned short* PQ = (const unsigned short*)(F.ws + WS_PQ);
    const unsigned short* SUBK = (const unsigned short*)(F.ws + WS_SUBK);
    unsigned* ROUTE = (unsigned*)(F.ws + WS_ROUTE);
    unsigned char* wl = F.lds + F.wave * 8192;
    unsigned short* ql = (unsigned short*)wl;
    float* tv = (float*)(wl + 4096);
    int* ti = (int*)(wl + 4096 + 1024);
    const int lane = F.lane;
    for (int t = F.gw; t < T; t += F.NGW) {
        { const v4u* src = (const v4u*)(PQ + (size_t)t * 2048); v4u* dst = (v4u*)ql;
#pragma unroll
          for (int i = 0; i < 4; ++i) dst[lane + 64 * i] = src[lane + 64 * i]; }
        LDS_WAIT(); asm volatile("" ::: "memory");
        for (int g = 0; g < 16; ++g) {
            const v4u* k0 = (const v4u*)(SUBK + (size_t)(g * 128 + lane) * 128);
            const v4u* k1 = (const v4u*)(SUBK + (size_t)(g * 128 + 64 + lane) * 128);
            const v4u* qg = (const v4u*)(ql + g * 128);
            float s0 = 0.f, s1 = 0.f;
#pragma unroll 4
            for (int ch = 0; ch < 16; ++ch) { const v4u q = qg[ch], a = k0[ch], c = k1[ch];
                s0 = dot2c(s0, q.x, a.x); s0 = dot2c(s0, q.y, a.y); s0 = dot2c(s0, q.z, a.z); s0 = dot2c(s0, q.w, a.w);
                s1 = dot2c(s1, q.x, c.x); s1 = dot2c(s1, q.y, c.y); s1 = dot2c(s1, q.z, c.z); s1 = dot2c(s1, q.w, c.w); }
            float myv = 0.f; int myi = 0;
            for (int it = 0; it < 16; ++it) {
                float bv; int bi; if (s0 >= s1) { bv = s0; bi = lane; } else { bv = s1; bi = lane + 64; }
                argmax_step(bv, bi);
                if (it == lane) { myv = bv; myi = bi; }
                if (bi == lane) s0 = -INFINITY; if (bi == lane + 64) s1 = -INFINITY;
            }
            if (lane < 16) { tv[g * 16 + lane] = myv; ti[g * 16 + lane] = myi; }
        }
        LDS_WAIT(); asm volatile("" ::: "memory");
        for (int h = 0; h < 8; ++h) {
            float cv[4];
#pragma unroll
            for (int r = 0; r < 4; ++r) cv[r] = tv[(2 * h) * 16 + (lane >> 2)] + tv[(2 * h + 1) * 16 + 4 * (lane & 3) + r];
            float myv = -INFINITY; int myc = 0;
            for (int it = 0; it < 16; ++it) {
                float bv = cv[0]; int bi = 4 * lane;
#pragma unroll
                for (int r = 1; r < 4; ++r) if (cv[r] > bv) { bv = cv[r]; bi = 4 * lane + r; }
                argmax_step(bv, bi);
                if (it == lane) { myv = bv; myc = bi; }
#pragma unroll
                for (int r = 0; r < 4; ++r) if (bi == 4 * lane + r) cv[r] = -INFINITY;
            }
            const float mx = __shfl(myv, 0);
            float ex = lane < 16 ? __expf(myv - mx) : 0.f;
            const float sum = wave_sum(ex);
            if (lane < 16) { const int e = ti[(2 * h) * 16 + (myc >> 4)] * 128 + ti[(2 * h + 1) * 16 + (myc & 15)];
                ROUTE[(size_t)t * 128 + h * 16 + lane] = ((unsigned)e << 16) | f2bf(ex / sum); }
        }
        LDS_WAIT(); asm volatile("" ::: "memory");
    }
}


__device__ __forceinline__ void sort_insert16(float (&a)[16], float x) {
#pragma unroll
    for (int k = 15; k >= 1; --k) a[k] = __builtin_amdgcn_fmed3f(a[k - 1], x, a[k]);
    a[0] = fmaxf(a[0], x);
}
__device__ __forceinline__ void merge_halves16(float (&a)[16]) {
    float c[16];
#pragma unroll
    for (int k = 0; k < 16; ++k) c[k] = __shfl_xor(a[k], 32);
#pragma unroll
    for (int k = 0; k < 16; ++k) a[k] = fmaxf(a[k], c[15 - k]);
#pragma unroll
    for (int st = 8; st >= 1; st >>= 1)
#pragma unroll
        for (int i = 0; i < 16; ++i) if ((i & st) == 0) { const float hi = fmaxf(a[i], a[i + st]), lo = fminf(a[i], a[i + st]); a[i] = hi; a[i + st] = lo; }
}
__device__ __forceinline__ void peer_route_mfma(Frame& F) {
    const unsigned short* PQ = (const unsigned short*)(F.ws + WS_PQ);
    const unsigned short* SUBK = (const unsigned short*)(F.ws + WS_SUBK);
    unsigned* ROUTE = (unsigned*)(F.ws + WS_ROUTE);
    constexpr int SKP = 272;
    LAS unsigned char* L = (LAS unsigned char*)F.lds;
    LAS unsigned* lst = (LAS unsigned*)(L + 2 * 128 * SKP) + F.wave * 1024;
    const int lane = F.lane, hh = lane >> 5, q32 = lane & 31, tid = F.tid;
    for (int tile = F.gw; tile < T / 32; tile += F.NGW) {
    const size_t t = (size_t)tile * 32 + q32;
    for (int h = 0; h < 8; ++h) {
        __syncthreads();
#pragma unroll
        for (int i = 0; i < 8; ++i) { const int pc = tid + 512 * i, row = pc >> 4, ch = pc & 15;
            *(LAS v4u*)(L + row * SKP + ch * 16) = *(const v4u*)(SUBK + ((size_t)(2 * h) * 128 + row) * 128 + ch * 8); }
        __syncthreads();
        float kk[2][16];
#pragma unroll
        for (int p = 0; p < 2; ++p) {
            const int g = 2 * h + p;
            bf16x8 bq[8];
#pragma unroll
            for (int ks = 0; ks < 8; ++ks) bq[ks] = *(const bf16x8*)(PQ + t * 2048 + g * 128 + 16 * ks + 8 * hh);
            float a[16];
#pragma unroll
            for (int k = 0; k < 16; ++k) a[k] = -INFINITY;
#pragma unroll
            for (int nt = 0; nt < 4; ++nt) {
                f32x16 acc = {};
                const LAS unsigned char* arow = L + (p * 128 + 32 * nt + q32) * SKP + 16 * hh;
#pragma unroll
                for (int ks = 0; ks < 8; ++ks) acc = __builtin_amdgcn_mfma_f32_32x32x16_bf16(*(const LAS bf16x8*)(arow + 32 * ks), bq[ks], acc, 0, 0, 0);
#pragma unroll
                for (int r = 0; r < 16; ++r) { const int nconst = 32 * nt + (r & 3) + 8 * (r >> 2);
                    const float sv = acc[r];
                    const unsigned key = (__float_as_uint(sv) & 0xFFFFFF80u) | (unsigned)(127 - nconst - 4 * hh);
                    sort_insert16(a, __builtin_bit_cast(float, key)); }
            }
            merge_halves16(a);
#pragma unroll
            for (int k = 0; k < 16; ++k) { kk[p][k] = a[k]; lst[(p * 16 + k) * 32 + q32] = __builtin_bit_cast(unsigned, a[k]); }
        }
        float c2[16];
#pragma unroll
        for (int k = 0; k < 16; ++k) c2[k] = -INFINITY;
#pragma unroll
        for (int i = 0; i < 16; ++i)
#pragma unroll
            for (int j = 0; j < 16; ++j) if ((i + 1) * (j + 1) <= 16) {
                const float sm = kk[0][i] + kk[1][j];
                const unsigned key = (__builtin_bit_cast(unsigned, sm) & 0xFFFFFF00u) | (unsigned)(255 - (i * 16 + j));
                sort_insert16(c2, __builtin_bit_cast(float, key)); }
        LDS_WAIT(); asm volatile("" ::: "memory");
        float ex[16]; float sum = 0.f;
#pragma unroll
        for (int k = 0; k < 16; ++k) { ex[k] = __expf(c2[k] - c2[0]); sum += ex[k]; }
        const float inv = 1.0f / sum;
        unsigned outw[16];
#pragma unroll
        for (int k = 0; k < 16; ++k) { const unsigned pidx = 255u - (__builtin_bit_cast(unsigned, c2[k]) & 255u);
            const unsigned n0 = 127u - (lst[(pidx >> 4) * 32 + q32] & 127u), n1 = 127u - (lst[(16 + (pidx & 15u)) * 32 + q32] & 127u);
            outw[k] = ((n0 * 128u + n1) << 16) | f2bf(ex[k] * inv); }
        v4u w0, w1;
        w0.x = hh ? outw[8] : outw[0]; w0.y = hh ? outw[9] : outw[1]; w0.z = hh ? outw[10] : outw[2]; w0.w = hh ? outw[11] : outw[3];
        w1.x = hh ? outw[12] : outw[4]; w1.y = hh ? outw[13] : outw[5]; w1.z = hh ? outw[14] : outw[6]; w1.w = hh ? outw[15] : outw[7];
        v4u* dst = (v4u*)(ROUTE + t * 128 + h * 16 + 8 * hh);
        dst[0] = w0; dst[1] = w1;
        LDS_WAIT(); asm volatile("" ::: "memory");
    }
    }
}

__device__ __forceinline__ float gelu_tanh(float x) { const float z = 0.7978845608028654f * (x + 0.044715f * x * x * x); const float th = 1.0f - 2.0f / (1.0f + __expf(2.0f * z)); return 0.5f * x * (1.0f + th); }
__device__ __forceinline__ void peer_gather(Frame& F) {
    const unsigned short* H2 = (const unsigned short*)(F.ws + WS_H2);
    const unsigned short* U = (const unsigned short*)(F.ws + WS_U);
    const unsigned short* V = (const unsigned short*)(F.ws + WS_V);
    const unsigned* ROUTE = (const unsigned*)(F.ws + WS_ROUTE);
    const float* MOD = (const float*)(F.ws + WS_MOD);
    const float* fg = F.in[20];
    float* pp = (float*)(F.lds + F.wave * (64 * 65 * 4));
    const int lane = F.lane;
    for (int t = F.gw; t < T; t += F.NGW) {
        const int b = t >> 12;
        const v4u ha = ((const v4u*)(H2 + (size_t)t * 1024))[lane], hb = ((const v4u*)(H2 + (size_t)t * 1024))[64 + lane];
        const unsigned r0 = ROUTE[(size_t)t * 128 + lane], r1 = ROUTE[(size_t)t * 128 + 64 + lane];
        float coef0, coef1;
#pragma unroll
        for (int half = 0; half < 2; ++half) {
            const unsigned rr = half ? r1 : r0;
            for (int k = 0; k < 64; k += 4) {
                v4u ua[4], ub[4];
#pragma unroll
                for (int q = 0; q < 4; ++q) { const unsigned id = __builtin_amdgcn_readlane(rr, k + q) >> 16; const v4u* row = (const v4u*)(U + (size_t)id * 1024); ua[q] = row[lane]; ub[q] = row[64 + lane]; }
#pragma unroll
                for (int q = 0; q < 4; ++q) { float d = 0.f;
                    d = dot2c(d, ua[q].x, ha.x); d = dot2c(d, ua[q].y, ha.y); d = dot2c(d, ua[q].z, ha.z); d = dot2c(d, ua[q].w, ha.w);
                    d = dot2c(d, ub[q].x, hb.x); d = dot2c(d, ub[q].y, hb.y); d = dot2c(d, ub[q].z, hb.z); d = dot2c(d, ub[q].w, hb.w);
                    pp[(k + q) * 65 + lane] = d; }
            }
            LDS_WAIT(); asm volatile("" ::: "memory");
            float tot = 0.f;
#pragma unroll 8
            for (int i = 0; i < 64; ++i) tot += pp[lane * 65 + i];
            LDS_WAIT(); asm volatile("" ::: "memory");
            const float cf = bflo(rr) * gelu_tanh(tot);
            if (half) coef1 = cf; else coef0 = cf;
        }
        float o[16];
#pragma unroll
        for (int i = 0; i < 16; ++i) o[i] = 0.f;
#pragma unroll
        for (int half = 0; half < 2; ++half) {
            const unsigned rr = half ? r1 : r0; const float cfv = half ? coef1 : coef0;
            for (int k = 0; k < 64; k += 4) {
                v4u va[4], vb[4]; float cs[4];
#pragma unroll
                for (int q = 0; q < 4; ++q) { const unsigned id = __builtin_amdgcn_readlane(rr, k + q) >> 16; cs[q] = __builtin_bit_cast(float, __builtin_amdgcn_readlane(__builtin_bit_cast(unsigned, cfv), k + q));
                    const v4u* row = (const v4u*)(V + (size_t)id * 1024); va[q] = row[lane]; vb[q] = row[64 + lane]; }
#pragma unroll
                for (int q = 0; q < 4; ++q) { const float c = cs[q];
                    o[0] += c * bflo(va[q].x); o[1] += c * bfhi(va[q].x); o[2] += c * bflo(va[q].y); o[3] += c * bfhi(va[q].y);
                    o[4] += c * bflo(va[q].z); o[5] += c * bfhi(va[q].z); o[6] += c * bflo(va[q].w); o[7] += c * bfhi(va[q].w);
                    o[8] += c * bflo(vb[q].x); o[9] += c * bfhi(vb[q].x); o[10] += c * bflo(vb[q].y); o[11] += c * bfhi(vb[q].y);
                    o[12] += c * bflo(vb[q].z); o[13] += c * bfhi(vb[q].z); o[14] += c * bflo(vb[q].w); o[15] += c * bfhi(vb[q].w); }
            }
        }
        float* xrow = F.out + (size_t)t * 1024;
        const float* gt2 = MOD + b * 6144 + 5120;
        float x2[16]; float ss = 0.f;
#pragma unroll
        for (int c4 = 0; c4 < 4; ++c4) { const int e0 = (c4 < 2 ? 8 * lane + 4 * c4 : 512 + 8 * lane + 4 * (c4 - 2));
            const f32x4 xv = *(const f32x4*)(xrow + e0), gv = *(const f32x4*)(gt2 + e0);
#pragma unroll
            for (int i = 0; i < 4; ++i) { const float v = xv[i] + gv[i] * o[4 * c4 + i]; x2[4 * c4 + i] = v; ss += v * v; } }
        const float rstd = rsqrtf(wave_sum(ss) * (1.0f / 1024.0f) + EPS);
#pragma unroll
        for (int c4 = 0; c4 < 4; ++c4) { const int e0 = (c4 < 2 ? 8 * lane + 4 * c4 : 512 + 8 * lane + 4 * (c4 - 2));
            const f32x4 gv = *(const f32x4*)(fg + e0); f32x4 ov;
#pragma unroll
            for (int i = 0; i < 4; ++i) ov[i] = x2[4 * c4 + i] * rstd * gv[i];
            *(f32x4*)(xrow + e0) = ov; }
    }
}


__device__ __forceinline__ void peer_gather_fp8(Frame& F) {
    const unsigned short* H2 = (const unsigned short*)(F.ws + WS_H2);
    const unsigned char* U = F.ws + WS_U; const unsigned char* V = F.ws + WS_V;
    const float* USC = (const float*)(F.ws + WS_USC); const float* VSC = (const float*)(F.ws + WS_VSC);
    const unsigned* ROUTE = (const unsigned*)(F.ws + WS_ROUTE);
    const float* MOD = (const float*)(F.ws + WS_MOD);
    const float* fg = F.in[20];
    LAS float* pp = (LAS float*)F.lds + F.wave * (64 * 65);
    const int lane = F.lane;
    for (int t = F.gw; t < T; t += F.NGW) {
        const int b = t >> 12;
        f32x2_t hf[8];
        { const v4u ha = ((const v4u*)(H2 + (size_t)t * 1024))[2 * lane], hb = ((const v4u*)(H2 + (size_t)t * 1024))[2 * lane + 1];
          hf[0] = (f32x2_t){bflo(ha.x), bfhi(ha.x)}; hf[1] = (f32x2_t){bflo(ha.y), bfhi(ha.y)}; hf[2] = (f32x2_t){bflo(ha.z), bfhi(ha.z)}; hf[3] = (f32x2_t){bflo(ha.w), bfhi(ha.w)};
          hf[4] = (f32x2_t){bflo(hb.x), bfhi(hb.x)}; hf[5] = (f32x2_t){bflo(hb.y), bfhi(hb.y)}; hf[6] = (f32x2_t){bflo(hb.z), bfhi(hb.z)}; hf[7] = (f32x2_t){bflo(hb.w), bfhi(hb.w)}; }
        const unsigned r0 = ROUTE[(size_t)t * 128 + lane], r1 = ROUTE[(size_t)t * 128 + 64 + lane];
        const float su0 = USC[r0 >> 16], su1 = USC[r1 >> 16], sv0 = VSC[r0 >> 16], sv1 = VSC[r1 >> 16];
        float coef0 = 0.f, coef1 = 0.f;
#define LOAD8(dst, tab, rr, k0) do { _Pragma("unroll") for (int q = 0; q < 8; ++q) { const unsigned id = (__builtin_amdgcn_readlane(rr, (k0) + q) >> 16) & DBG_IDMASK; dst[q] = ((const v4u*)((tab) + (size_t)id * 1024))[lane]; } } while (0)
#define UDOT8(src, k0) do { _Pragma("unroll") for (int q = 0; q < 8; ++q) { const unsigned w[4] = {src[q].x, src[q].y, src[q].z, src[q].w}; f32x2_t acc = {0.f, 0.f}; \
            _Pragma("unroll") for (int j = 0; j < 4; ++j) { acc = __builtin_elementwise_fma(__builtin_amdgcn_cvt_pk_f32_fp8(w[j], false), hf[2 * j], acc); acc = __builtin_elementwise_fma(__builtin_amdgcn_cvt_pk_f32_fp8(w[j], true), hf[2 * j + 1], acc); } \
            pp[((k0) + q) * 65 + lane] = acc.x + acc.y; } } while (0)
#pragma unroll
        for (int half = 0; half < 2; ++half) {
            const unsigned rr = half ? r1 : r0;
            v4u ra[8], rb[8];
            LOAD8(ra, U, rr, 0);
            for (int kb = 0; kb < 64; kb += 16) {
                LOAD8(rb, U, rr, kb + 8);
                UDOT8(ra, kb);
                if (kb + 16 < 64) LOAD8(ra, U, rr, kb + 16);
                UDOT8(rb, kb + 8);
            }
            LDS_WAIT(); asm volatile("" ::: "memory");
            float tot = 0.f;
#pragma unroll 8
            for (int i = 0; i < 64; ++i) tot += pp[lane * 65 + i];
            LDS_WAIT(); asm volatile("" ::: "memory");
            const float cf = bflo(rr) * gelu_tanh(tot * (half ? su1 : su0)) * (half ? sv1 : sv0);
            if (half) coef1 = cf; else coef0 = cf;
        }
        f32x2_t o[8];
#pragma unroll
        for (int i = 0; i < 8; ++i) o[i] = (f32x2_t){0.f, 0.f};
#define VACC8(src, cfv, k0) do { _Pragma("unroll") for (int q = 0; q < 8; ++q) { const unsigned w[4] = {src[q].x, src[q].y, src[q].z, src[q].w}; \
            const float c = __uint_as_float(__builtin_amdgcn_readlane(__float_as_uint(cfv), (k0) + q)); const f32x2_t cc = {c, c}; \
            _Pragma("unroll") for (int j = 0; j < 4; ++j) { o[2 * j] = __builtin_elementwise_fma(__builtin_amdgcn_cvt_pk_f32_fp8(w[j], false), cc, o[2 * j]); o[2 * j + 1] = __builtin_elementwise_fma(__builtin_amdgcn_cvt_pk_f32_fp8(w[j], true), cc, o[2 * j + 1]); } } } while (0)
#pragma unroll
        for (int half = 0; half < 2; ++half) {
            const unsigned rr = half ? r1 : r0; const float cfv = half ? coef1 : coef0;
            v4u ra[8], rb[8];
            LOAD8(ra, V, rr, 0);
            for (int kb = 0; kb < 64; kb += 16) {
                LOAD8(rb, V, rr, kb + 8);
                VACC8(ra, cfv, kb);
                if (kb + 16 < 64) LOAD8(ra, V, rr, kb + 16);
                VACC8(rb, cfv, kb + 8);
            }
        }
#undef LOAD8
#undef UDOT8
#undef VACC8
        float* xrow = F.out + (size_t)t * 1024 + 16 * lane;
        const float* gt2 = MOD + b * 6144 + 5120 + 16 * lane;
        f32x4 x2[4]; float ss = 0.f;
#pragma unroll
        for (int c4 = 0; c4 < 4; ++c4) { const f32x4 xv = ((const f32x4*)xrow)[c4], gv = ((const f32x4*)gt2)[c4];
            f32x4 ov; ov.x = o[2 * c4].x; ov.y = o[2 * c4].y; ov.z = o[2 * c4 + 1].x; ov.w = o[2 * c4 + 1].y;
            x2[c4] = xv + gv * ov; ss += (x2[c4].x * x2[c4].x + x2[c4].y * x2[c4].y) + (x2[c4].z * x2[c4].z + x2[c4].w * x2[c4].w); }
        const float rstd = rsqrtf(wave_sum(ss) * (1.0f / 1024.0f) + EPS);
#pragma unroll
        for (int c4 = 0; c4 < 4; ++c4) { const f32x4 gv = ((const f32x4*)(fg + 16 * lane))[c4]; ((f32x4*)xrow)[c4] = x2[c4] * rstd * gv; }
    }
}


typedef unsigned u32x8_t __attribute__((ext_vector_type(8)));
typedef float f32x8_t __attribute__((ext_vector_type(8)));
__device__ __forceinline__ f32x2_t dot16_fp8(const v4u row, const f32x2_t (&h)[8]) {
    const unsigned w[4] = {row.x, row.y, row.z, row.w}; f32x2_t acc = {0.f, 0.f};
#pragma unroll
    for (int j = 0; j < 4; ++j) { acc = __builtin_elementwise_fma(__builtin_amdgcn_cvt_pk_f32_fp8(w[j], false), h[2 * j], acc); acc = __builtin_elementwise_fma(__builtin_amdgcn_cvt_pk_f32_fp8(w[j], true), h[2 * j + 1], acc); }
    return acc;
}
__device__ __forceinline__ void axpy16_fp8(const v4u row, const float c, f32x2_t (&o)[8]) {
    const unsigned w[4] = {row.x, row.y, row.z, row.w}; const f32x2_t cc = {c, c};
#pragma unroll
    for (int j = 0; j < 4; ++j) { o[2 * j] = __builtin_elementwise_fma(__builtin_amdgcn_cvt_pk_f32_fp8(w[j], false), cc, o[2 * j]); o[2 * j + 1] = __builtin_elementwise_fma(__builtin_amdgcn_cvt_pk_f32_fp8(w[j], true), cc, o[2 * j + 1]); }
}
__device__ __forceinline__ void load_h16(const unsigned short* H2, size_t t, int lane, f32x2_t (&hf)[8]) {
    const v4u ha = ((const v4u*)(H2 + t * 1024))[2 * lane], hb = ((const v4u*)(H2 + t * 1024))[2 * lane + 1];
    hf[0] = (f32x2_t){bflo(ha.x), bfhi(ha.x)}; hf[1] = (f32x2_t){bflo(ha.y), bfhi(ha.y)}; hf[2] = (f32x2_t){bflo(ha.z), bfhi(ha.z)}; hf[3] = (f32x2_t){bflo(ha.w), bfhi(ha.w)};
    hf[4] = (f32x2_t){bflo(hb.x), bfhi(hb.x)}; hf[5] = (f32x2_t){bflo(hb.y), bfhi(hb.y)}; hf[6] = (f32x2_t){bflo(hb.z), bfhi(hb.z)}; hf[7] = (f32x2_t){bflo(hb.w), bfhi(hb.w)};
}
__device__ __forceinline__ void peer_gather_sweep(Frame& F) {
    const unsigned short* H2 = (const unsigned short*)(F.ws + WS_H2);
    const unsigned char* U = F.ws + WS_U; const unsigned char* V = F.ws + WS_V;
    const float* USC = (const float*)(F.ws + WS_USC); const float* VSC = (const float*)(F.ws + WS_VSC);
    const unsigned* ROUTE = (const unsigned*)(F.ws + WS_ROUTE);
    const float* MOD = (const float*)(F.ws + WS_MOD);
    const float* fg = F.in[20];
    LAS float* pp = (LAS float*)F.lds + F.wave * (64 * 65);
    const int lane = F.lane;
    for (int bt = F.gw; bt < T / 4; bt += F.NGW) {
        const size_t tb = (size_t)bt * 4; const int b = (int)(tb >> 12);
        unsigned keys[8];
#pragma unroll
        for (int tk = 0; tk < 4; ++tk) { const unsigned r0 = ROUTE[(tb + tk) * 128 + lane], r1 = ROUTE[(tb + tk) * 128 + 64 + lane];
            keys[2 * tk] = ((r0 >> 16) << 18) | ((unsigned)tk << 16) | (r0 & 0xffffu); keys[2 * tk + 1] = ((r1 >> 16) << 18) | ((unsigned)tk << 16) | (r1 & 0xffffu); }
#pragma unroll
        for (int k = 2; k <= SW_SORT_MAX; k <<= 1) {
#pragma unroll
            for (int j = k >> 1; j > 0; j >>= 1) {
                if (j >= 64) { const int jr = j >> 6;
#pragma unroll
                    for (int r = 0; r < 8; ++r) if ((r & jr) == 0) { const bool asc = ((r * 64) & k) == 0; const unsigned a = keys[r], c = keys[r | jr], lo = a < c ? a : c, hi = a < c ? c : a; keys[r] = asc ? lo : hi; keys[r | jr] = asc ? hi : lo; }
                } else {
#pragma unroll
                    for (int r = 0; r < 8; ++r) { const unsigned o = (unsigned)__shfl_xor((int)keys[r], j); const bool asc = (((r * 64 + lane) & k) == 0), lower = (lane & j) == 0;
                        const unsigned mn = keys[r] < o ? keys[r] : o, mx = keys[r] < o ? o : keys[r]; keys[r] = (asc == lower) ? mn : mx; }
                }
            }
        }
        u32x8_t kv; kv[0] = keys[0]; kv[1] = keys[1]; kv[2] = keys[2]; kv[3] = keys[3]; kv[4] = keys[4]; kv[5] = keys[5]; kv[6] = keys[6]; kv[7] = keys[7];
        f32x8_t cfv = {};
        {
            f32x2_t h0[8], h1[8], h2[8], h3[8];
            load_h16(H2, tb, lane, h0); load_h16(H2, tb + 1, lane, h1); load_h16(H2, tb + 2, lane, h2); load_h16(H2, tb + 3, lane, h3);
            for (int c = 0; c < 8; ++c) {
                const unsigned kc = kv[c];
                v4u ra[4], rb[4];
#define SW_LOAD4(dst, tab, k0) do { _Pragma("unroll") for (int q = 0; q < 4; ++q) { const unsigned id = (unsigned)__builtin_amdgcn_readlane(kc, (k0) + q) >> 18; dst[q] = ((const v4u*)((tab) + (size_t)id * 1024))[lane]; } } while (0)
#define SW_UDOT4(src, k0) do { _Pragma("unroll") for (int q = 0; q < 4; ++q) { const unsigned tk = ((unsigned)__builtin_amdgcn_readlane(kc, (k0) + q) >> 16) & 3u; f32x2_t acc; \
                    if (tk == 0) acc = dot16_fp8(src[q], h0); else if (tk == 1) acc = dot16_fp8(src[q], h1); else if (tk == 2) acc = dot16_fp8(src[q], h2); else acc = dot16_fp8(src[q], h3); \
                    pp[((k0) + q) * 65 + lane] = acc.x + acc.y; } } while (0)
                SW_LOAD4(ra, U, 0);
                for (int kb = 0; kb < 64; kb += 8) {
                    SW_LOAD4(rb, U, kb + 4);
                    SW_UDOT4(ra, kb);
                    if (kb + 8 < 64) SW_LOAD4(ra, U, kb + 8);
                    SW_UDOT4(rb, kb + 4);
                }
#undef SW_UDOT4
                LDS_WAIT(); asm volatile("" ::: "memory");
                float tot = 0.f;
#pragma unroll 8
                for (int i = 0; i < 64; ++i) tot += pp[lane * 65 + i];
                LDS_WAIT(); asm volatile("" ::: "memory");
                const unsigned myid = kc >> 18;
                cfv[c] = bflo(kc) * gelu_tanh(tot * USC[myid]) * VSC[myid];
            }
        }
        f32x2_t o0[8], o1[8], o2[8], o3[8];
#pragma unroll
        for (int i = 0; i < 8; ++i) { o0[i] = (f32x2_t){0.f, 0.f}; o1[i] = o0[i]; o2[i] = o0[i]; o3[i] = o0[i]; }
        for (int c = 0; c < 8; ++c) {
            const unsigned kc = kv[c]; const unsigned cfb = __float_as_uint(cfv[c]);
            v4u ra[4], rb[4];
#define SW_VACC4(src, k0) do { _Pragma("unroll") for (int q = 0; q < 4; ++q) { const unsigned tk = ((unsigned)__builtin_amdgcn_readlane(kc, (k0) + q) >> 16) & 3u; const float cf = __uint_as_float(__builtin_amdgcn_readlane(cfb, (k0) + q)); \
                if (tk == 0) axpy16_fp8(src[q], cf, o0); else if (tk == 1) axpy16_fp8(src[q], cf, o1); else if (tk == 2) axpy16_fp8(src[q], cf, o2); else axpy16_fp8(src[q], cf, o3); } } while (0)
            SW_LOAD4(ra, V, 0);
            for (int kb = 0; kb < 64; kb += 8) {
                SW_LOAD4(rb, V, kb + 4);
                SW_VACC4(ra, kb);
                if (kb + 8 < 64) SW_LOAD4(ra, V, kb + 8);
                SW_VACC4(rb, kb + 4);
            }
#undef SW_VACC4
#undef SW_LOAD4
        }
#define SW_FIN(tk, oo) do { float* xrow = F.out + (tb + (tk)) * 1024 + 16 * lane; const float* gt2 = MOD + b * 6144 + 5120 + 16 * lane; f32x4 x2[4]; float ss = 0.f; \
            _Pragma("unroll") for (int c4 = 0; c4 < 4; ++c4) { const f32x4 xv = ((const f32x4*)xrow)[c4], gv = ((const f32x4*)gt2)[c4]; f32x4 ov; ov.x = oo[2 * c4].x; ov.y = oo[2 * c4].y; ov.z = oo[2 * c4 + 1].x; ov.w = oo[2 * c4 + 1].y; \
                x2[c4] = xv + gv * ov; ss += (x2[c4].x * x2[c4].x + x2[c4].y * x2[c4].y) + (x2[c4].z * x2[c4].z + x2[c4].w * x2[c4].w); } \
            const float rstd = rsqrtf(wave_sum(ss) * (1.0f / 1024.0f) + EPS); \
            _Pragma("unroll") for (int c4 = 0; c4 < 4; ++c4) { const f32x4 gv = ((const f32x4*)(fg + 16 * lane))[c4]; ((f32x4*)xrow)[c4] = x2[c4] * rstd * gv; } } while (0)
        SW_FIN(0, o0); SW_FIN(1, o1); SW_FIN(2, o2); SW_FIN(3, o3);
#undef SW_FIN
    }
}


__device__ __forceinline__ f32x2_t dot16_fp4(unsigned wx, unsigned wy, const f32x2_t (&h)[8]) {
    f32x2_t acc = {0.f, 0.f};
    acc = __builtin_elementwise_fma(__builtin_amdgcn_cvt_scalef32_pk_f32_fp4(wx, 1.0f, 0), h[0], acc); acc = __builtin_elementwise_fma(__builtin_amdgcn_cvt_scalef32_pk_f32_fp4(wx, 1.0f, 1), h[1], acc);
    acc = __builtin_elementwise_fma(__builtin_amdgcn_cvt_scalef32_pk_f32_fp4(wx, 1.0f, 2), h[2], acc); acc = __builtin_elementwise_fma(__builtin_amdgcn_cvt_scalef32_pk_f32_fp4(wx, 1.0f, 3), h[3], acc);
    acc = __builtin_elementwise_fma(__builtin_amdgcn_cvt_scalef32_pk_f32_fp4(wy, 1.0f, 0), h[4], acc); acc = __builtin_elementwise_fma(__builtin_amdgcn_cvt_scalef32_pk_f32_fp4(wy, 1.0f, 1), h[5], acc);
    acc = __builtin_elementwise_fma(__builtin_amdgcn_cvt_scalef32_pk_f32_fp4(wy, 1.0f, 2), h[6], acc); acc = __builtin_elementwise_fma(__builtin_amdgcn_cvt_scalef32_pk_f32_fp4(wy, 1.0f, 3), h[7], acc);
    return acc;
}
__device__ __forceinline__ void axpy16_fp4(unsigned wx, unsigned wy, const float c, f32x2_t (&o)[8]) {
    const f32x2_t cc = {c, c};
    o[0] = __builtin_elementwise_fma(__builtin_amdgcn_cvt_scalef32_pk_f32_fp4(wx, 1.0f, 0), cc, o[0]); o[1] = __builtin_elementwise_fma(__builtin_amdgcn_cvt_scalef32_pk_f32_fp4(wx, 1.0f, 1), cc, o[1]);
    o[2] = __builtin_elementwise_fma(__builtin_amdgcn_cvt_scalef32_pk_f32_fp4(wx, 1.0f, 2), cc, o[2]); o[3] = __builtin_elementwise_fma(__builtin_amdgcn_cvt_scalef32_pk_f32_fp4(wx, 1.0f, 3), cc, o[3]);
    o[4] = __builtin_elementwise_fma(__builtin_amdgcn_cvt_scalef32_pk_f32_fp4(wy, 1.0f, 0), cc, o[4]); o[5] = __builtin_elementwise_fma(__builtin_amdgcn_cvt_scalef32_pk_f32_fp4(wy, 1.0f, 1), cc, o[5]);
    o[6] = __builtin_elementwise_fma(__builtin_amdgcn_cvt_scalef32_pk_f32_fp4(wy, 1.0f, 2), cc, o[6]); o[7] = __builtin_elementwise_fma(__builtin_amdgcn_cvt_scalef32_pk_f32_fp4(wy, 1.0f, 3), cc, o[7]);
}

__device__ __forceinline__ float dot16_fp4_bf16(unsigned wx, unsigned wy, const v4u ha, const v4u hb) {
    float acc = 0.f;
    acc = __builtin_amdgcn_fdot2_f32_bf16(__builtin_amdgcn_cvt_scalef32_pk_bf16_fp4(wx, 1.0f, 0), __builtin_bit_cast(bf16x2_t, ha.x), acc, false);
    acc = __builtin_amdgcn_fdot2_f32_bf16(__builtin_amdgcn_cvt_scalef32_pk_bf16_fp4(wx, 1.0f, 1), __builtin_bit_cast(bf16x2_t, ha.y), acc, false);
    acc = __builtin_amdgcn_fdot2_f32_bf16(__builtin_amdgcn_cvt_scalef32_pk_bf16_fp4(wx, 1.0f, 2), __builtin_bit_cast(bf16x2_t, ha.z), acc, false);
    acc = __builtin_amdgcn_fdot2_f32_bf16(__builtin_amdgcn_cvt_scalef32_pk_bf16_fp4(wx, 1.0f, 3), __builtin_bit_cast(bf16x2_t, ha.w), acc, false);
    acc = __builtin_amdgcn_fdot2_f32_bf16(__builtin_amdgcn_cvt_scalef32_pk_bf16_fp4(wy, 1.0f, 0), __builtin_bit_cast(bf16x2_t, hb.x), acc, false);
    acc = __builtin_amdgcn_fdot2_f32_bf16(__builtin_amdgcn_cvt_scalef32_pk_bf16_fp4(wy, 1.0f, 1), __builtin_bit_cast(bf16x2_t, hb.y), acc, false);
    acc = __builtin_amdgcn_fdot2_f32_bf16(__builtin_amdgcn_cvt_scalef32_pk_bf16_fp4(wy, 1.0f, 2), __builtin_bit_cast(bf16x2_t, hb.z), acc, false);
    acc = __builtin_amdgcn_fdot2_f32_bf16(__builtin_amdgcn_cvt_scalef32_pk_bf16_fp4(wy, 1.0f, 3), __builtin_bit_cast(bf16x2_t, hb.w), acc, false);
    return acc;
}
__device__ __forceinline__ void peer_gather_fp4(Frame& F) {
    constexpr int GB = PEER_GB;
    typedef unsigned u32x2_t __attribute__((ext_vector_type(2)));
    const unsigned short* H2 = (const unsigned short*)(F.ws + WS_H2);
    const unsigned char* U = F.ws + WS_U; const unsigned char* V = F.ws + WS_V;
    const float* USC = (const float*)(F.ws + WS_USC); const float* VSC = (const float*)(F.ws + WS_VSC);
    const unsigned* ROUTE = (const unsigned*)(F.ws + WS_ROUTE);
    const float* MOD = (const float*)(F.ws + WS_MOD);
    const float* fg = F.in[20];
    LAS float* pp = (LAS float*)F.lds + F.wave * (64 * 65);
    const int lane = F.lane;
#define LOAD8(dst, tab, rr, k0) do { _Pragma("unroll") for (int q = 0; q < GB; ++q) { const unsigned id = (unsigned)__builtin_amdgcn_readlane(rr, (k0) + q) >> 16; dst[q] = ((const u32x2_t*)((tab) + (size_t)id * 512))[lane]; } } while (0)
    for (int tile = F.gw; tile < T / 32; tile += F.NGW) {
    unsigned r0n = ROUTE[(size_t)tile * 32 * 128 + lane], r1n = ROUTE[(size_t)tile * 32 * 128 + 64 + lane];
    for (int t = tile * 32; t < tile * 32 + 32; ++t) {
        const int b = t >> 12;
        const unsigned r0 = r0n, r1 = r1n;
        if (t + 1 < tile * 32 + 32) { r0n = ROUTE[(size_t)(t + 1) * 128 + lane]; r1n = ROUTE[(size_t)(t + 1) * 128 + 64 + lane]; }
        const float su0 = USC[r0 >> 16], su1 = USC[r1 >> 16], sv0 = VSC[r0 >> 16], sv1 = VSC[r1 >> 16];
        float coef0 = 0.f, coef1 = 0.f;
        {
            typedef int v8i_t __attribute__((ext_vector_type(8)));
            f32x2_t hf[8];
            load_h16(H2, (size_t)t, lane, hf);
            float mx = 0.f;
#pragma unroll
            for (int i2 = 0; i2 < 8; ++i2) mx = fmaxf(mx, fmaxf(fabsf(hf[i2].x), fabsf(hf[i2].y)));
            const float sc1 = 6.0f / fmaxf(lane63(scan_max64(mx)), 1e-30f);
            unsigned q1x = 0u, q1y = 0u;
            q1x = __builtin_amdgcn_cvt_scalef32_pk_fp4_f32(q1x, hf[0].x * sc1, hf[0].y * sc1, 1.0f, 0); q1x = __builtin_amdgcn_cvt_scalef32_pk_fp4_f32(q1x, hf[1].x * sc1, hf[1].y * sc1, 1.0f, 1);
            q1x = __builtin_amdgcn_cvt_scalef32_pk_fp4_f32(q1x, hf[2].x * sc1, hf[2].y * sc1, 1.0f, 2); q1x = __builtin_amdgcn_cvt_scalef32_pk_fp4_f32(q1x, hf[3].x * sc1, hf[3].y * sc1, 1.0f, 3);
            q1y = __builtin_amdgcn_cvt_scalef32_pk_fp4_f32(q1y, hf[4].x * sc1, hf[4].y * sc1, 1.0f, 0); q1y = __builtin_amdgcn_cvt_scalef32_pk_fp4_f32(q1y, hf[5].x * sc1, hf[5].y * sc1, 1.0f, 1);
            q1y = __builtin_amdgcn_cvt_scalef32_pk_fp4_f32(q1y, hf[6].x * sc1, hf[6].y * sc1, 1.0f, 2); q1y = __builtin_amdgcn_cvt_scalef32_pk_fp4_f32(q1y, hf[7].x * sc1, hf[7].y * sc1, 1.0f, 3);
            f32x2_t rs[8];
            rs[0] = hf[0] * sc1 - __builtin_amdgcn_cvt_scalef32_pk_f32_fp4(q1x, 1.0f, 0); rs[1] = hf[1] * sc1 - __builtin_amdgcn_cvt_scalef32_pk_f32_fp4(q1x, 1.0f, 1);
            rs[2] = hf[2] * sc1 - __builtin_amdgcn_cvt_scalef32_pk_f32_fp4(q1x, 1.0f, 2); rs[3] = hf[3] * sc1 - __builtin_amdgcn_cvt_scalef32_pk_f32_fp4(q1x, 1.0f, 3);
            rs[4] = hf[4] * sc1 - __builtin_amdgcn_cvt_scalef32_pk_f32_fp4(q1y, 1.0f, 0); rs[5] = hf[5] * sc1 - __builtin_amdgcn_cvt_scalef32_pk_f32_fp4(q1y, 1.0f, 1);
            rs[6] = hf[6] * sc1 - __builtin_amdgcn_cvt_scalef32_pk_f32_fp4(q1y, 1.0f, 2); rs[7] = hf[7] * sc1 - __builtin_amdgcn_cvt_scalef32_pk_f32_fp4(q1y, 1.0f, 3);
            float mr = 0.f;
#pragma unroll
            for (int i2 = 0; i2 < 8; ++i2) mr = fmaxf(mr, fmaxf(fabsf(rs[i2].x), fabsf(rs[i2].y)));
            const float sc2 = 6.0f / fmaxf(lane63(scan_max64(mr)), 1e-30f);
            unsigned q2x = 0u, q2y = 0u;
            q2x = __builtin_amdgcn_cvt_scalef32_pk_fp4_f32(q2x, rs[0].x * sc2, rs[0].y * sc2, 1.0f, 0); q2x = __builtin_amdgcn_cvt_scalef32_pk_fp4_f32(q2x, rs[1].x * sc2, rs[1].y * sc2, 1.0f, 1);
            q2x = __builtin_amdgcn_cvt_scalef32_pk_fp4_f32(q2x, rs[2].x * sc2, rs[2].y * sc2, 1.0f, 2); q2x = __builtin_amdgcn_cvt_scalef32_pk_fp4_f32(q2x, rs[3].x * sc2, rs[3].y * sc2, 1.0f, 3);
            q2y = __builtin_amdgcn_cvt_scalef32_pk_fp4_f32(q2y, rs[4].x * sc2, rs[4].y * sc2, 1.0f, 0); q2y = __builtin_amdgcn_cvt_scalef32_pk_fp4_f32(q2y, rs[5].x * sc2, rs[5].y * sc2, 1.0f, 1);
            q2y = __builtin_amdgcn_cvt_scalef32_pk_fp4_f32(q2y, rs[6].x * sc2, rs[6].y * sc2, 1.0f, 2); q2y = __builtin_amdgcn_cvt_scalef32_pk_fp4_f32(q2y, rs[7].x * sc2, rs[7].y * sc2, 1.0f, 3);
            LAS unsigned char* wl = (LAS unsigned char*)pp;
            *(LAS u32x2_t*)(wl + 8 * lane) = (u32x2_t){q1x, q1y}; *(LAS u32x2_t*)(wl + 512 + 8 * lane) = (u32x2_t){q2x, q2y};
            LDS_WAIT(); asm volatile("" ::: "memory");
            const int g = lane >> 4;
            v8i_t B1[8], B2[8];
#pragma unroll
            for (int s2 = 0; s2 < 8; ++s2) { const v4u b1 = *(const LAS v4u*)(wl + 64 * s2 + 16 * g), b2 = *(const LAS v4u*)(wl + 512 + 64 * s2 + 16 * g);
                B1[s2] = (v8i_t){(int)b1.x, (int)b1.y, (int)b1.z, (int)b1.w, 0, 0, 0, 0}; B2[s2] = (v8i_t){(int)b2.x, (int)b2.y, (int)b2.z, (int)b2.w, 0, 0, 0, 0}; }
            const float inv1 = 1.0f / sc1, inv12 = inv1 / sc2;
            LAS float* ttl = (LAS float*)(wl + 1024);
            v4u A0[8], A1[8];
#define LOADG(dst, eg) do { const unsigned idv = (unsigned)__shfl((int)((eg) < 4 ? r0 : r1), 16 * ((eg) & 3) + (lane & 15)) >> 16; const unsigned char* p_ = U + (size_t)idv * 512 + 16 * g; \
                _Pragma("unroll") for (int s2 = 0; s2 < 8; ++s2) dst[s2] = *(const v4u*)(p_ + 64 * s2); } while (0)
#define SCOREG(src, eg) do { f32x4 c1 = {0.f, 0.f, 0.f, 0.f}, c2 = {0.f, 0.f, 0.f, 0.f}; \
                _Pragma("unroll") for (int s2 = 0; s2 < 8; ++s2) { const v8i_t a8 = (v8i_t){(int)src[s2].x, (int)src[s2].y, (int)src[s2].z, (int)src[s2].w, 0, 0, 0, 0}; \
                    c1 = __builtin_amdgcn_mfma_scale_f32_16x16x128_f8f6f4(a8, B1[s2], c1, 4, 4, 0, 0, 0, 0); c2 = __builtin_amdgcn_mfma_scale_f32_16x16x128_f8f6f4(a8, B2[s2], c2, 4, 4, 0, 0, 0, 0); } \
                if ((lane & 15) == 0) { *(LAS f32x4*)(ttl + 16 * (eg) + 4 * g) = c1 * inv1 + c2 * inv12; } } while (0)
            LOADG(A0, 0);
#pragma unroll
            for (int eg = 0; eg < 8; eg += 2) {
                LOADG(A1, eg + 1);
                SCOREG(A0, eg);
                if (eg + 2 < 8) LOADG(A0, eg + 2);
                SCOREG(A1, eg + 1);
            }
#undef LOADG
#undef SCOREG
            LDS_WAIT(); asm volatile("" ::: "memory");
            const float tot0 = ttl[lane], tot1 = ttl[64 + lane];
            LDS_WAIT(); asm volatile("" ::: "memory");
            coef0 = bflo(r0) * gelu_tanh(tot0 * su0) * sv0;
            coef1 = bflo(r1) * gelu_tanh(tot1 * su1) * sv1;
        }
        f32x2_t o[8];
#pragma unroll
        for (int i = 0; i < 8; ++i) o[i] = (f32x2_t){0.f, 0.f};
#define VACC8(src, cfv, k0) do { _Pragma("unroll") for (int q = 0; q < GB; ++q) { \
            const float c = __uint_as_float(__builtin_amdgcn_readlane(__float_as_uint(cfv), (k0) + q)); axpy16_fp4(src[q].x, src[q].y, c, o); } } while (0)
#pragma unroll
        for (int half = 0; half < 2; ++half) {
            const unsigned rr = half ? r1 : r0; const float cfv = half ? coef1 : coef0;
            u32x2_t ra[GB], rb[GB];
            LOAD8(ra, V, rr, 0);
            for (int kb = 0; kb < 64; kb += 2 * GB) {
                LOAD8(rb, V, rr, kb + GB);
                VACC8(ra, cfv, kb);
                if (kb + 2 * GB < 64) LOAD8(ra, V, rr, kb + 2 * GB);
                VACC8(rb, cfv, kb + GB);
            }
        }
#undef VACC8
        float* xrow = F.out + (size_t)t * 1024 + 16 * lane;
        const float* gt2 = MOD + b * 6144 + 5120 + 16 * lane;
        const v4u xa = ((const v4u*)((const unsigned short*)(F.ws + WS_X1) + (size_t)t * 1024))[2 * lane], xb = ((const v4u*)((const unsigned short*)(F.ws + WS_X1) + (size_t)t * 1024))[2 * lane + 1];
        const f32x4 xin4[4] = {(f32x4){bflo(xa.x), bfhi(xa.x), bflo(xa.y), bfhi(xa.y)}, (f32x4){bflo(xa.z), bfhi(xa.z), bflo(xa.w), bfhi(xa.w)}, (f32x4){bflo(xb.x), bfhi(xb.x), bflo(xb.y), bfhi(xb.y)}, (f32x4){bflo(xb.z), bfhi(xb.z), bflo(xb.w), bfhi(xb.w)}};
        f32x4 x2[4]; float ss = 0.f;
#pragma unroll
        for (int c4 = 0; c4 < 4; ++c4) { const f32x4 xv = xin4[c4], gv = ((const f32x4*)gt2)[c4];
            f32x4 ov; ov.x = o[2 * c4].x; ov.y = o[2 * c4].y; ov.z = o[2 * c4 + 1].x; ov.w = o[2 * c4 + 1].y;
            x2[c4] = xv + gv * ov; ss += (x2[c4].x * x2[c4].x + x2[c4].y * x2[c4].y) + (x2[c4].z * x2[c4].z + x2[c4].w * x2[c4].w); }
        const float rstd = rsqrtf(wave_sum_u(ss) * (1.0f / 1024.0f) + EPS);
#pragma unroll
        for (int c4 = 0; c4 < 4; ++c4) { const f32x4 gv = ((const f32x4*)(fg + 16 * lane))[c4]; ((f32x4*)xrow)[c4] = x2[c4] * rstd * gv; }
    }
    }
#undef LOAD8
}


__device__ __forceinline__ void peer_gather_pipe(Frame& F) {
    typedef unsigned u32x2_t __attribute__((ext_vector_type(2)));
    typedef int v8i_t __attribute__((ext_vector_type(8)));
    const unsigned short* H2 = (const unsigned short*)(F.ws + WS_H2);
    const unsigned char* U = F.ws + WS_U; const unsigned char* V = F.ws + WS_V;
    const float* USC = (const float*)(F.ws + WS_USC); const float* VSC = (const float*)(F.ws + WS_VSC);
    const unsigned* ROUTE = (const unsigned*)(F.ws + WS_ROUTE);
    const float* MOD = (const float*)(F.ws + WS_MOD);
    const float* fg = F.in[20];
    LAS unsigned char* wl = (LAS unsigned char*)F.lds + F.wave * 2048;
    LAS float* ttl = (LAS float*)(wl + 1024);
    const int lane = F.lane, g = lane >> 4;
    v8i_t B1[8], B2[8]; float inv1 = 0.f, inv12 = 0.f;
    auto prep = [&](const v4u ha, const v4u hb) {
        f32x2_t hf[8];
        hf[0] = (f32x2_t){bflo(ha.x), bfhi(ha.x)}; hf[1] = (f32x2_t){bflo(ha.y), bfhi(ha.y)}; hf[2] = (f32x2_t){bflo(ha.z), bfhi(ha.z)}; hf[3] = (f32x2_t){bflo(ha.w), bfhi(ha.w)};
        hf[4] = (f32x2_t){bflo(hb.x), bfhi(hb.x)}; hf[5] = (f32x2_t){bflo(hb.y), bfhi(hb.y)}; hf[6] = (f32x2_t){bflo(hb.z), bfhi(hb.z)}; hf[7] = (f32x2_t){bflo(hb.w), bfhi(hb.w)};
        float mx = 0.f;
#pragma unroll
        for (int i2 = 0; i2 < 8; ++i2) mx = fmaxf(mx, fmaxf(fabsf(hf[i2].x), fabsf(hf[i2].y)));
        const float sc1 = 6.0f / fmaxf(lane63(scan_max64(mx)), 1e-30f);
        unsigned q1x = 0u, q1y = 0u;
        q1x = __builtin_amdgcn_cvt_scalef32_pk_fp4_f32(q1x, hf[0].x * sc1, hf[0].y * sc1, 1.0f, 0); q1x = __builtin_amdgcn_cvt_scalef32_pk_fp4_f32(q1x, hf[1].x * sc1, hf[1].y * sc1, 1.0f, 1);
        q1x = __builtin_amdgcn_cvt_scalef32_pk_fp4_f32(q1x, hf[2].x * sc1, hf[2].y * sc1, 1.0f, 2); q1x = __builtin_amdgcn_cvt_scalef32_pk_fp4_f32(q1x, hf[3].x * sc1, hf[3].y * sc1, 1.0f, 3);
        q1y = __builtin_amdgcn_cvt_scalef32_pk_fp4_f32(q1y, hf[4].x * sc1, hf[4].y * sc1, 1.0f, 0); q1y = __builtin_amdgcn_cvt_scalef32_pk_fp4_f32(q1y, hf[5].x * sc1, hf[5].y * sc1, 1.0f, 1);
        q1y = __builtin_amdgcn_cvt_scalef32_pk_fp4_f32(q1y, hf[6].x * sc1, hf[6].y * sc1, 1.0f, 2); q1y = __builtin_amdgcn_cvt_scalef32_pk_fp4_f32(q1y, hf[7].x * sc1, hf[7].y * sc1, 1.0f, 3);
        f32x2_t rs[8];
        rs[0] = hf[0] * sc1 - __builtin_amdgcn_cvt_scalef32_pk_f32_fp4(q1x, 1.0f, 0); rs[1] = hf[1] * sc1 - __builtin_amdgcn_cvt_scalef32_pk_f32_fp4(q1x, 1.0f, 1);
        rs[2] = hf[2] * sc1 - __builtin_amdgcn_cvt_scalef32_pk_f32_fp4(q1x, 1.0f, 2); rs[3] = hf[3] * sc1 - __builtin_amdgcn_cvt_scalef32_pk_f32_fp4(q1x, 1.0f, 3);
        rs[4] = hf[4] * sc1 - __builtin_amdgcn_cvt_scalef32_pk_f32_fp4(q1y, 1.0f, 0); rs[5] = hf[5] * sc1 - __builtin_amdgcn_cvt_scalef32_pk_f32_fp4(q1y, 1.0f, 1);
        rs[6] = hf[6] * sc1 - __builtin_amdgcn_cvt_scalef32_pk_f32_fp4(q1y, 1.0f, 2); rs[7] = hf[7] * sc1 - __builtin_amdgcn_cvt_scalef32_pk_f32_fp4(q1y, 1.0f, 3);
        float mr = 0.f;
#pragma unroll
        for (int i2 = 0; i2 < 8; ++i2) mr = fmaxf(mr, fmaxf(fabsf(rs[i2].x), fabsf(rs[i2].y)));
        const float sc2 = 6.0f / fmaxf(lane63(scan_max64(mr)), 1e-30f);
        unsigned q2x = 0u, q2y = 0u;
        q2x = __builtin_amdgcn_cvt_scalef32_pk_fp4_f32(q2x, rs[0].x * sc2, rs[0].y * sc2, 1.0f, 0); q2x = __builtin_amdgcn_cvt_scalef32_pk_fp4_f32(q2x, rs[1].x * sc2, rs[1].y * sc2, 1.0f, 1);
        q2x = __builtin_amdgcn_cvt_scalef32_pk_fp4_f32(q2x, rs[2].x * sc2, rs[2].y * sc2, 1.0f, 2); q2x = __builtin_amdgcn_cvt_scalef32_pk_fp4_f32(q2x, rs[3].x * sc2, rs[3].y * sc2, 1.0f, 3);
        q2y = __builtin_amdgcn_cvt_scalef32_pk_fp4_f32(q2y, rs[4].x * sc2, rs[4].y * sc2, 1.0f, 0); q2y = __builtin_amdgcn_cvt_scalef32_pk_fp4_f32(q2y, rs[5].x * sc2, rs[5].y * sc2, 1.0f, 1);
        q2y = __builtin_amdgcn_cvt_scalef32_pk_fp4_f32(q2y, rs[6].x * sc2, rs[6].y * sc2, 1.0f, 2); q2y = __builtin_amdgcn_cvt_scalef32_pk_fp4_f32(q2y, rs[7].x * sc2, rs[7].y * sc2, 1.0f, 3);
        *(LAS u32x2_t*)(wl + 8 * lane) = (u32x2_t){q1x, q1y}; *(LAS u32x2_t*)(wl + 512 + 8 * lane) = (u32x2_t){q2x, q2y};
        LDS_WAIT(); asm volatile("" ::: "memory");
#pragma unroll
        for (int s2 = 0; s2 < 8; ++s2) { const v4u b1 = *(const LAS v4u*)(wl + 64 * s2 + 16 * g), b2 = *(const LAS v4u*)(wl + 512 + 64 * s2 + 16 * g);
            B1[s2] = (v8i_t){(int)b1.x, (int)b1.y, (int)b1.z, (int)b1.w, 0, 0, 0, 0}; B2[s2] = (v8i_t){(int)b2.x, (int)b2.y, (int)b2.z, (int)b2.w, 0, 0, 0, 0}; }
        LDS_WAIT(); asm volatile("" ::: "memory");
        inv1 = 1.0f / sc1; inv12 = inv1 / sc2;
    };
#define PLOADG(dst, ra_, rb_, eg) do { const unsigned idv = (unsigned)__shfl((int)((eg) < 4 ? ra_ : rb_), 16 * ((eg) & 3) + (lane & 15)) >> 16; const unsigned char* p_ = U + (size_t)idv * 512 + 16 * g; \
        _Pragma("unroll") for (int s2 = 0; s2 < 8; ++s2) dst[s2] = *(const v4u*)(p_ + 64 * s2); } while (0)
#define PSCOREG(src, eg) do { f32x4 c1 = {0.f, 0.f, 0.f, 0.f}, c2 = {0.f, 0.f, 0.f, 0.f}; \
        _Pragma("unroll") for (int s2 = 0; s2 < 8; ++s2) { const v8i_t a8 = (v8i_t){(int)src[s2].x, (int)src[s2].y, (int)src[s2].z, (int)src[s2].w, 0, 0, 0, 0}; \
            c1 = __builtin_amdgcn_mfma_scale_f32_16x16x128_f8f6f4(a8, B1[s2], c1, 4, 4, 0, 0, 0, 0); c2 = __builtin_amdgcn_mfma_scale_f32_16x16x128_f8f6f4(a8, B2[s2], c2, 4, 4, 0, 0, 0, 0); } \
        if ((lane & 15) == 0) { *(LAS f32x4*)(ttl + 16 * (eg) + 4 * g) = c1 * inv1 + c2 * inv12; } } while (0)
#define PLOADV(dst, rr, k0) do { _Pragma("unroll") for (int q = 0; q < 8; ++q) { const unsigned id = (unsigned)__builtin_amdgcn_readlane(rr, (k0) + q) >> 16; dst[q] = ((const u32x2_t*)(V + (size_t)id * 512))[lane]; } } while (0)
#define PVACC(src, cfv, k0) do { _Pragma("unroll") for (int q = 0; q < 8; ++q) { const float c = __uint_as_float(__builtin_amdgcn_readlane(__float_as_uint(cfv), (k0) + q)); axpy16_fp4(src[q].x, src[q].y, c, o); } } while (0)
    for (int tile = F.gw; tile < T / 32; tile += F.NGW) {
        const int t0 = tile * 32, t1 = t0 + 32;
        unsigned r0c = ROUTE[(size_t)t0 * 128 + lane], r1c = ROUTE[(size_t)t0 * 128 + 64 + lane];
        unsigned r0n = ROUTE[(size_t)(t0 + 1) * 128 + lane], r1n = ROUTE[(size_t)(t0 + 1) * 128 + 64 + lane];
        v4u han = ((const v4u*)(H2 + (size_t)(t0 + 1) * 1024))[2 * lane], hbn = ((const v4u*)(H2 + (size_t)(t0 + 1) * 1024))[2 * lane + 1];
        float coef0c, coef1c;
        {
            const v4u ha = ((const v4u*)(H2 + (size_t)t0 * 1024))[2 * lane], hb = ((const v4u*)(H2 + (size_t)t0 * 1024))[2 * lane + 1];
            const float su0 = USC[r0c >> 16], su1 = USC[r1c >> 16], sv0 = VSC[r0c >> 16], sv1 = VSC[r1c >> 16];
            prep(ha, hb);
            v4u A0[8], A1[8];
            PLOADG(A0, r0c, r1c, 0);
#pragma unroll
            for (int eg = 0; eg < 8; eg += 2) { PLOADG(A1, r0c, r1c, eg + 1); PSCOREG(A0, eg); if (eg + 2 < 8) PLOADG(A0, r0c, r1c, eg + 2); PSCOREG(A1, eg + 1); }
            LDS_WAIT(); asm volatile("" ::: "memory");
            const float tot0 = ttl[lane], tot1 = ttl[64 + lane];
            LDS_WAIT(); asm volatile("" ::: "memory");
            coef0c = bflo(r0c) * gelu_tanh(tot0 * su0) * sv0; coef1c = bflo(r1c) * gelu_tanh(tot1 * su1) * sv1;
        }
        for (int t = t0; t < t1; ++t) {
            const int b = t >> 12;
            const int t2 = (t + 2 < t1) ? t + 2 : t1 - 1;
            const unsigned r0nn = ROUTE[(size_t)t2 * 128 + lane], r1nn = ROUTE[(size_t)t2 * 128 + 64 + lane];
            const v4u hann = ((const v4u*)(H2 + (size_t)t2 * 1024))[2 * lane], hbnn = ((const v4u*)(H2 + (size_t)t2 * 1024))[2 * lane + 1];
            const float su0 = USC[r0n >> 16], su1 = USC[r1n >> 16], sv0 = VSC[r0n >> 16], sv1 = VSC[r1n >> 16];
            const bool has_next = (t + 1 < t1);
            v4u A0[8];
            if (has_next) { prep(han, hbn);
                PLOADG(A0, r0n, r1n, 0); }
            f32x2_t o[8];
#pragma unroll
            for (int i2 = 0; i2 < 8; ++i2) o[i2] = (f32x2_t){0.f, 0.f};
            u32x2_t va[8], vb[8];
            PLOADV(va, r0c, 0);
#pragma unroll 1
            for (int kk = 0; kk < 4; ++kk) {
                const unsigned rr = (kk < 2) ? r0c : r1c, rr2 = (kk + 1 < 2) ? r0c : r1c; const float cfv = (kk < 2) ? coef0c : coef1c; const int kb = 32 * (kk & 1);
                PLOADV(vb, rr, kb + 8);
                PVACC(va, cfv, kb);
                PLOADV(va, rr, kb + 16);
                if (has_next) { PSCOREG(A0, 2 * kk);
                    PLOADG(A0, r0n, r1n, 2 * kk + 1); }
                PVACC(vb, cfv, kb + 8);
                PLOADV(vb, rr, kb + 24);
                PVACC(va, cfv, kb + 16);
                if (kk < 3) PLOADV(va, rr2, (kb + 32) & 63);
                if (has_next) { PSCOREG(A0, 2 * kk + 1);
                    if (kk < 3) PLOADG(A0, r0n, r1n, 2 * kk + 2); }
                PVACC(vb, cfv, kb + 24);
            }
            float coef0n, coef1n;
            {
                LDS_WAIT(); asm volatile("" ::: "memory");
                const float tot0 = ttl[lane], tot1 = ttl[64 + lane];
                LDS_WAIT(); asm volatile("" ::: "memory");
                coef0n = bflo(r0n) * gelu_tanh(tot0 * su0) * sv0; coef1n = bflo(r1n) * gelu_tanh(tot1 * su1) * sv1;
            }
            float* xrow = F.out + (size_t)t * 1024 + 16 * lane;
            const float* gt2 = MOD + b * 6144 + 5120 + 16 * lane;
            const v4u xa = ((const v4u*)((const unsigned short*)(F.ws + WS_X1) + (size_t)t * 1024))[2 * lane], xb = ((const v4u*)((const unsigned short*)(F.ws + WS_X1) + (size_t)t * 1024))[2 * lane + 1];
            const f32x4 xin4[4] = {(f32x4){bflo(xa.x), bfhi(xa.x), bflo(xa.y), bfhi(xa.y)}, (f32x4){bflo(xa.z), bfhi(xa.z), bflo(xa.w), bfhi(xa.w)}, (f32x4){bflo(xb.x), bfhi(xb.x), bflo(xb.y), bfhi(xb.y)}, (f32x4){bflo(xb.z), bfhi(xb.z), bflo(xb.w), bfhi(xb.w)}};
            f32x4 x2[4]; float ss = 0.f;
#pragma unroll
            for (int c4 = 0; c4 < 4; ++c4) { const f32x4 xv = xin4[c4], gv = ((const f32x4*)gt2)[c4];
                f32x4 ov; ov.x = o[2 * c4].x; ov.y = o[2 * c4].y; ov.z = o[2 * c4 + 1].x; ov.w = o[2 * c4 + 1].y;
                x2[c4] = xv + gv * ov; ss += (x2[c4].x * x2[c4].x + x2[c4].y * x2[c4].y) + (x2[c4].z * x2[c4].z + x2[c4].w * x2[c4].w); }
            const float rstd = rsqrtf(wave_sum_u(ss) * (1.0f / 1024.0f) + EPS);
#pragma unroll
            for (int c4 = 0; c4 < 4; ++c4) { const f32x4 gv = ((const f32x4*)(fg + 16 * lane))[c4]; ((f32x4*)xrow)[c4] = x2[c4] * rstd * gv; }
            r0c = r0n; r1c = r1n; r0n = r0nn; r1n = r1nn; han = hann; hbn = hbnn; coef0c = coef0n; coef1c = coef1n;
        }
    }
#undef PLOADG
#undef PSCOREG
#undef PLOADV
#undef PVACC
}

constexpr int N_PHASES = 12;
#ifndef PEER_FP8
#define PEER_FP8 1
#endif
#ifndef USE_ROUTE_REF
#define USE_ROUTE_REF 0
#endif
#ifndef USE_MLSTM_REF
#define USE_MLSTM_REF 0
#endif
#ifndef USE_ATTN_REF
#define USE_ATTN_REF 0
#endif
#ifndef MK_ONE_LAUNCH
#define MK_ONE_LAUNCH 0
#endif
__global__ void __launch_bounds__(NWAVES * 64, 2) fwd_kernel(Args args) {
    extern __shared__ __attribute__((aligned(16))) unsigned char lds[];
    Frame F;
    F.lds = lds; F.tid = threadIdx.x; F.lane = F.tid & 63; F.wave = __builtin_amdgcn_readfirstlane(F.tid >> 6);
    F.G = gridDim.x; F.gw = blockIdx.x * NWAVES + F.wave; F.NGW = F.G * NWAVES;
#pragma unroll
    for (int i = 0; i < 21; ++i) F.in[i] = args.in[i];
    F.out = args.out; F.ws = args.ws;
    LAS unsigned char* ldsl = (LAS unsigned char*)lds;
    volatile LAS unsigned* MISC = (volatile LAS unsigned*)(ldsl + MISC_OFF);
    for (int u = F.tid; u < (LDS_BYTES - MISC_OFF) / 4; u += NWAVES * 64) ((LAS unsigned*)(ldsl + MISC_OFF))[u] = 0u;
    __syncthreads();
    unsigned* ctl = (unsigned*)(F.ws + WS_CTL);
    XcdBarrier bar; bar.bar = ctl + CW_BAR; bar.x = 0; bar.st = nullptr;
    const bool one = (args.ph_hi - args.ph_lo) > 1;
    if (one) bar = xcd_barrier_post(ctl + CW_BAR, MISC + 8);
    const int lo = args.ph_lo, hi = args.ph_hi;
#define IN(k) (lo <= (k) && (k) < hi)
#ifdef DBG_TIME
    unsigned long long dbg_t0 = __builtin_amdgcn_s_memrealtime(), dbg_t1 = 0;
#define SEAM(k) do { if (IN(k) && IN((k) + 1)) xcd_barrier(bar); if ((k) + 1 == DBG_TIME) dbg_t0 = __builtin_amdgcn_s_memrealtime(); if ((k) == DBG_TIME) dbg_t1 = __builtin_amdgcn_s_memrealtime(); } while (0)
#else
#define SEAM(k) do { if (IN(k) && IN((k) + 1)) xcd_barrier(bar); } while (0)
#endif
    if (IN(0)) { p0_prologue(F); } SEAM(0);
    if (IN(1)) { norm_mod_rows<true>(F, F.in[0], F.in[4], 0, 1024, (unsigned short*)(F.ws + WS_H1)); } SEAM(1);
#if PROJ_ALL_FP8
    if (IN(2)) { pg8::Gemm g{(const pg8::bf16_t*)(F.ws + WS_H1Q), (const pg8::bf16_t*)(F.ws + WS_WINQ), T, NPROJ_ALL, 512};
        pg8::StaticOrder S; S.init(T, NPROJ_ALL, F.G, (int)blockIdx.x);
        Epi<EPI_ROUTE> E{F.ws, F.in[0], F.out, 2}; pg8::gemm_phase<Epi<EPI_ROUTE>, pg8::StaticOrder, true, true, true>(ldsl, g, S, E); } SEAM(2);
#else
    if (IN(2)) {
        { pg8::Gemm g{(const pg8::bf16_t*)(F.ws + WS_H1), (const pg8::bf16_t*)(F.ws + WS_WIN), T, NPROJ_B, 1024}; pg8::StaticOrder S; S.init(T, NPROJ_B, F.G, (int)blockIdx.x);
          Epi<EPI_ROUTE> E{F.ws, F.in[0], F.out, 0}; pg8::gemm_phase<Epi<EPI_ROUTE>, pg8::StaticOrder, true, true>(ldsl, g, S, E); }
        { pg8::Gemm g{(const pg8::bf16_t*)(F.ws + WS_H1Q), (const pg8::bf16_t*)(F.ws + WS_WINQ), T, NPROJ_Q, 512};
          pg8::StaticOrder S; S.init(T, NPROJ_Q, F.G, (int)blockIdx.x);
          Epi<EPI_ROUTE> E{F.ws, F.in[0], F.out, 1}; pg8::gemm_phase<Epi<EPI_ROUTE>, pg8::StaticOrder, true, true, true>(ldsl, g, S, E); }
    } SEAM(2);
#endif
    if (IN(3)) {
#if ML_SPLIT
        mlstm_gate_stats(F);
#endif
        qk_conv_pass(F); } SEAM(3);
    if (IN(4)) {
#if ML_SPLIT
#endif
#if USE_MLSTM_REF
        if (blockIdx.x < 64) mlstm_ref_unit(F, blockIdx.x >> 2, blockIdx.x & 3);
#else
#ifndef DBG_SKIP_MLSTM
        if (blockIdx.x < 64) mlstm_unit(F, blockIdx.x >> 2, blockIdx.x & 3);
#else
        if (0) {}
#endif
#endif
        else {
#if ML_SPLIT
            mlstm_intra_tasks(F);
#endif
#if USE_ATTN_REF
            const int nw = (F.G - 64) * NWAVES, w0 = (blockIdx.x - 64) * NWAVES + F.wave; for (int it = w0; it < T * 8; it += nw) attn_ref_item(F, it >> 3, it & 7);
#else
#ifndef DBG_SKIP_ATTN
            for (int u = blockIdx.x - 64; u < 2048; u += F.G - 64) { attn_unit(F, u >> 7, (u >> 4) & 7, 4 * (u & 15)); }
#endif
            late_weight_copies(F, (blockIdx.x - 64) * NWAVES + F.wave, (F.G - 64) * NWAVES);
#endif
        }
    } SEAM(4);
    if (IN(5)) { pg8::Gemm g{(const pg8::bf16_t*)(F.ws + WS_YA), (const pg8::bf16_t*)(F.ws + WS_WA), T, 1024, 512, (const pg8::bf16_t*)(F.ws + WS_YB), (const pg8::bf16_t*)(F.ws + WS_WB)};
        pg8::TwoPassOrder S; S.init(T, 1024, F.G, (int)blockIdx.x);
        Epi<EPI_MERGE> E{F.ws, F.in[0], F.out}; pg8::gemm_phase<Epi<EPI_MERGE>, pg8::TwoPassOrder, true, true>(ldsl, g, S, E); }
    SEAM(6);
    if (IN(7)) { pg8::Gemm g{(const pg8::bf16_t*)(F.ws + WS_Y), (const pg8::bf16_t*)(F.ws + WS_WOUT), T, 1024, 1024}; pg8::StaticOrder S; S.init(T, 1024, F.G, (int)blockIdx.x);
        Epi<EPI_OUTPROJ> E{F.ws, F.in[0], F.out}; pg8::gemm_phase<Epi<EPI_OUTPROJ>, pg8::StaticOrder, true, true>(ldsl, g, S, E); } SEAM(7);
    if (IN(8)) { norm_mod_rows<false, true>(F, (const float*)(F.ws + WS_X1), F.in[15], 3072, 4096, (unsigned short*)(F.ws + WS_H2)); } SEAM(8);
    if (IN(9)) { pg8::Gemm g{(const pg8::bf16_t*)(F.ws + WS_H2), (const pg8::bf16_t*)(F.ws + WS_WPQ), T, 2048, 1024}; pg8::StaticOrder S; S.init(T, 2048, F.G, (int)blockIdx.x);
        Epi<EPI_PQ> E{F.ws, F.in[0], F.out}; pg8::gemm_phase<Epi<EPI_PQ>, pg8::StaticOrder, true, true>(ldsl, g, S, E); } SEAM(9);
#if USE_ROUTE_REF
    if (IN(10)) { peer_route_ref(F); } SEAM(10);
#else
    if (IN(10)) { peer_route_mfma(F); asm volatile("s_waitcnt vmcnt(0)" ::: "memory"); __syncthreads(); }
#endif
#if PEER_FP4 && PEER_PIPE
    if (IN(11)) { peer_gather_pipe(F); }
#elif PEER_FP4
    if (IN(11)) { peer_gather_fp4(F); }
#elif PEER_FP8 && PEER_SWEEP
    if (IN(11)) { peer_gather_sweep(F); }
#elif PEER_FP8
    if (IN(11)) { peer_gather_fp8(F); }
#else
    if (IN(11)) { peer_gather(F); }
#endif
#ifdef DBG_TIME
    if (DBG_TIME == 11 || DBG_TIME == 99) dbg_t1 = __builtin_amdgcn_s_memrealtime();
    __syncthreads();
    if (blockIdx.x == 0 && F.tid == 0) { asm volatile("s_waitcnt vmcnt(0)" ::: "memory"); F.out[0] = (float)((dbg_t1 - dbg_t0) / DBG_TQ) * (float)(DBG_TQ / 1000); }
#endif
#ifdef DBG_DUMP
    if (hi < N_PHASES) { xcd_barrier(bar);
        for (int t = F.gw; t < T; t += F.NGW) { float* o = F.out + (size_t)t * 1024;
            for (int c = F.lane; c < 1024; c += 64) { float v = 0.f;
                if (DBG_DUMP == 8) v = bf2f(((const unsigned short*)(F.ws + WS_H2))[(size_t)t * 1024 + c]);
                if (DBG_DUMP == 9) v = bf2f(((const unsigned short*)(F.ws + WS_PQ))[(size_t)t * 2048 + c]) + 3.0f * bf2f(((const unsigned short*)(F.ws + WS_PQ))[(size_t)t * 2048 + 1024 + c]);
                if (DBG_DUMP == 10) v = (float)(((const unsigned*)(F.ws + WS_ROUTE))[(size_t)t * 128 + (c & 127)] >> ((c & 128) ? 16 : 0) & 0xffff) * (1.0f / 4096.0f);
                o[c] = v; } } }
#endif
#undef IN
#undef SEAM
}

extern "C" void kernel_launch(void* const* d_in, const int* in_sizes, int n_in, void* d_out, int out_size, void* d_ws, size_t ws_size, hipStream_t stream) {
    static int grid = 0;
    if (grid == 0) {
        if (n_in != 21 || out_size != T * DM || ws_size < WS_END) { fprintf(stderr, "kernel_launch: unexpected shapes (n_in %d, out %d, ws %zu); nothing launched\n", n_in, out_size, ws_size); grid = -1; return; }
        int dev = 0, cus = 0;
        if (hipGetDevice(&dev) != hipSuccess || hipDeviceGetAttribute(&cus, hipDeviceAttributeMultiprocessorCount, dev) != hipSuccess) { grid = -1; return; }
        if (hipFuncSetAttribute((const void*)fwd_kernel, hipFuncAttributeMaxDynamicSharedMemorySize, LDS_BYTES) != hipSuccess) { fprintf(stderr, "kernel_launch: hipFuncSetAttribute failed\n"); grid = -1; return; }
        int per_cu = 0;
        if (hipOccupancyMaxActiveBlocksPerMultiprocessor(&per_cu, (const void*)fwd_kernel, NWAVES * 64, LDS_BYTES) != hipSuccess || per_cu < 1) fprintf(stderr, "kernel_launch: occupancy query reports %d\n", per_cu);
        (void)hipGetLastError();
        grid = cus < 256 ? cus : 256;
    }
    if (grid < 0) return;
    (void)hipMemsetAsync((char*)d_ws + WS_CTL, 0, CTL_ZERO_BYTES, stream);
    Args a{};
    for (int i = 0; i < 21; ++i) a.in[i] = (const float*)d_in[i];
    a.out = (float*)d_out; a.ws = (unsigned char*)d_ws;
#if MK_ONE_LAUNCH
#ifndef DBG_STOP
#define DBG_STOP N_PHASES
#endif
    a.ph_lo = 0; a.ph_hi = DBG_STOP; a.li = 0;
    hipLaunchKernelGGL(fwd_kernel, dim3(grid), dim3(NWAVES * 64), LDS_BYTES, stream, a);
#else
    for (int li = 0; li < N_PHASES; ++li) { a.ph_lo = li; a.ph_hi = li + 1; a.li = li; hipLaunchKernelGGL(fwd_kernel, dim3(grid), dim3(NWAVES * 64), LDS_BYTES, stream, a); }
#endif
}
```

```cpp
#include <hip/hip_runtime.h>
#include <cstdio>
#include <cstdint>
#include <cmath>
#define MK_ONE_LAUNCH 1
namespace pg8 {
#define PG8_LAS __attribute__((address_space(3)))
typedef unsigned short bf16_t;
typedef short bf16x8 __attribute__((ext_vector_type(8)));
typedef float f32x4 __attribute__((ext_vector_type(4)));
typedef unsigned u32x4 __attribute__((ext_vector_type(4)));
typedef int pg8_v4i __attribute__((ext_vector_type(4)));
typedef int pg8_v8i __attribute__((ext_vector_type(8)));
constexpr int BM = 256, BK = 64, HALF = 128, HTB = HALF * BK * 2  , STAGE_BYTES = 8 * HTB, NXCD = 8, WGM = 8;

__host__ __device__ __forceinline__ int lds_byte(int r, int c) { const int st = (r >> 4) * 2 + (c >> 5), rr = r & 15, cc = c & 31, ob = rr * 64 + cc * 2; return st * 1024 + (ob ^ (((ob >> 9) & 1) << 5)); }
__host__ __device__ __forceinline__ void stage_rc(int b, int& R, int& C) { const int st = b / 1024, sb = b % 1024, swz = sb ^ (((sb >> 9) & 1) << 5); R = (st >> 1) * 16 + swz / 64; C = (st & 1) * 32 + (swz % 64) / 2; }
__host__ __device__ __forceinline__ int perm32(int rho) { const int n = rho >> 4, i = rho & 15; return 8 * (i >> 2) + 4 * n + (i & 3); }

struct Unit { int pm, pn, half; };
struct Gemm { const bf16_t* A; const bf16_t* Bt; int M, N, K; const bf16_t* A2 = nullptr; const bf16_t* Bt2 = nullptr; };

struct StaticOrder {
    int nM, nN, nwg, G, c;
    __host__ __device__ void init(int M, int N, int G_, int c_) { nM = M / BM; nN = N / BM; nwg = nM * nN; G = G_; c = c_; }
    __host__ __device__ bool next(int i, Unit& u) const {
        const long L = (long)i * G + c; if (L >= nwg) return false;
        int wgid = (int)L; { const int q = nwg / NXCD, r = nwg % NXCD, xcd = wgid % NXCD, off = wgid / NXCD; wgid = (xcd < r ? xcd * (q + 1) : r * (q + 1) + (xcd - r) * q) + off; }
        const int nig = WGM * nN, gid = wgid / nig, fm = gid * WGM, gsz = (nM - fm) < WGM ? (nM - fm) : WGM;
        u.pm = fm + ((wgid % nig) % gsz); u.pn = (wgid % nig) / gsz; u.half = 0; return true;
    }
    __device__ __forceinline__ void a_ready(const Unit&) const {}
    __device__ __forceinline__ void done(const Unit&) const {}
};
struct TwoPassOrder {
    StaticOrder so;
    __host__ __device__ void init(int M, int N, int G_, int c_) { so.init(M, N, G_, c_); }
    __host__ __device__ bool next(int i, Unit& u) const { if (!so.next(i >> 1, u)) return false; u.half = i & 1; return true; }
    __device__ __forceinline__ void a_ready(const Unit&) const {}
    __device__ __forceinline__ void done(const Unit&) const {}
};
__device__ __forceinline__ unsigned cvt_pk_bf16(float lo, float hi) { unsigned r; asm volatile("v_cvt_pk_bf16_f32 %0, %1, %2" : "=v"(r) : "v"(lo), "v"(hi)); return r; }
template <class Epi, class Sched, bool ALIGN_EPI = false, bool SP2 = false, bool FP8 = false>
__device__ __forceinline__ void gemm_phase(PG8_LAS unsigned char* lds, const Gemm g, const Sched& S, const Epi& E) {
    const int tid = threadIdx.x, wid = __builtin_amdgcn_readfirstlane(tid >> 6), lane = tid & 63, wr = wid >> 2, wc = wid & 3, fr = lane & 15, fq = lane >> 4;
    const int K = g.K, nt = K / BK;
    unsigned voffA[2], voffB[2];
#pragma unroll
    for (int i = 0; i < 2; ++i) { int R, C; stage_rc(tid * 16 + i * 8192, R, C); const int Rb = Epi::PERM ? ((R & ~31) + perm32(R & 31)) : R;
        voffA[i] = (unsigned)(R * K + C) * 2u; voffB[i] = (unsigned)(Rb * K + C) * 2u; }
    const size_t kstep = (size_t)(BK * 2);
    const size_t hstep = (size_t)HALF * K * 2;
    const size_t tstep = 2 * hstep;
    const unsigned ldsw = (unsigned)wid * 1024u;
    const int aoff = lds_byte(wr * 64 + fr, fq * 8), boff = lds_byte(wc * 32 + fr, fq * 8);
#define PG8_SA(b, h) (((b) * 2 + (h)) * HTB)
#define PG8_SB(b, h) ((4 + (b) * 2 + (h)) * HTB)
#define PG8_STAGE(bufoff, gbase, voff) do { _Pragma("unroll") for (int _i = 0; _i < 2; ++_i) \
        __builtin_amdgcn_global_load_lds((const unsigned*)((const char*)(gbase) + (voff)[_i]), (PG8_LAS unsigned*)(lds + (bufoff) + ldsw + _i * 8192), 16, 0, 0); } while (0)
#define PG8_LDA(dst, b, h) do { _Pragma("unroll") for (int m = 0; m < 4; ++m) dst[m] = PG8_CAT(*(const PG8_LAS bf16x8*)(lds + PG8_SA(b, h) + aoff + m * 2048), *(const PG8_LAS bf16x8*)(lds + PG8_SA(b, h) + aoff + m * 2048 + 1024)); } while (0)
#define PG8_LDB(dst, b, h) do { _Pragma("unroll") for (int n = 0; n < 2; ++n) dst[n] = PG8_CAT(*(const PG8_LAS bf16x8*)(lds + PG8_SB(b, h) + boff + n * 2048), *(const PG8_LAS bf16x8*)(lds + PG8_SB(b, h) + boff + n * 2048 + 1024)); } while (0)
#define PG8_CAT(x, y) __builtin_shufflevector(__builtin_bit_cast(pg8_v4i, x), __builtin_bit_cast(pg8_v4i, y), 0, 1, 2, 3, 4, 5, 6, 7)
#define PG8_HALF(v, k) __builtin_bit_cast(bf16x8, __builtin_shufflevector(v, v, 4 * (k), 4 * (k) + 1, 4 * (k) + 2, 4 * (k) + 3))
#define PG8_MMA(ai, bj, At, Bt) do { __builtin_amdgcn_s_setprio(1); \
        if constexpr (FP8) { _Pragma("unroll") for (int m = 0; m < 4; ++m) _Pragma("unroll") for (int n = 0; n < 2; ++n) \
            asm volatile("v_mfma_f32_16x16x128_f8f6f4 %0, %1, %2, %0" : "+v"(acc[ai][bj][m][n]) : "v"(Bt[n]), "v"(At[m])); } \
        else { _Pragma("unroll") for (int m = 0; m < 4; ++m) _Pragma("unroll") for (int n = 0; n < 2; ++n) { \
            acc[ai][bj][m][n] = __builtin_amdgcn_mfma_f32_16x16x32_bf16(PG8_HALF(Bt[n], 0), PG8_HALF(At[m], 0), acc[ai][bj][m][n], 0, 0, 0); \
            acc[ai][bj][m][n] = __builtin_amdgcn_mfma_f32_16x16x32_bf16(PG8_HALF(Bt[n], 1), PG8_HALF(At[m], 1), acc[ai][bj][m][n], 0, 0, 0); } } \
        __builtin_amdgcn_s_setprio(0); } while (0)
#define PG8_WAIT_V(n) asm volatile("s_waitcnt vmcnt(" #n ")" ::: "memory")
#define PG8_WAIT_L(n) asm volatile("s_waitcnt lgkmcnt(" #n ")" ::: "memory")
#define PG8_BAR __builtin_amdgcn_s_barrier()
#define PG8_SCHED __builtin_amdgcn_sched_barrier(0)
    Unit cur, nxt; int ui = 0;
    if (!S.next(0, cur)) return;
    f32x4 acc[2][2][4][2];
#pragma unroll
    for (int a = 0; a < 2; ++a)
#pragma unroll
        for (int b = 0; b < 2; ++b)
#pragma unroll
            for (int m = 0; m < 4; ++m)
#pragma unroll
                for (int n = 0; n < 2; ++n) acc[a][b][m][n] = (f32x4){0.f, 0.f, 0.f, 0.f};
    pg8_v8i At[4], B0[2], B1[2];
    const char* cA = (const char*)((Epi::TWO_PASS && cur.half) ? g.A2 : g.A) + (size_t)cur.pm * tstep; const char* cB = (const char*)((Epi::TWO_PASS && cur.half) ? g.Bt2 : g.Bt) + (size_t)cur.pn * tstep;
    S.a_ready(cur);
    if constexpr (SP2) {
        PG8_STAGE(PG8_SB(0, 0), cB, voffB); PG8_STAGE(PG8_SB(0, 1), cB + hstep, voffB); PG8_STAGE(PG8_SA(0, 0), cA, voffA); PG8_STAGE(PG8_SA(0, 1), cA + hstep, voffA);
        if (wr == 1) PG8_BAR;
        PG8_WAIT_V(2); PG8_BAR;
        PG8_STAGE(PG8_SB(1, 0), cB + kstep, voffB); PG8_STAGE(PG8_SA(1, 0), cA + kstep, voffA); PG8_STAGE(PG8_SB(1, 1), cB + hstep + kstep, voffB);
        PG8_WAIT_V(6); PG8_BAR;
    } else {
        PG8_STAGE(PG8_SB(0, 0), cB, voffB); PG8_STAGE(PG8_SA(0, 0), cA, voffA); PG8_STAGE(PG8_SB(0, 1), cB + hstep, voffB); PG8_STAGE(PG8_SA(0, 1), cA + hstep, voffA);
        if (wr == 1) PG8_BAR;
        PG8_WAIT_V(4); PG8_BAR;
        PG8_STAGE(PG8_SB(1, 0), cB + kstep, voffB); PG8_STAGE(PG8_SA(1, 0), cA + kstep, voffA); PG8_STAGE(PG8_SB(1, 1), cB + hstep + kstep, voffB);
        PG8_WAIT_V(6); PG8_BAR;
    }
    for (;;) {
        const bool has_next = S.next(ui + 1, nxt);
        const char* nA = has_next ? (const char*)((Epi::TWO_PASS && nxt.half) ? g.A2 : g.A) + (size_t)nxt.pm * tstep : cA; const char* nB = has_next ? (const char*)((Epi::TWO_PASS && nxt.half) ? g.Bt2 : g.Bt) + (size_t)nxt.pn * tstep : cB;
        for (int t = 0; t < nt; t += 2) {
            const bool last = (t == nt - 2);
            const char* a1 = cA + (size_t)(t + 1) * kstep;
            const char* a2 = last ? nA : cA + (size_t)(t + 2) * kstep; const char* b2 = last ? nB : cB + (size_t)(t + 2) * kstep;
            const char* a3 = a2 + kstep; const char* b3 = b2 + kstep;
            if (last && has_next) S.a_ready(nxt);
            if constexpr (SP2) {
            PG8_LDB(B0, 0, 0); PG8_LDB(B1, 0, 1); PG8_SCHED; PG8_LDA(At, 0, 0); PG8_STAGE(PG8_SA(1, 1), a1 + hstep, voffA);
            PG8_WAIT_V(8); PG8_WAIT_L(0); PG8_BAR; PG8_MMA(0, 0, At, B0); PG8_MMA(0, 1, At, B1); PG8_BAR; PG8_SCHED;
            PG8_LDA(At, 0, 1); PG8_STAGE(PG8_SB(0, 0), b2, voffB); PG8_STAGE(PG8_SB(0, 1), b2 + hstep, voffB); PG8_STAGE(PG8_SA(0, 0), a2, voffA);
            PG8_WAIT_V(8); PG8_WAIT_L(0); PG8_BAR; PG8_MMA(1, 0, At, B0); PG8_MMA(1, 1, At, B1); PG8_BAR; PG8_SCHED;
            PG8_LDB(B0, 1, 0); PG8_LDB(B1, 1, 1); PG8_SCHED; PG8_LDA(At, 1, 0); PG8_STAGE(PG8_SA(0, 1), a2 + hstep, voffA);
            PG8_WAIT_V(8); PG8_WAIT_L(0); PG8_BAR; PG8_MMA(0, 0, At, B0); PG8_MMA(0, 1, At, B1); PG8_BAR; PG8_SCHED;
            PG8_LDA(At, 1, 1); PG8_STAGE(PG8_SB(1, 0), b3, voffB); PG8_STAGE(PG8_SB(1, 1), b3 + hstep, voffB); PG8_STAGE(PG8_SA(1, 0), a3, voffA);
            PG8_WAIT_V(8); PG8_WAIT_L(0); PG8_BAR; PG8_MMA(1, 0, At, B0); PG8_MMA(1, 1, At, B1); PG8_BAR; PG8_SCHED;
            } else {
            PG8_LDB(B0, 0, 0); PG8_SCHED; PG8_LDA(At, 0, 0); PG8_STAGE(PG8_SA(1, 1), a1 + hstep, voffA);
            PG8_WAIT_L(8); PG8_BAR; PG8_WAIT_L(0); PG8_MMA(0, 0, At, B0); PG8_BAR; PG8_SCHED;
            PG8_LDB(B1, 0, 1); PG8_STAGE(PG8_SB(0, 0), b2, voffB);
            PG8_BAR; PG8_WAIT_L(0); PG8_MMA(0, 1, At, B1); PG8_BAR;
            PG8_LDA(At, 0, 1); PG8_STAGE(PG8_SA(0, 0), a2, voffA);
            PG8_BAR; PG8_WAIT_L(0); PG8_MMA(1, 0, At, B0); PG8_BAR; PG8_SCHED;
            PG8_STAGE(PG8_SB(0, 1), b2 + hstep, voffB);
            PG8_WAIT_V(6); PG8_BAR; PG8_MMA(1, 1, At, B1); PG8_BAR;
            PG8_LDB(B0, 1, 0); PG8_SCHED; PG8_LDA(At, 1, 0); PG8_STAGE(PG8_SA(0, 1), a2 + hstep, voffA);
            PG8_WAIT_L(8); PG8_BAR; PG8_WAIT_L(0); PG8_MMA(0, 0, At, B0); PG8_BAR; PG8_SCHED;
            PG8_LDB(B1, 1, 1); PG8_STAGE(PG8_SB(1, 0), b3, voffB);
            PG8_BAR; PG8_WAIT_L(0); PG8_MMA(0, 1, At, B1); PG8_BAR;
            PG8_LDA(At, 1, 1); PG8_STAGE(PG8_SA(1, 0), a3, voffA);
            PG8_BAR; PG8_WAIT_L(0); PG8_MMA(1, 0, At, B0); PG8_BAR; PG8_SCHED;
            PG8_STAGE(PG8_SB(1, 1), b3 + hstep, voffB);
            PG8_WAIT_V(6); PG8_BAR; PG8_MMA(1, 1, At, B1); PG8_BAR;
            }
        }
        if constexpr (FP8) asm volatile("s_nop 15\n\ts_nop 15" ::: "memory");
        if constexpr (ALIGN_EPI) { if (wr == 0) PG8_BAR; }
        bool keep_acc = false;
        if constexpr (Epi::TWO_PASS) { if (cur.half == 0) { E.mid(acc, cur, wr, wc, fr, fq); keep_acc = true; } else { E(acc, cur, wr, wc, fr, fq); } }
        else if constexpr (!Epi::AFTER_DRAIN) { E(acc, cur, wr, wc, fr, fq); S.done(cur); }
        if (!has_next) break;
        if (!keep_acc)
#pragma unroll
        for (int a = 0; a < 2; ++a)
#pragma unroll
            for (int b = 0; b < 2; ++b)
#pragma unroll
                for (int m = 0; m < 4; ++m)
#pragma unroll
                    for (int n = 0; n < 2; ++n) acc[a][b][m][n] = (f32x4){0.f, 0.f, 0.f, 0.f};
        cur = nxt; cA = nA; cB = nB; ++ui;
        if constexpr (ALIGN_EPI) { if (wr == 1) PG8_BAR; }
    }
    PG8_WAIT_V(0);
    if constexpr (!ALIGN_EPI) { if (wr == 0) PG8_BAR; }
    PG8_BAR;
    if constexpr (Epi::AFTER_DRAIN) { E.fused(acc, cur, wr, wc, fr, fq, lds, wid, lane); S.done(cur); }
#undef PG8_SA
#undef PG8_SB
#undef PG8_STAGE
#undef PG8_LDA
#undef PG8_LDB
#undef PG8_MMA
#undef PG8_CAT
#undef PG8_HALF
#undef PG8_WAIT_V
#undef PG8_WAIT_L
#undef PG8_BAR
#undef PG8_SCHED
}
}
#define GAS __attribute__((address_space(1)))
#define LAS __attribute__((address_space(3)))
typedef unsigned short bf16;
typedef unsigned v4u __attribute__((ext_vector_type(4)));
typedef float f32x4 __attribute__((ext_vector_type(4)));
typedef short bf16x8 __attribute__((ext_vector_type(8)));
typedef GAS unsigned gu32;
typedef GAS unsigned long long gu64;
#define RLX_AGENT __ATOMIC_RELAXED, __HIP_MEMORY_SCOPE_AGENT
#define LDS_WAIT() asm volatile("s_waitcnt lgkmcnt(0)" ::: "memory")
#define VM_WAIT() asm volatile("s_waitcnt vmcnt(0)" ::: "memory")
__device__ __forceinline__ unsigned long long rt() { return __builtin_amdgcn_s_memrealtime(); }
__device__ __forceinline__ unsigned f2bf(float f) { unsigned u = __builtin_bit_cast(unsigned, f); return (u + 0x7fffu + ((u >> 16) & 1u)) >> 16; }
__device__ __forceinline__ unsigned pk2(float lo, float hi) { return f2bf(lo) | (f2bf(hi) << 16); }

#define XB_TMO      128
#define XB_XCNT(j)  (256  + 64 * (j))
#define XB_XSUB(j)  (1280 + 64 * (j))
#define XB_XGEN(j)  (2304 + 64 * (j))
#define XB_TOP      3328
#define XB_TOPGEN   3392
#define XCD_BAR_WORDS 3456
#define XB_SPIN_CAP (1u << 18)

__device__ __forceinline__ unsigned xb_ld(unsigned* p)              { return __hip_atomic_load(p, __ATOMIC_RELAXED, __HIP_MEMORY_SCOPE_AGENT); }
__device__ __forceinline__ unsigned xb_add(unsigned* p, unsigned v) { return __hip_atomic_fetch_add(p, v, __ATOMIC_RELAXED, __HIP_MEMORY_SCOPE_AGENT); }
__device__ __forceinline__ unsigned xb_xcc_id() { return (unsigned)__builtin_amdgcn_s_getreg((3 << 11) | 20) & 0xFu; }
#define XB_SPIN(cond, bar) do { unsigned _sp = 0; while (cond) { __builtin_amdgcn_s_sleep(1); \
    if ((++_sp & 255u) == 0u) { if (xb_ld(&(bar)[XB_TMO])) break; if (_sp > XB_SPIN_CAP) { atomicAdd(&(bar)[XB_TMO], 1u); break; } } } } while (0)

struct XcdBarrier {
    unsigned* bar; unsigned x;
    volatile LAS unsigned* st;
};

__device__ __forceinline__ XcdBarrier xcd_barrier_post(unsigned* bar, volatile LAS unsigned* st) {
    XcdBarrier b; b.bar = bar; b.x = xb_xcc_id(); b.st = st;
    if (threadIdx.x == 0) (void)xb_add(&bar[XB_XCNT(b.x)], 1u);
    return b;
}
__device__ __forceinline__ void xcd_barrier_complete(unsigned* bar, unsigned x, unsigned& nloc, unsigned& nx) {
    const unsigned G = gridDim.x * gridDim.y * gridDim.z;
    unsigned sum, cnt, mine, sp = 0u;
    for (;;) {
        sum = 0u; cnt = 0u; mine = 0u;
#pragma unroll
        for (unsigned j = 0; j < 16; ++j) { const unsigned c = xb_ld(&bar[XB_XCNT(j)]); sum += c; cnt += (c > 0u) ? 1u : 0u; mine = (j == x) ? c : mine; }
        if (sum == G) break;
        __builtin_amdgcn_s_sleep(1);
        if ((++sp & 255u) == 0u) { if (xb_ld(&bar[XB_TMO])) break; if (sp > XB_SPIN_CAP) { atomicAdd(&bar[XB_TMO], 1u); break; } }
    }
    nloc = mine > 0u ? mine : 1u; nx = cnt > 0u ? cnt : 1u;
}

__device__ __forceinline__ void xcd_barrier(const XcdBarrier& b) {
    asm volatile("s_waitcnt vmcnt(0)" ::: "memory");
    __syncthreads();
    if (threadIdx.x == 0) {
        unsigned* bar = b.bar;
        __builtin_amdgcn_s_waitcnt(0);
        unsigned nloc = b.st[0], nx = b.st[1];
        if (nloc == 0u) { xcd_barrier_complete(bar, b.x, nloc, nx); b.st[0] = nloc; b.st[1] = nx; }
        const unsigned old = xb_add(&bar[XB_XSUB(b.x)], 1u);
        const unsigned gen = old / nloc;
        if (old + 1u == (gen + 1u) * nloc) {
            __builtin_amdgcn_fence(__ATOMIC_RELEASE, "agent");
            asm volatile("s_waitcnt vmcnt(0)" ::: "memory");
            const unsigned og = xb_add(&bar[XB_TOP], 1u);
            const unsigned tg = og / nx;
            if (og + 1u == (tg + 1u) * nx) xb_add(&bar[XB_TOPGEN], 1u);
            else XB_SPIN(xb_ld(&bar[XB_TOPGEN]) == tg, bar);
            __builtin_amdgcn_fence(__ATOMIC_ACQUIRE, "agent");
            xb_add(&bar[XB_XGEN(b.x)], 1u);
            asm volatile("s_waitcnt vmcnt(0)" ::: "memory");
        } else {
            XB_SPIN(xb_ld(&bar[XB_XGEN(b.x)]) == gen, bar);
            __builtin_amdgcn_fence(__ATOMIC_ACQUIRE, "agent");
            asm volatile("s_waitcnt vmcnt(0)" ::: "memory");
        }
    }
    __syncthreads();
}

#ifndef PEER_FP8
#define PEER_FP8 1
#endif
#ifndef FP4_BF16_SWAP
#define FP4_BF16_SWAP 1
#endif
#ifndef ML_SHARE_P
#define ML_SHARE_P 1
#endif
#ifndef PEER_PIPE
#define PEER_PIPE 1
#endif
#ifndef PEER_GB
#define PEER_GB 16
#endif
#ifndef PEER_SWEEP
#define PEER_SWEEP 0
#endif
#ifndef PEER_FP4
#define PEER_FP4 1
#endif
#ifndef DBG_TQ
#define DBG_TQ 1000ull
#endif
#ifndef DBG_IDMASK
#define DBG_IDMASK 0xffffu
#endif
#ifndef SW_SORT_MAX
#define SW_SORT_MAX 512
#endif
constexpr int NB = 16, SEQ = 4096, DM = 1024, T = NB * SEQ;
#ifndef PROJ_ALL_FP8
#define PROJ_ALL_FP8 1
#endif
constexpr int NPROJ_ALL = 5632;
constexpr int NPROJ_B = 2048;
constexpr int NPROJ_Q = 3584;
constexpr float WQ_SCALE = 64.0f;
constexpr int IN_COLS = 5640;
constexpr float EPS = 1e-6f;
constexpr int NWAVES = 8;

constexpr size_t MiB = 1u << 20;
constexpr size_t WS_CTL = 0, CTL_ZERO_BYTES = 1 * MiB;
constexpr size_t WS_MOD = 1 * MiB;
constexpr size_t WS_W8 = 2 * MiB;
constexpr size_t WS_WIN = 4 * MiB;
constexpr size_t WS_WINQ = 9 * MiB;
constexpr size_t WS_H1Q = 960 * MiB;
constexpr size_t WS_WA = 15 * MiB;
constexpr size_t WS_WB = 16 * MiB;
constexpr size_t WS_WOUT = 17 * MiB;
constexpr size_t WS_WPQ = 19 * MiB;
constexpr size_t WS_SUBK = 23 * MiB;
constexpr size_t WS_U = 24 * MiB;
constexpr size_t WS_V = 56 * MiB;
constexpr size_t WS_USC = 40 * MiB, WS_VSC = 41 * MiB;
constexpr size_t WS_GATES = 88 * MiB;
constexpr size_t WS_ROUTE = 90 * MiB;
constexpr size_t WS_H1 = 128 * MiB;
constexpr size_t WS_QKC = 128 * MiB;
constexpr size_t WS_YA = 448 * MiB, WS_YB = 512 * MiB, WS_H2 = 128 * MiB;
constexpr size_t WS_QKVA = 256 * MiB;
constexpr size_t WS_Y = 256 * MiB;
constexpr size_t WS_QKB = 448 * MiB;
constexpr size_t WS_VB = 576 * MiB;
constexpr size_t WS_OB = 640 * MiB;
constexpr size_t WS_GAB = 704 * MiB;
constexpr size_t WS_PQ = 704 * MiB;
constexpr size_t WS_X1 = 448 * MiB;
constexpr size_t WS_COEF = 960 * MiB;
constexpr size_t WS_END = 992 * MiB;
constexpr int CW_BAR = 4096;

constexpr int LDS_BYTES = 151552;
constexpr int MISC_OFF = 147456;

struct Args { const float* in[21]; float* out; unsigned char* ws; int ph_lo, ph_hi, li, pad; };

struct Frame {
    unsigned char* lds;
    int tid, lane, wave, G, gw, NGW;
    const float* in[21]; float* out; unsigned char* ws;
};

__device__ __forceinline__ float bf2f(unsigned short h) { return __builtin_bit_cast(float, (unsigned)h << 16); }
__device__ __forceinline__ float bflo(unsigned w) { return __builtin_bit_cast(float, w << 16); }
__device__ __forceinline__ float bfhi(unsigned w) { return __builtin_bit_cast(float, w & 0xffff0000u); }
typedef __bf16 bf16x2_t __attribute__((ext_vector_type(2)));
__device__ __forceinline__ float dot2c(float acc, unsigned a, unsigned b) { return __builtin_amdgcn_fdot2_f32_bf16(__builtin_bit_cast(bf16x2_t, a), __builtin_bit_cast(bf16x2_t, b), acc, false); }
__device__ __forceinline__ float wave_sum(float v) {
#pragma unroll
    for (int o = 1; o < 64; o <<= 1) v += __shfl_xor(v, o);
    return v;
}
__device__ __forceinline__ float wave_max(float v) {
#pragma unroll
    for (int o = 1; o < 64; o <<= 1) v = fmaxf(v, __shfl_xor(v, o));
    return v;
}
typedef float f32x2_t __attribute__((ext_vector_type(2)));
typedef float f32x16 __attribute__((ext_vector_type(16)));
__device__ __forceinline__ unsigned cvtpk(float lo, float hi) { f32x2_t v = {lo, hi}; bf16x2_t b = __builtin_convertvector(v, bf16x2_t); return __builtin_bit_cast(unsigned, b); }
__device__ __forceinline__ float sigmoidf_(float v) { return 1.0f / (1.0f + __expf(-v)); }

#define DPPF(oldv, v, ctrl, rmask) __builtin_bit_cast(float, __builtin_amdgcn_update_dpp(__builtin_bit_cast(int, (float)(oldv)), __builtin_bit_cast(int, (float)(v)), ctrl, rmask, 0xf, false))
__device__ __forceinline__ float scan_sum64(float v) {
    v += DPPF(0.f, v, 0x111, 0xf); v += DPPF(0.f, v, 0x112, 0xf); v += DPPF(0.f, v, 0x114, 0xf); v += DPPF(0.f, v, 0x118, 0xf);
    v += DPPF(0.f, v, 0x142, 0xa); v += DPPF(0.f, v, 0x143, 0xc);
    return v;
}
__device__ __forceinline__ float scan_max64(float v) {
    v = fmaxf(v, DPPF(-INFINITY, v, 0x111, 0xf)); v = fmaxf(v, DPPF(-INFINITY, v, 0x112, 0xf)); v = fmaxf(v, DPPF(-INFINITY, v, 0x114, 0xf)); v = fmaxf(v, DPPF(-INFINITY, v, 0x118, 0xf));
    v = fmaxf(v, DPPF(-INFINITY, v, 0x142, 0xa)); v = fmaxf(v, DPPF(-INFINITY, v, 0x143, 0xc));
    return v;
}
__device__ __forceinline__ float lane63(float v) { return __builtin_bit_cast(float, __builtin_amdgcn_readlane(__builtin_bit_cast(int, v), 63)); }
__device__ __forceinline__ float wave_sum_u(float v) { return lane63(scan_sum64(v)); }

enum { EPI_ROUTE = 1, EPI_MERGE_A = 2, EPI_MERGE_B = 3, EPI_OUTPROJ = 4, EPI_PQ = 5, EPI_MERGE = 6 };
template <int MODE> struct Epi {
    static constexpr bool PERM = true, AFTER_DRAIN = false, TWO_PASS = (MODE == EPI_MERGE);
    unsigned char* ws; const float* x; float* out; int part = 0;
    __device__ __forceinline__ void mid(pg8::f32x4 (&acc)[2][2][4][2], const pg8::Unit& u, int wr, int wc, int fr, int fq) const {
        using pg8::u32x4;
        const int row0 = u.pm * 256 + wr * 64 + fr, colw = 256 * u.pn + wc * 32 + 8 * fq;
#pragma unroll
        for (int ai = 0; ai < 2; ++ai)
#pragma unroll
            for (int m = 0; m < 4; ++m) {
                const int row = row0 + ai * 128 + m * 16;
#pragma unroll
                for (int bj = 0; bj < 2; ++bj) {
                    typedef unsigned u32x2_t __attribute__((ext_vector_type(2)));
                    const unsigned char* gp = (const unsigned char*)(ws + WS_GAB) + (size_t)row * 2048 + colw + bj * 128;
                    const u32x2_t ga = *(const u32x2_t*)gp, gb = *(const u32x2_t*)(gp + 1024);
                    const f32x2_t a0 = __builtin_amdgcn_cvt_pk_f32_fp8(ga.x, false), a1 = __builtin_amdgcn_cvt_pk_f32_fp8(ga.x, true), a2 = __builtin_amdgcn_cvt_pk_f32_fp8(ga.y, false), a3 = __builtin_amdgcn_cvt_pk_f32_fp8(ga.y, true);
                    const f32x2_t b0 = __builtin_amdgcn_cvt_pk_f32_fp8(gb.x, false), b1 = __builtin_amdgcn_cvt_pk_f32_fp8(gb.x, true), b2 = __builtin_amdgcn_cvt_pk_f32_fp8(gb.y, false), b3 = __builtin_amdgcn_cvt_pk_f32_fp8(gb.y, true);
                    acc[ai][bj][m][0][0] *= a0.x * __builtin_amdgcn_rcpf(b0.x); acc[ai][bj][m][0][1] *= a0.y * __builtin_amdgcn_rcpf(b0.y);
                    acc[ai][bj][m][0][2] *= a1.x * __builtin_amdgcn_rcpf(b1.x); acc[ai][bj][m][0][3] *= a1.y * __builtin_amdgcn_rcpf(b1.y);
                    acc[ai][bj][m][1][0] *= a2.x * __builtin_amdgcn_rcpf(b2.x); acc[ai][bj][m][1][1] *= a2.y * __builtin_amdgcn_rcpf(b2.y);
                    acc[ai][bj][m][1][2] *= a3.x * __builtin_amdgcn_rcpf(b3.x); acc[ai][bj][m][1][3] *= a3.y * __builtin_amdgcn_rcpf(b3.y);
                }
            }
    }
    __device__ __forceinline__ void operator()(const pg8::f32x4 (&acc)[2][2][4][2], const pg8::Unit& u, int wr, int wc, int fr, int fq) const {
        using pg8::f32x4; using pg8::u32x4; using pg8::cvt_pk_bf16;
        const int row0 = u.pm * 256 + wr * 64 + fr;
        const int colw = wc * 32 + 8 * fq;
        unsigned short* obase = nullptr; int ldc = 0, coff = 0; bool sig = false, gab8 = false; float qsc = 1.0f;
        if (MODE == EPI_ROUTE) {
            const int pn = u.pn;
            if (part == 2) {
                qsc = 1.0f / WQ_SCALE;
                if (pn < 6) { obase = (unsigned short*)(ws + WS_QKVA); ldc = 1536; coff = 256 * pn; }
                else if (pn < 10) { obase = (unsigned short*)(ws + WS_QKB); ldc = 1024; coff = 256 * (pn - 6); }
                else if (pn < 12) { obase = (unsigned short*)(ws + WS_VB); ldc = 512; coff = 256 * (pn - 10); }
                else if (pn < 14) { obase = (unsigned short*)(ws + WS_OB); ldc = 512; coff = 256 * (pn - 12); sig = true; }
                else { obase = (unsigned short*)(ws + WS_GAB); ldc = 2048; coff = 256 * (pn - 14); sig = true; gab8 = true; }
            } else if (part == 0) {
                if (pn < 4) { obase = (unsigned short*)(ws + WS_QKVA); ldc = 1536; coff = 256 * pn; }
                else { obase = (unsigned short*)(ws + WS_QKB); ldc = 1024; coff = 256 * (pn - 4); }
            } else {
                qsc = 1.0f / WQ_SCALE;
                if (pn < 2) { obase = (unsigned short*)(ws + WS_QKVA); ldc = 1536; coff = 1024 + 256 * pn; }
                else if (pn < 4) { obase = (unsigned short*)(ws + WS_VB); ldc = 512; coff = 256 * (pn - 2); }
                else if (pn < 6) { obase = (unsigned short*)(ws + WS_OB); ldc = 512; coff = 256 * (pn - 4); sig = true; }
                else { obase = (unsigned short*)(ws + WS_GAB); ldc = 2048; coff = 256 * (pn - 6); sig = true; gab8 = true; }
            }
        } else if (MODE == EPI_MERGE_A || MODE == EPI_MERGE_B || MODE == EPI_MERGE) { obase = (unsigned short*)(ws + WS_Y); ldc = 1024; coff = 256 * u.pn; }
        else if (MODE == EPI_PQ) { obase = (unsigned short*)(ws + WS_PQ); ldc = 2048; coff = 256 * u.pn; }
        else { coff = 256 * u.pn; }
#pragma unroll
        for (int ai = 0; ai < 2; ++ai)
#pragma unroll
            for (int m = 0; m < 4; ++m) {
                const int row = row0 + ai * 128 + m * 16;
#pragma unroll
                for (int bj = 0; bj < 2; ++bj) {
                    const int col = coff + bj * 128 + colw;
                    f32x4 v0 = acc[ai][bj][m][0], v1 = acc[ai][bj][m][1];
                    if (MODE == EPI_ROUTE) {
                        v0 = v0 * qsc; v1 = v1 * qsc;
                        if (sig) {
#pragma unroll
                            for (int e = 0; e < 4; ++e) { v0[e] = sigmoidf_(v0[e]); v1[e] = sigmoidf_(v1[e]); }
                        }
                    } else if (MODE == EPI_MERGE) {
                        typedef unsigned u32x2_t __attribute__((ext_vector_type(2)));
                        const u32x2_t g = *(const u32x2_t*)((const unsigned char*)(ws + WS_GAB) + (size_t)row * 2048 + 1024 + col);
                        const f32x2_t b0 = __builtin_amdgcn_cvt_pk_f32_fp8(g.x, false), b1 = __builtin_amdgcn_cvt_pk_f32_fp8(g.x, true), b2 = __builtin_amdgcn_cvt_pk_f32_fp8(g.y, false), b3 = __builtin_amdgcn_cvt_pk_f32_fp8(g.y, true);
                        v0[0] *= b0.x; v0[1] *= b0.y; v0[2] *= b1.x; v0[3] *= b1.y;
                        v1[0] *= b2.x; v1[1] *= b2.y; v1[2] *= b3.x; v1[3] *= b3.y;
                    } else if (MODE == EPI_MERGE_A || MODE == EPI_MERGE_B) {
                        const u32x4 g = *(const u32x4*)((const unsigned short*)(ws + WS_GAB) + (size_t)row * 2048 + (MODE == EPI_MERGE_B ? 1024 : 0) + col);
                        v0[0] *= bflo(g.x); v0[1] *= bfhi(g.x); v0[2] *= bflo(g.y); v0[3] *= bfhi(g.y);
                        v1[0] *= bflo(g.z); v1[1] *= bfhi(g.z); v1[2] *= bflo(g.w); v1[3] *= bfhi(g.w);
                        if (MODE == EPI_MERGE_B) {
                            const u32x4 y = *(const u32x4*)(obase + (size_t)row * ldc + col);
                            v0[0] += bflo(y.x); v0[1] += bfhi(y.x); v0[2] += bflo(y.y); v0[3] += bfhi(y.y);
                            v1[0] += bflo(y.z); v1[1] += bfhi(y.z); v1[2] += bflo(y.w); v1[3] += bfhi(y.w);
                        }
                    }
                    if (MODE == EPI_OUTPROJ) {
                        const int b = row >> 12;
                        const float* gt = (const float*)(ws + WS_MOD) + b * 6144 + 2048 + col;
                        const float* xr = x + (size_t)row * 1024 + col;
                        const f32x4 g0 = *(const f32x4*)gt, g1 = *(const f32x4*)(gt + 4), x0 = *(const f32x4*)xr, x1 = *(const f32x4*)(xr + 4);
                        const f32x4 r0 = x0 + g0 * v0, r1 = x1 + g1 * v1;
                        u32x4 w; w.x = cvtpk(r0[0], r0[1]); w.y = cvtpk(r0[2], r0[3]); w.z = cvtpk(r1[0], r1[1]); w.w = cvtpk(r1[2], r1[3]);
                        *(u32x4*)((unsigned short*)(ws + WS_X1) + (size_t)row * 1024 + col) = w;
                    } else if (MODE == EPI_ROUTE && gab8) {
                        typedef unsigned u32x2_t __attribute__((ext_vector_type(2)));
#pragma unroll
                        for (int e = 0; e < 4; ++e) { v0[e] = fmaxf(v0[e], 0.015625f); v1[e] = fmaxf(v1[e], 0.015625f); }
                        int p0 = __builtin_amdgcn_cvt_pk_fp8_f32(v0[0], v0[1], 0, false); p0 = __builtin_amdgcn_cvt_pk_fp8_f32(v0[2], v0[3], p0, true);
                        int p1 = __builtin_amdgcn_cvt_pk_fp8_f32(v1[0], v1[1], 0, false); p1 = __builtin_amdgcn_cvt_pk_fp8_f32(v1[2], v1[3], p1, true);
                        *(u32x2_t*)((unsigned char*)obase + (size_t)row * 2048 + col) = (u32x2_t){(unsigned)p0, (unsigned)p1};
                    } else {
                        u32x4 w; w.x = cvt_pk_bf16(v0[0], v0[1]); w.y = cvt_pk_bf16(v0[2], v0[3]); w.z = cvt_pk_bf16(v1[0], v1[1]); w.w = cvt_pk_bf16(v1[2], v1[3]);
                        *(u32x4*)(obase + (size_t)row * ldc + col) = w;
                    }
                }
            }
    }
};

__device__ __forceinline__ void p0_transpose_item(const float* W, int K, int N, int pitch, unsigned short* WT, int row_off, float* scr, int item, int lane) {
    const int nblk = N / 32, kb = item / nblk, nb = item % nblk, k0 = 64 * kb, n0 = 32 * nb;
#pragma unroll 8
    for (int i = 0; i < 32; ++i) { const int kk = 2 * i + (lane >> 5); scr[kk * 33 + (lane & 31)] = W[(size_t)(k0 + kk) * pitch + n0 + (lane & 31)]; }
    LDS_WAIT(); asm volatile("" ::: "memory");
    const int c = lane & 7;
#pragma unroll
    for (int j = 0; j < 4; ++j) { const int n = (lane >> 3) + 8 * j; const float* s = scr + (8 * c) * 33 + n;
        v4u o; o.x = pk2(s[0 * 33], s[1 * 33]); o.y = pk2(s[2 * 33], s[3 * 33]); o.z = pk2(s[4 * 33], s[5 * 33]); o.w = pk2(s[6 * 33], s[7 * 33]);
        *(v4u*)(WT + (size_t)(row_off + n0 + n) * K + k0 + 8 * c) = o; }
    LDS_WAIT(); asm volatile("" ::: "memory");
}

__device__ __forceinline__ void p0_transpose_item_fp8(const float* W, int K, int N, int pitch, unsigned char* WT8, int row_off, float* scr, int item, int lane, float scale) {
    const int nblk = N / 32, kb = item / nblk, nb = item % nblk, k0 = 64 * kb, n0 = 32 * nb;
#pragma unroll 8
    for (int i = 0; i < 32; ++i) { const int kk = 2 * i + (lane >> 5); scr[kk * 33 + (lane & 31)] = W[(size_t)(k0 + kk) * pitch + n0 + (lane & 31)] * scale; }
    LDS_WAIT(); asm volatile("" ::: "memory");
    const int c = lane & 7;
#pragma unroll
    for (int j = 0; j < 4; ++j) { const int n = (lane >> 3) + 8 * j; const float* sp = scr + (8 * c) * 33 + n;
        typedef unsigned u32x2_t __attribute__((ext_vector_type(2)));
        int p0 = __builtin_amdgcn_cvt_pk_fp8_f32(sp[0 * 33], sp[1 * 33], 0, false); p0 = __builtin_amdgcn_cvt_pk_fp8_f32(sp[2 * 33], sp[3 * 33], p0, true);
        int p1 = __builtin_amdgcn_cvt_pk_fp8_f32(sp[4 * 33], sp[5 * 33], 0, false); p1 = __builtin_amdgcn_cvt_pk_fp8_f32(sp[6 * 33], sp[7 * 33], p1, true);
        *(u32x2_t*)(WT8 + (size_t)(row_off + n0 + n) * K + k0 + 8 * c) = (u32x2_t){(unsigned)p0, (unsigned)p1}; }
    LDS_WAIT(); asm volatile("" ::: "memory");
}
__device__ __forceinline__ void p0_cvt_item(const float* src, unsigned short* dst, size_t item, int lane) {
    const f32x4* s = (const f32x4*)(src + item * 512) + lane * 2;
    const f32x4 a = s[0], b = s[1];
    v4u o; o.x = pk2(a.x, a.y); o.y = pk2(a.z, a.w); o.z = pk2(b.x, b.y); o.w = pk2(b.z, b.w);
    *((v4u*)(dst + item * 512) + lane) = o;
}

__device__ __forceinline__ void p0_fp8_row(const float* src, unsigned char* dst, float* sc, int row, int lane) {
    const f32x4* sp = (const f32x4*)(src + (size_t)row * 1024) + lane * 4;
    f32x4 v[4]; float mx = 0.f;
#pragma unroll
    for (int j = 0; j < 4; ++j) { v[j] = sp[j]; mx = fmaxf(mx, fmaxf(fmaxf(fabsf(v[j].x), fabsf(v[j].y)), fmaxf(fabsf(v[j].z), fabsf(v[j].w)))); }
    mx = wave_max(mx);
    const float scale = mx > 0.f ? 240.0f / mx : 1.0f;
    if (lane == 0) sc[row] = mx > 0.f ? mx * (1.0f / 240.0f) : 1.0f;
    v4u o; unsigned w[4];
#pragma unroll
    for (int j = 0; j < 4; ++j) { int p = __builtin_amdgcn_cvt_pk_fp8_f32(v[j].x * scale, v[j].y * scale, 0, false); p = __builtin_amdgcn_cvt_pk_fp8_f32(v[j].z * scale, v[j].w * scale, p, true); w[j] = (unsigned)p; }
    o.x = w[0]; o.y = w[1]; o.z = w[2]; o.w = w[3];
    *((v4u*)(dst + (size_t)row * 1024) + lane) = o;
}

__device__ __forceinline__ void p0_fp4_row(const float* src, unsigned char* dst, float* sc, int row, int lane) {
    const f32x4* sp = (const f32x4*)(src + (size_t)row * 1024) + lane * 4;
    f32x4 v[4]; float mx = 0.f;
#pragma unroll
    for (int j = 0; j < 4; ++j) { v[j] = sp[j]; mx = fmaxf(mx, fmaxf(fmaxf(fabsf(v[j].x), fabsf(v[j].y)), fmaxf(fabsf(v[j].z), fabsf(v[j].w)))); }
    mx = wave_max(mx);
    const float scale = mx > 0.f ? 6.0f / mx : 1.0f;
    if (lane == 0) sc[row] = mx > 0.f ? mx * (1.0f / 6.0f) : 1.0f;
    unsigned w0 = 0u, w1 = 0u;
    w0 = __builtin_amdgcn_cvt_scalef32_pk_fp4_f32(w0, v[0].x * scale, v[0].y * scale, 1.0f, 0); w0 = __builtin_amdgcn_cvt_scalef32_pk_fp4_f32(w0, v[0].z * scale, v[0].w * scale, 1.0f, 1);
    w0 = __builtin_amdgcn_cvt_scalef32_pk_fp4_f32(w0, v[1].x * scale, v[1].y * scale, 1.0f, 2); w0 = __builtin_amdgcn_cvt_scalef32_pk_fp4_f32(w0, v[1].z * scale, v[1].w * scale, 1.0f, 3);
    w1 = __builtin_amdgcn_cvt_scalef32_pk_fp4_f32(w1, v[2].x * scale, v[2].y * scale, 1.0f, 0); w1 = __builtin_amdgcn_cvt_scalef32_pk_fp4_f32(w1, v[2].z * scale, v[2].w * scale, 1.0f, 1);
    w1 = __builtin_amdgcn_cvt_scalef32_pk_fp4_f32(w1, v[3].x * scale, v[3].y * scale, 1.0f, 2); w1 = __builtin_amdgcn_cvt_scalef32_pk_fp4_f32(w1, v[3].z * scale, v[3].w * scale, 1.0f, 3);
    typedef unsigned u32x2_t __attribute__((ext_vector_type(2)));
    *((u32x2_t*)(dst + (size_t)row * 512) + lane) = (u32x2_t){w0, w1};
}
__device__ __forceinline__ void p0_prologue(Frame& F) {
    if (blockIdx.x < 96) {
        float* sc = (float*)F.lds;
        float* red = (float*)(F.lds + 65536);
        const float* c = F.in[1]; const float* w_ada = F.in[2]; const float* b_ada = F.in[3];
        for (int i = F.tid; i < 16 * 1024; i += 512) { const float v = c[i]; sc[i] = v / (1.0f + __expf(-v)); }
        __syncthreads();
        const int n = blockIdx.x * 64 + F.lane;
        float acc[16];
#pragma unroll
        for (int b = 0; b < 16; ++b) acc[b] = 0.f;
        for (int k0 = F.wave * 128; k0 < F.wave * 128 + 128; k0 += 16) {
            float wv[16];
#pragma unroll
            for (int i = 0; i < 16; ++i) wv[i] = w_ada[(size_t)(k0 + i) * 6144 + n];
#pragma unroll
            for (int i = 0; i < 16; ++i)
#pragma unroll
                for (int b = 0; b < 16; ++b) acc[b] += sc[b * 1024 + k0 + i] * wv[i];
        }
#pragma unroll
        for (int b = 0; b < 16; ++b) red[(F.wave * 16 + b) * 64 + F.lane] = acc[b];
        __syncthreads();
        float* MOD = (float*)(F.ws + WS_MOD);
        for (int idx = F.tid; idx < 16 * 64; idx += 512) { const int b = idx >> 6, l = idx & 63; float s = b_ada[blockIdx.x * 64 + l];
#pragma unroll
            for (int w = 0; w < 8; ++w) s += red[(w * 16 + b) * 64 + l];
            MOD[b * 6144 + blockIdx.x * 64 + l] = s; }
        __syncthreads();
    }
    float* scr = (float*)(F.lds + F.wave * 16384);
#if PROJ_ALL_FP8
    for (int it = F.gw; it < 16 * 112 + 16 * 64; it += F.NGW) {
        if (it < 16 * 112) p0_transpose_item_fp8(F.in[5], 1024, 3584, IN_COLS, F.ws + WS_WINQ, 0, scr, it, F.lane, WQ_SCALE);
        else p0_transpose_item_fp8(F.in[5] + 3592, 1024, 2048, IN_COLS, F.ws + WS_WINQ, 3584, scr, it - 16 * 112, F.lane, WQ_SCALE);
    }
#else
    constexpr int I_B = 16 * 32, I_Q1 = 16 * 16, I_Q4 = 16 * 64;
    for (int it = F.gw; it < 2 * I_B + 3 * I_Q1 + I_Q4; it += F.NGW) {
        int r = it;
        if (r < I_B) { p0_transpose_item(F.in[5], 1024, 1024, IN_COLS, (unsigned short*)(F.ws + WS_WIN), 0, scr, r, F.lane); continue; } r -= I_B;
        if (r < I_B) { p0_transpose_item(F.in[5] + 1536, 1024, 1024, IN_COLS, (unsigned short*)(F.ws + WS_WIN), 1024, scr, r, F.lane); continue; } r -= I_B;
        if (r < I_Q1) { p0_transpose_item_fp8(F.in[5] + 1024, 1024, 512, IN_COLS, F.ws + WS_WINQ, 0, scr, r, F.lane, WQ_SCALE); continue; } r -= I_Q1;
        if (r < I_Q1) { p0_transpose_item_fp8(F.in[5] + 2560, 1024, 512, IN_COLS, F.ws + WS_WINQ, 512, scr, r, F.lane, WQ_SCALE); continue; } r -= I_Q1;
        if (r < I_Q1) { p0_transpose_item_fp8(F.in[5] + 3072, 1024, 512, IN_COLS, F.ws + WS_WINQ, 1024, scr, r, F.lane, WQ_SCALE); continue; } r -= I_Q1;
        p0_transpose_item_fp8(F.in[5] + 3592, 1024, 2048, IN_COLS, F.ws + WS_WINQ, 1536, scr, r, F.lane, WQ_SCALE);
    }
#endif
    { float* W8 = (float*)(F.ws + WS_W8); const int g = blockIdx.x * 512 + F.tid; if (g < 8192) { const int j = g >> 10, k = g & 1023; W8[g] = F.in[5][(size_t)k * IN_COLS + 3584 + j]; } }
}

__device__ __forceinline__ void late_weight_copies(Frame& F, int w0, int nw) {
    float* scr = (float*)(F.lds + F.wave * 16384);
    constexpr int I_A = 8 * 32, I_B = 8 * 32, I_O = 16 * 32, I_PQ = 16 * 64;
    for (int it = w0; it < I_A + I_B + I_O + I_PQ; it += nw) {
        int r = it;
        if (r < I_A) { p0_transpose_item(F.in[12], 512, 1024, 1024, (unsigned short*)(F.ws + WS_WA), 0, scr, r, F.lane); continue; } r -= I_A;
        if (r < I_B) { p0_transpose_item(F.in[13], 512, 1024, 1024, (unsigned short*)(F.ws + WS_WB), 0, scr, r, F.lane); continue; } r -= I_B;
        if (r < I_O) { p0_transpose_item(F.in[14], 1024, 1024, 1024, (unsigned short*)(F.ws + WS_WOUT), 0, scr, r, F.lane); continue; } r -= I_O;
        p0_transpose_item(F.in[16], 1024, 2048, 2048, (unsigned short*)(F.ws + WS_WPQ), 0, scr, r, F.lane);
    }
    for (int it = w0; it < 262144 / 512; it += nw) p0_cvt_item(F.in[17], (unsigned short*)(F.ws + WS_SUBK), (size_t)it, F.lane);
    for (int it = w0; it < 2 * 16384; it += nw) {
        if (it < 16384) p0_fp4_row(F.in[18], F.ws + WS_U, (float*)(F.ws + WS_USC), it, F.lane);
        else p0_fp4_row(F.in[19], F.ws + WS_V, (float*)(F.ws + WS_VSC), it - 16384, F.lane);
    }
}

template <bool WITH_GATES, bool BF16_IN = false>
__device__ __forceinline__ void norm_mod_rows(Frame& F, const float* xin, const float* gvec, int sh_off, int sc_off, unsigned short* hout) {
    const float* MOD = (const float*)(F.ws + WS_MOD);
    const float* W8 = (const float*)(F.ws + WS_W8);
    LAS float* w8l = (LAS float*)F.lds;
    if (WITH_GATES) { for (int i = F.tid; i < 8192; i += 512) w8l[i] = W8[i]; __syncthreads(); }
    const int RPW = T / F.NGW;
    const int row0 = F.gw * RPW, b = row0 >> 12;
    LAS f32x4* GmL = (LAS f32x4*)(w8l + 8192); LAS f32x4* ShL = GmL + 256;
    if (F.tid < 256) { const f32x4 g = ((const f32x4*)gvec)[F.tid], sc = ((const f32x4*)(MOD + b * 6144 + sc_off))[F.tid]; GmL[F.tid] = g * (sc + 1.0f); ShL[F.tid] = ((const f32x4*)(MOD + b * 6144 + sh_off))[F.tid]; }
    __syncthreads();
    for (int rg = 0; rg < RPW; rg += 4) {
        f32x4 v[4][4];
#pragma unroll
        for (int r = 0; r < 4; ++r) {
            if (BF16_IN) { typedef unsigned u32x2_t __attribute__((ext_vector_type(2)));
                const u32x2_t* xr = (const u32x2_t*)((const unsigned short*)xin + (size_t)(row0 + rg + r) * 1024) + F.lane;
#pragma unroll
                for (int j = 0; j < 4; ++j) { const u32x2_t w = xr[64 * j]; v[r][j] = (f32x4){bflo(w.x), bfhi(w.x), bflo(w.y), bfhi(w.y)}; }
            } else { const f32x4* xr = (const f32x4*)(xin + (size_t)(row0 + rg + r) * 1024) + F.lane;
#pragma unroll
                for (int j = 0; j < 4; ++j) v[r][j] = xr[64 * j]; } }
#pragma unroll
        for (int r = 0; r < 4; ++r) {
            __builtin_amdgcn_sched_barrier(0);
            const int row = row0 + rg + r;
            float s = 0.f;
#pragma unroll
            for (int j = 0; j < 4; ++j) s += (v[r][j].x * v[r][j].x + v[r][j].y * v[r][j].y) + (v[r][j].z * v[r][j].z + v[r][j].w * v[r][j].w);
            const float rstd = rsqrtf(wave_sum_u(s) * (1.0f / 1024.0f) + EPS);
            float gd[8];
#pragma unroll
            for (int q = 0; q < 8; ++q) gd[q] = 0.f;
            unsigned long long* o8 = (unsigned long long*)(hout + (size_t)row * 1024) + F.lane;
#pragma unroll
            for (int j = 0; j < 4; ++j) {
                const int k4 = F.lane + 64 * j;
                const f32x4 h = (v[r][j] * rstd) * GmL[k4] + ShL[k4];
                if (WITH_GATES) {
#pragma unroll
                    for (int q = 0; q < 8; ++q) { const f32x4 w = ((const LAS f32x4*)(w8l + q * 1024))[k4]; gd[q] += (h.x * w.x + h.y * w.y) + (h.z * w.z + h.w * w.w); }
                }
                if (!(WITH_GATES && PROJ_ALL_FP8)) o8[64 * j] = (unsigned long long)pk2(h.x, h.y) | ((unsigned long long)pk2(h.z, h.w) << 32);
                if (WITH_GATES) { int p8 = __builtin_amdgcn_cvt_pk_fp8_f32(h.x, h.y, 0, false); p8 = __builtin_amdgcn_cvt_pk_fp8_f32(h.z, h.w, p8, true);
                    ((unsigned*)(F.ws + WS_H1Q + (size_t)row * 1024))[k4] = (unsigned)p8; }
            }
            if (WITH_GATES) {
#pragma unroll
                for (int q = 0; q < 8; ++q) gd[q] = wave_sum_u(gd[q]);
                if (F.lane == 0) { float* G = (float*)(F.ws + WS_GATES) + (size_t)row * 8;
#pragma unroll
                    for (int q = 0; q < 8; ++q) G[q] = gd[q] + (q < 4 ? F.in[8][q] : F.in[9][q - 4]); }
            }
        }
    }
}

__device__ __forceinline__ void attn_ref_item(Frame& F, int t, int h) {
    const unsigned short* QKVA = (const unsigned short*)(F.ws + WS_QKVA);
    const float* rel_bias = F.in[10];
    const int lane = F.lane, b = t >> 12, pos = t & 4095, j = pos >> 6;
    const v4u* qrow = (const v4u*)(QKVA + (size_t)t * 1536 + h * 64);
    v4u qv[8];
#pragma unroll
    for (int i = 0; i < 8; ++i) qv[i] = qrow[i];
    float s[9]; float m = -INFINITY;
#pragma unroll
    for (int c = 0; c < 9; ++c) {
        const int kc = j - 8 + c; s[c] = -INFINITY;
        if (kc >= 0) {
            const int kpos = kc * 64 + lane;
            const v4u* krow = (const v4u*)(QKVA + (size_t)(b * 4096 + kpos) * 1536 + 512 + h * 64);
            float d = 0.f;
#pragma unroll
            for (int i = 0; i < 8; ++i) { const v4u kv = krow[i]; d = dot2c(d, qv[i].x, kv.x); d = dot2c(d, qv[i].y, kv.y); d = dot2c(d, qv[i].z, kv.z); d = dot2c(d, qv[i].w, kv.w); }
            int rel = pos - kpos; rel = rel > 128 ? 128 : rel;
            s[c] = d * 0.125f + rel_bias[h * 257 + rel + 128];
            m = fmaxf(m, s[c]);
        }
    }
    m = wave_max(m);
    float l = 0.f;
#pragma unroll
    for (int c = 0; c < 9; ++c) { s[c] = (j - 8 + c >= 0) ? __expf(s[c] - m) : 0.f; l += s[c]; }
    l = wave_sum(l);
    float o = 0.f;
#pragma unroll
    for (int c = 0; c < 9; ++c) {
        const int kc = j - 8 + c;
        if (kc >= 0) {
            const unsigned short* vcol = QKVA + (size_t)(b * 4096 + kc * 64) * 1536 + 1024 + h * 64 + lane;
#pragma unroll 8
            for (int kk = 0; kk < 64; ++kk) { const float pk = __shfl(s[c], kk); o += pk * bf2f(vcol[(size_t)kk * 1536]); }
        }
    }
    ((unsigned short*)(F.ws + WS_YA))[(size_t)t * 512 + h * 64 + lane] = (unsigned short)f2bf(o / l);
}


constexpr int AT_KP = 144, AT_VP = 136;
constexpr int AT_K0 = 0, AT_V0 = 2 * 64 * AT_KP, AT_BIAS = AT_V0 + 2 * 64 * AT_VP;
__device__ __forceinline__ void attn_unit(Frame& F, int b, int h, int j0) {
    const unsigned short* QKVA = (const unsigned short*)(F.ws + WS_QKVA);
    LAS unsigned char* L = (LAS unsigned char*)F.lds;
    LAS float* biasL = (LAS float*)(L + AT_BIAS);
    const int tid = F.tid, lane = F.lane, wave = F.wave, hh = lane >> 5, q32 = lane & 31;
    const int c = j0 + (wave >> 1), qi = 32 * (wave & 1) + q32;
    const size_t tq = (size_t)b * SEQ + c * 64 + qi;
    constexpr float LOG2E = 1.4426950408889634f, C2 = 0.125f * LOG2E;
    if (tid < 257) biasL[tid] = F.in[10][h * 257 + tid] * LOG2E;
    bf16x8 qf[4];
#pragma unroll
    for (int s = 0; s < 4; ++s) qf[s] = *(const bf16x8*)(QKVA + tq * 1536 + h * 64 + 16 * s + 8 * hh);
    const int kc_lo = (j0 - 8 > 0) ? j0 - 8 : 0, nsteps = j0 + 3 - kc_lo + 1;
    const int skey = tid >> 3, sch = tid & 7;
    const unsigned short* ksrc = QKVA + ((size_t)b * SEQ + skey) * 1536 + 512 + h * 64 + sch * 8;
    v4u kreg = *(const v4u*)(ksrc + (size_t)kc_lo * 64 * 1536), vreg = *(const v4u*)(ksrc + (size_t)kc_lo * 64 * 1536 + 512);
    auto stage_write = [&](int buf) {
        *(LAS v4u*)(L + AT_K0 + buf * 64 * AT_KP + skey * AT_KP + sch * 16) = kreg;
        LAS unsigned short* vt = (LAS unsigned short*)(L + AT_V0 + buf * 64 * AT_VP) + skey;
        const unsigned w[4] = {vreg.x, vreg.y, vreg.z, vreg.w};
#pragma unroll
        for (int j = 0; j < 4; ++j) { vt[(8 * sch + 2 * j) * (AT_VP / 2)] = (unsigned short)(w[j] & 0xffffu); vt[(8 * sch + 2 * j + 1) * (AT_VP / 2)] = (unsigned short)(w[j] >> 16); }
    };
    stage_write(0);
    __syncthreads();
    float m_run = -INFINITY, l_run = 0.f;
    f32x16 o0 = {}, o1 = {};
    for (int i = 0; i < nsteps; ++i) {
        const int kc = kc_lo + i, buf = i & 1;
        if (i + 1 < nsteps) { kreg = *(const v4u*)(ksrc + (size_t)(kc + 1) * 64 * 1536); vreg = *(const v4u*)(ksrc + (size_t)(kc + 1) * 64 * 1536 + 512); }
        const int dch = c - kc;
        if (dch >= 0 && dch <= 8) {
            const LAS unsigned char* Kb = L + AT_K0 + buf * 64 * AT_KP + q32 * AT_KP + 16 * hh;
            f32x16 p0 = {}, p1 = {};
#pragma unroll
            for (int s = 0; s < 4; ++s) {
                const bf16x8 a0 = *(const LAS bf16x8*)(Kb + 32 * s), a1 = *(const LAS bf16x8*)(Kb + 32 * AT_KP + 32 * s);
                p0 = __builtin_amdgcn_mfma_f32_32x32x16_bf16(a0, qf[s], p0, 0, 0, 0);
                p1 = __builtin_amdgcn_mfma_f32_32x32x16_bf16(a1, qf[s], p1, 0, 0, 0);
            }
            float mx = -INFINITY;
            if (dch >= 3) {
                const float bc = biasL[256];
#pragma unroll
                for (int r = 0; r < 16; ++r) { p0[r] = p0[r] * C2 + bc; p1[r] = p1[r] * C2 + bc; mx = fmaxf(mx, fmaxf(p0[r], p1[r])); }
            } else {
                const int base = dch * 64 + qi - 4 * hh + 128;
#pragma unroll
                for (int r = 0; r < 16; ++r) { const int ki = (r & 3) + 8 * (r >> 2);
                    int i0 = base - ki, i1 = base - ki - 32; i0 = i0 > 256 ? 256 : i0; i1 = i1 > 256 ? 256 : i1;
                    p0[r] = p0[r] * C2 + biasL[i0]; p1[r] = p1[r] * C2 + biasL[i1]; mx = fmaxf(mx, fmaxf(p0[r], p1[r])); }
            }
            mx = fmaxf(mx, __shfl_xor(mx, 32));
            const float m_new = fmaxf(m_run, mx), alpha = __builtin_amdgcn_exp2f(m_run - m_new);
            m_run = m_new;
            float ls = 0.f;
#pragma unroll
            for (int r = 0; r < 16; ++r) { p0[r] = __builtin_amdgcn_exp2f(p0[r] - m_new); p1[r] = __builtin_amdgcn_exp2f(p1[r] - m_new); ls += p0[r] + p1[r]; }
            l_run = l_run * alpha + ls;
#pragma unroll
            for (int r = 0; r < 16; ++r) { o0[r] *= alpha; o1[r] *= alpha; }
            const LAS unsigned char* Vb = L + AT_V0 + buf * 64 * AT_VP + q32 * AT_VP + 8 * hh;
#pragma unroll
            for (int tt = 0; tt < 2; ++tt)
#pragma unroll
                for (int s = 0; s < 2; ++s) {
                    v4u pb;
                    if (tt == 0) { pb.x = cvtpk(p0[8 * s + 0], p0[8 * s + 1]); pb.y = cvtpk(p0[8 * s + 2], p0[8 * s + 3]); pb.z = cvtpk(p0[8 * s + 4], p0[8 * s + 5]); pb.w = cvtpk(p0[8 * s + 6], p0[8 * s + 7]); }
                    else { pb.x = cvtpk(p1[8 * s + 0], p1[8 * s + 1]); pb.y = cvtpk(p1[8 * s + 2], p1[8 * s + 3]); pb.z = cvtpk(p1[8 * s + 4], p1[8 * s + 5]); pb.w = cvtpk(p1[8 * s + 6], p1[8 * s + 7]); }
                    const bf16x8 bfrag = __builtin_bit_cast(bf16x8, pb);
                    const int koff = (32 * tt + 16 * s) * 2;
#pragma unroll
                    for (int et = 0; et < 2; ++et) {
                        typedef unsigned u32x2_t __attribute__((ext_vector_type(2)));
                        const u32x2_t lo = *(const LAS u32x2_t*)(Vb + et * 32 * AT_VP + koff), hi2 = *(const LAS u32x2_t*)(Vb + et * 32 * AT_VP + koff + 16);
                        v4u av; av.x = lo.x; av.y = lo.y; av.z = hi2.x; av.w = hi2.y;
                        const bf16x8 afrag = __builtin_bit_cast(bf16x8, av);
                        if (et == 0) o0 = __builtin_amdgcn_mfma_f32_32x32x16_bf16(afrag, bfrag, o0, 0, 0, 0);
                        else o1 = __builtin_amdgcn_mfma_f32_32x32x16_bf16(afrag, bfrag, o1, 0, 0, 0);
                    }
                }
        }
        if (i + 1 < nsteps) stage_write(buf ^ 1);
        __syncthreads();
    }
    const float lt = l_run + __shfl_xor(l_run, 32), inv = 1.0f / lt;
    unsigned short* yrow = (unsigned short*)(F.ws + WS_YA) + tq * 512 + h * 64 + 4 * hh;
#pragma unroll
    for (int g = 0; g < 4; ++g) {
        typedef unsigned u32x2_t __attribute__((ext_vector_type(2)));
        u32x2_t w0, w1;
        w0.x = cvtpk(o0[4 * g] * inv, o0[4 * g + 1] * inv); w0.y = cvtpk(o0[4 * g + 2] * inv, o0[4 * g + 3] * inv);
        w1.x = cvtpk(o1[4 * g] * inv, o1[4 * g + 1] * inv); w1.y = cvtpk(o1[4 * g + 2] * inv, o1[4 * g + 3] * inv);
        *(u32x2_t*)(yrow + 8 * g) = w0; *(u32x2_t*)(yrow + 32 + 8 * g) = w1;
    }
}


__device__ __forceinline__ void qk_conv_slice(Frame& F, int b, int h) {
    const unsigned short* QKB = (const unsigned short*)(F.ws + WS_QKB);
    unsigned short* QKC = (unsigned short*)(F.ws + WS_QKC);
    const int cg = F.tid & 31, cgp = (cg < 16 ? 16 * h + cg : 64 + 16 * h + (cg - 16));
    float wv[4][8], bv[8];
#pragma unroll
    for (int jj = 0; jj < 4; ++jj)
#pragma unroll
        for (int c = 0; c < 8; ++c) wv[jj][c] = F.in[6][jj * 1024 + 8 * cgp + c];
#pragma unroll
    for (int c = 0; c < 8; ++c) bv[c] = F.in[7][8 * cgp + c];
    const float osc = (cgp >= 64) ? 0.08838834764831845f : 1.0f;
    for (int rq4 = F.tid >> 5; rq4 < SEQ / 4; rq4 += 16) {
        const size_t r0 = (size_t)b * SEQ + rq4 * 4; const int pos0 = rq4 * 4;
        v4u rq[7];
#pragma unroll
        for (int r = 0; r < 7; ++r) rq[r] = (pos0 - 3 + r >= 0) ? *(const v4u*)(QKB + (r0 - 3 + r) * 1024 + 8 * cgp) : (v4u){0u, 0u, 0u, 0u};
#pragma unroll
        for (int i = 0; i < 4; ++i) {
            float o[8];
#pragma unroll
            for (int c = 0; c < 8; ++c) o[c] = bv[c];
#pragma unroll
            for (int jj = 0; jj < 4; ++jj) { const v4u u = rq[i + jj]; const unsigned w[4] = {u.x, u.y, u.z, u.w};
#pragma unroll
                for (int c2 = 0; c2 < 4; ++c2) { o[2 * c2] += wv[jj][2 * c2] * bflo(w[c2]); o[2 * c2 + 1] += wv[jj][2 * c2 + 1] * bfhi(w[c2]); } }
#pragma unroll
            for (int c = 0; c < 8; ++c) o[c] = osc * o[c] / (1.0f + __expf(-o[c]));
            v4u w; w.x = cvtpk(o[0], o[1]); w.y = cvtpk(o[2], o[3]); w.z = cvtpk(o[4], o[5]); w.w = cvtpk(o[6], o[7]);
            *(v4u*)(QKC + (r0 + i) * 1024 + 8 * cgp) = w;
        }
    }
    asm volatile("s_waitcnt vmcnt(0)" ::: "memory");
    __syncthreads();
}
__device__ __forceinline__ void qk_conv_pass(Frame& F) {
    const unsigned short* QKB = (const unsigned short*)(F.ws + WS_QKB);
    unsigned short* QKC = (unsigned short*)(F.ws + WS_QKC);
    const int gtid = blockIdx.x * 512 + F.tid, cgp = gtid & 127, NTH = F.G * 512;
    float wv[4][8], bv[8];
#pragma unroll
    for (int jj = 0; jj < 4; ++jj)
#pragma unroll
        for (int c = 0; c < 8; ++c) wv[jj][c] = F.in[6][jj * 1024 + 8 * cgp + c];
#pragma unroll
    for (int c = 0; c < 8; ++c) bv[c] = F.in[7][8 * cgp + c];
    const float osc = (cgp >= 64) ? 0.08838834764831845f : 1.0f;
    for (int it = gtid; it < (T / 4) * 128; it += NTH) {
        const int rq4 = it >> 7; const size_t r0 = (size_t)rq4 * 4; const int pos0 = (int)(r0 & 4095);
        v4u rq[7];
#pragma unroll
        for (int r = 0; r < 7; ++r) rq[r] = (pos0 - 3 + r >= 0) ? *(const v4u*)(QKB + (r0 - 3 + r) * 1024 + 8 * cgp) : (v4u){0u, 0u, 0u, 0u};
#pragma unroll
        for (int i = 0; i < 4; ++i) {
            float o[8];
#pragma unroll
            for (int c = 0; c < 8; ++c) o[c] = bv[c];
#pragma unroll
            for (int jj = 0; jj < 4; ++jj) { const v4u u = rq[i + jj]; const unsigned w[4] = {u.x, u.y, u.z, u.w};
#pragma unroll
                for (int c2 = 0; c2 < 4; ++c2) { o[2 * c2] += wv[jj][2 * c2] * bflo(w[c2]); o[2 * c2 + 1] += wv[jj][2 * c2 + 1] * bfhi(w[c2]); } }
#pragma unroll
            for (int c = 0; c < 8; ++c) o[c] = osc * o[c] / (1.0f + __expf(-o[c]));
            v4u w; w.x = cvtpk(o[0], o[1]); w.y = cvtpk(o[2], o[3]); w.z = cvtpk(o[4], o[5]); w.w = cvtpk(o[6], o[7]);
            *(v4u*)(QKC + (r0 + i) * 1024 + 8 * cgp) = w;
        }
    }
}


constexpr int ML_QS = 0, ML_KS = 17408, ML_KWS = 34816, ML_VS = 55296, ML_CT = 75776, ML_YT = 110592, ML_SC = 128000, ML_N = 130688, ML_HSQ = 131712, ML_NG = 132224, ML_QN = 132736, ML_PB = 133120, ML_DSP = 139264;
constexpr int ML_SCF = 336;
constexpr int ML_P = 272, ML_PT = 320;
typedef short s16x4_t __attribute__((ext_vector_type(4)));
__device__ __forceinline__ bf16x8 tr_frag(const LAS unsigned char* tile, int pitch, int rowA, int rowB, int colblk, int lane) {
    const int q = (lane & 15) >> 2, p = lane & 3, ch = (lane >> 4) & 1;
    const LAS unsigned char* a = tile + (rowA + q) * pitch + (colblk + 16 * ch + 4 * p) * 2;
    const LAS unsigned char* c = tile + (rowB + q) * pitch + (colblk + 16 * ch + 4 * p) * 2;
    const s16x4_t lo = __builtin_bit_cast(s16x4_t, __builtin_amdgcn_ds_read_tr16_b64_v4i16((LAS s16x4_t*)a));
    const s16x4_t hi = __builtin_bit_cast(s16x4_t, __builtin_amdgcn_ds_read_tr16_b64_v4i16((LAS s16x4_t*)c));
    return (bf16x8){lo[0], lo[1], lo[2], lo[3], hi[0], hi[1], hi[2], hi[3]};
}
__device__ __forceinline__ void mlstm_unit(Frame& F, int b, int h) {
    LAS unsigned char* L = (LAS unsigned char*)F.lds;
    const unsigned short* VB = (const unsigned short*)(F.ws + WS_VB);
    const unsigned short* OB = (const unsigned short*)(F.ws + WS_OB);
    unsigned short* YB = (unsigned short*)(F.ws + WS_YB);
    const float* GATES = (const float*)(F.ws + WS_GATES);
    const float* ng = F.in[11];
    const int tid = F.tid, lane = F.lane, wave = F.wave, hh = lane >> 5, q32 = lane & 31;
    const int et = wave >> 1, lt = wave & 1, eb = wave & 3, dbp = wave >> 2;
    LAS float* SC = (LAS float*)(L + ML_SC);
    LAS float* NV = (LAS float*)(L + ML_N);
    LAS float* HSQ = (LAS float*)(L + ML_HSQ);
    for (int i = tid; i < 34816 / 4; i += 512) ((LAS unsigned*)(L + ML_CT))[i] = 0u;
    if (tid < 256) NV[tid] = 0.f;
    if (tid < 128) { HSQ[tid] = 0.f; ((LAS float*)(L + ML_NG))[tid] = ng[h * 128 + tid]; }
    f32x16 accC0 = {}, accC1 = {};
    float m_state = 0.f;
    const int sl = tid >> 3, sp = tid & 7;
    const size_t rowb = (size_t)b * SEQ;
    const unsigned short* QKC = (const unsigned short*)(F.ws + WS_QKC);
    const unsigned short* qsrc = QKC + h * 128 + 8 * sp;
    const unsigned short* vsrc = VB + h * 128 + 8 * sp;
    const int fr = tid >> 4, fc = tid & 15;
    v4u rq[2], rk[2], rv[2], rob[2]; float gi = 0.f, gf = 0.f;
    auto load_raw = [&](int j) {
        const size_t tr = rowb + 64 * j + sl;
#pragma unroll
        for (int i = 0; i < 2; ++i) { rq[i] = *(const v4u*)(qsrc + tr * 1024 + 64 * i); rk[i] = *(const v4u*)(qsrc + tr * 1024 + 512 + 64 * i); rv[i] = *(const v4u*)(vsrc + tr * 512 + 64 * i); }
        if (wave == 0) { const float* gp = GATES + (rowb + 64 * j + lane) * 8; gi = gp[h]; gf = gp[4 + h]; }
    };
    auto load_ob = [&](int j) {
#pragma unroll
        for (int i = 0; i < 2; ++i) rob[i] = *(const v4u*)(OB + (rowb + 64 * j + fr + 32 * i) * 512 + h * 128 + 8 * fc);
    };
    auto flush = [&](int j) {
#pragma unroll
        for (int i = 0; i < 2; ++i) { const int r = fr + 32 * i;
            const v4u y = *(const LAS v4u*)(L + ML_YT + r * ML_P + fc * 16); const v4u o = rob[i]; v4u w;
            w.x = cvtpk(bflo(y.x) * bflo(o.x), bfhi(y.x) * bfhi(o.x)); w.y = cvtpk(bflo(y.y) * bflo(o.y), bfhi(y.y) * bfhi(o.y));
            w.z = cvtpk(bflo(y.z) * bflo(o.z), bfhi(y.z) * bfhi(o.z)); w.w = cvtpk(bflo(y.w) * bflo(o.w), bfhi(y.w) * bfhi(o.w));
            *(v4u*)(YB + (rowb + 64 * j + r) * 512 + h * 128 + 8 * fc) = w; }
    };
    auto gates_compute = [&](int buf) {
        LAS float* sc = SC + buf * ML_SCF;
        const float li = gi, lf = fminf(gf, 0.f) - log1pf(__expf(-fabsf(gf)));
        const float a = scan_sum64(lf);
        const float A = lane63(a);
        const float g = A - a + li;
        const float gmax = lane63(scan_max64(g));
        const float m_new = fmaxf(A + m_state, gmax);
        const float ws = li - a;
        const float pm = scan_max64(ws);
        const float mrow = a + fmaxf(m_state, pm);
        sc[lane] = __expf(g - m_new); sc[64 + lane] = ws; sc[128 + lane] = a - mrow; sc[192 + lane] = __expf(a + m_state - mrow); sc[256 + lane] = __expf(-mrow);
        if (lane == 0) sc[320] = __expf(A + m_state - m_new);
        m_state = m_new;
    };
    load_raw(0);
    if (wave == 0) gates_compute(0);
    __syncthreads();
    for (int j = 0; j < 64; ++j) {
        const int cur = j & 1;
        LAS float* sc = SC + cur * ML_SCF;
        {
            LAS float* nq = NV + cur * 128;
            float qp = 0.f;
#pragma unroll
            for (int i = 0; i < 2; ++i) { const f32x4 n0 = *(const LAS f32x4*)(nq + 64 * i + 8 * sp), n1 = *(const LAS f32x4*)(nq + 64 * i + 8 * sp + 4);
                qp += bflo(rq[i].x) * n0.x + bfhi(rq[i].x) * n0.y + bflo(rq[i].y) * n0.z + bfhi(rq[i].y) * n0.w + bflo(rq[i].z) * n1.x + bfhi(rq[i].z) * n1.y + bflo(rq[i].w) * n1.z + bfhi(rq[i].w) * n1.w; }
            qp += __shfl_xor(qp, 1); qp += __shfl_xor(qp, 2); qp += __shfl_xor(qp, 4);
            if (sp == 0) ((LAS float*)(L + ML_QN))[sl] = qp;
        }
        {
            const float wk = sc[sl];
#pragma unroll
            for (int i = 0; i < 2; ++i) {
                *(LAS v4u*)(L + ML_QS + sl * ML_P + (sp + 8 * i) * 16) = rq[i];
                *(LAS v4u*)(L + ML_KS + sl * ML_P + (sp + 8 * i) * 16) = rk[i];
                v4u kw; kw.x = cvtpk(bflo(rk[i].x) * wk, bfhi(rk[i].x) * wk); kw.y = cvtpk(bflo(rk[i].y) * wk, bfhi(rk[i].y) * wk); kw.z = cvtpk(bflo(rk[i].z) * wk, bfhi(rk[i].z) * wk); kw.w = cvtpk(bflo(rk[i].w) * wk, bfhi(rk[i].w) * wk);
                *(LAS v4u*)(L + ML_KWS + sl * ML_PT + (sp + 8 * i) * 16) = kw;
                *(LAS v4u*)(L + ML_VS + sl * ML_PT + (sp + 8 * i) * 16) = rv[i];
            }
        }
        if (j < 63) load_raw(j + 1);
        if (j > 0) load_ob(j - 1);
        __syncthreads();
        const int l = 32 * lt + q32;
        const float u_l = sc[128 + l], wi_l = sc[192 + l], fl_l = sc[256 + l], decay = sc[320];
        LAS float* nold = NV + cur * 128; LAS float* nnew = NV + (cur ^ 1) * 128;
        const float qn = ((const LAS float*)(L + ML_QN))[l];
        const LAS unsigned char* Qb = L + ML_QS + l * ML_P + 16 * hh;
#if ML_SHARE_P
        {
            const int sst = (wave == 3) ? 1 : 0;
            if (wave == 4 || wave == 1 || wave == 3) {
                const int blk = (wave == 4) ? 0 : 1 + sst;
                f32x16 sa = {};
                const LAS unsigned char* Kb = L + ML_KS + (32 * sst + q32) * ML_P + 16 * hh;
#pragma unroll
                for (int ks = 0; ks < 8; ++ks) sa = __builtin_amdgcn_mfma_f32_32x32x16_bf16(*(const LAS bf16x8*)(Kb + 32 * ks), *(const LAS bf16x8*)(Qb + 32 * ks), sa, 0, 0, 0);
                float ds = 0.f;
#pragma unroll
                for (int r = 0; r < 16; ++r) { const int sidx = 32 * sst + (r & 3) + 8 * (r >> 2) + 4 * hh;
                    const float p = (sidx <= l) ? sa[r] * __expf(u_l + sc[64 + sidx]) : 0.f; sa[r] = p; ds += p; }
                ds += __shfl_xor(ds, 32);
#pragma unroll
                for (int s2 = 0; s2 < 2; ++s2) { v4u pbw; pbw.x = cvtpk(sa[8 * s2 + 0], sa[8 * s2 + 1]); pbw.y = cvtpk(sa[8 * s2 + 2], sa[8 * s2 + 3]); pbw.z = cvtpk(sa[8 * s2 + 4], sa[8 * s2 + 5]); pbw.w = cvtpk(sa[8 * s2 + 6], sa[8 * s2 + 7]);
                    *(LAS v4u*)(L + ML_PB + blk * 2048 + s2 * 1024 + lane * 16) = pbw; }
                if (hh == 0) ((LAS float*)(L + ML_DSP))[blk * 32 + q32] = ds;
            }
        }
        f32x16 accH = {};
        { const LAS unsigned char* Cb = L + ML_CT + (32 * et + q32) * ML_P + 16 * hh;
#pragma unroll
          for (int ks = 0; ks < 8; ++ks) accH = __builtin_amdgcn_mfma_f32_32x32x16_bf16(*(const LAS bf16x8*)(Cb + 32 * ks), *(const LAS bf16x8*)(Qb + 32 * ks), accH, 0, 0, 0); }
#pragma unroll
        for (int r = 0; r < 16; ++r) accH[r] *= wi_l;
#else
        float dsum = 0.f;
        v4u pb[2][2];
#pragma unroll
        for (int st = 0; st < 2; ++st) {
            if (st <= lt) {
                f32x16 sa = {};
                const LAS unsigned char* Kb = L + ML_KS + (32 * st + q32) * ML_P + 16 * hh;
#pragma unroll
                for (int ks = 0; ks < 8; ++ks) sa = __builtin_amdgcn_mfma_f32_32x32x16_bf16(*(const LAS bf16x8*)(Kb + 32 * ks), *(const LAS bf16x8*)(Qb + 32 * ks), sa, 0, 0, 0);
#pragma unroll
                for (int r = 0; r < 16; ++r) { const int sidx = 32 * st + (r & 3) + 8 * (r >> 2) + 4 * hh;
                    const float p = (sidx <= l) ? sa[r] * __expf(u_l + sc[64 + sidx]) : 0.f; sa[r] = p; dsum += p; }
#pragma unroll
                for (int s2 = 0; s2 < 2; ++s2) { pb[st][s2].x = cvtpk(sa[8 * s2 + 0], sa[8 * s2 + 1]); pb[st][s2].y = cvtpk(sa[8 * s2 + 2], sa[8 * s2 + 3]); pb[st][s2].z = cvtpk(sa[8 * s2 + 4], sa[8 * s2 + 5]); pb[st][s2].w = cvtpk(sa[8 * s2 + 6], sa[8 * s2 + 7]); }
            }
        }
        dsum += __shfl_xor(dsum, 32);
        f32x16 accH = {};
        { const LAS unsigned char* Cb = L + ML_CT + (32 * et + q32) * ML_P + 16 * hh;
#pragma unroll
          for (int ks = 0; ks < 8; ++ks) accH = __builtin_amdgcn_mfma_f32_32x32x16_bf16(*(const LAS bf16x8*)(Cb + 32 * ks), *(const LAS bf16x8*)(Qb + 32 * ks), accH, 0, 0, 0); }
#pragma unroll
        for (int r = 0; r < 16; ++r) accH[r] *= wi_l;
#pragma unroll
        for (int st = 0; st < 2; ++st) {
            if (st <= lt) {
#pragma unroll
                for (int s2 = 0; s2 < 2; ++s2) {
                    const int ra = 32 * st + 16 * s2 + 4 * hh;
                    accH = __builtin_amdgcn_mfma_f32_32x32x16_bf16(tr_frag(L + ML_VS, ML_PT, ra, ra + 8, 32 * et, lane), __builtin_bit_cast(bf16x8, pb[st][s2]), accH, 0, 0, 0);
                }
            }
        }
#if !ML_SHARE_P
        { const float den = wi_l * qn + dsum, inv = 1.0f / fmaxf(fabsf(den), fl_l); float ssq = 0.f;
#pragma unroll
          for (int r = 0; r < 16; ++r) { accH[r] *= inv; ssq += accH[r] * accH[r]; }
          ssq += __shfl_xor(ssq, 32);
          if (hh == 0) atomicAdd((float*)(HSQ + cur * 64 + l), ssq); }
#endif
#endif
#pragma unroll
        for (int r = 0; r < 16; ++r) { accC0[r] *= decay; accC1[r] *= decay; }
#pragma unroll
        for (int ks = 0; ks < 4; ++ks) { const int ra = 16 * ks + 8 * hh;
            const bf16x8 bvv = tr_frag(L + ML_VS, ML_PT, ra, ra + 4, 32 * eb, lane);
            accC0 = __builtin_amdgcn_mfma_f32_32x32x16_bf16(tr_frag(L + ML_KWS, ML_PT, ra, ra + 4, 64 * dbp, lane), bvv, accC0, 0, 0, 0);
            accC1 = __builtin_amdgcn_mfma_f32_32x32x16_bf16(tr_frag(L + ML_KWS, ML_PT, ra, ra + 4, 64 * dbp + 32, lane), bvv, accC1, 0, 0, 0); }
        if (wave == 2) {
            float ps[8];
#pragma unroll
            for (int c = 0; c < 8; ++c) ps[c] = 0.f;
#pragma unroll
            for (int r = 0; r < 16; ++r) { const v4u k8 = *(const LAS v4u*)(L + ML_KWS + (16 * (lane >> 4) + r) * ML_PT + (lane & 15) * 16);
                ps[0] += bflo(k8.x); ps[1] += bfhi(k8.x); ps[2] += bflo(k8.y); ps[3] += bfhi(k8.y); ps[4] += bflo(k8.z); ps[5] += bfhi(k8.z); ps[6] += bflo(k8.w); ps[7] += bfhi(k8.w); }
#pragma unroll
            for (int c = 0; c < 8; ++c) { ps[c] += __shfl_xor(ps[c], 16); ps[c] += __shfl_xor(ps[c], 32); }
            if (lane < 16) {
#pragma unroll
                for (int c = 0; c < 8; ++c) nnew[8 * lane + c] = decay * nold[8 * lane + c] + ps[c]; }
        }
        if (wave == 0 && j < 63) gates_compute(cur ^ 1);
#if ML_SHARE_P
        __syncthreads();
        {
            const LAS float* dsp = (const LAS float*)(L + ML_DSP);
            const float dsum = (lt == 0) ? dsp[q32] : dsp[32 + q32] + dsp[64 + q32];
#pragma unroll
            for (int st = 0; st < 2; ++st) {
                if (st <= lt) {
                    const int blk = (lt == 0) ? 0 : 1 + st;
#pragma unroll
                    for (int s2 = 0; s2 < 2; ++s2) {
                        const int ra = 32 * st + 16 * s2 + 4 * hh;
                        const v4u pbw = *(const LAS v4u*)(L + ML_PB + blk * 2048 + s2 * 1024 + lane * 16);
                        accH = __builtin_amdgcn_mfma_f32_32x32x16_bf16(tr_frag(L + ML_VS, ML_PT, ra, ra + 8, 32 * et, lane), __builtin_bit_cast(bf16x8, pbw), accH, 0, 0, 0);
                    }
                }
            }
            const float den = wi_l * qn + dsum, inv = 1.0f / fmaxf(fabsf(den), fl_l); float ssq = 0.f;
#pragma unroll
            for (int r = 0; r < 16; ++r) { accH[r] *= inv; ssq += accH[r] * accH[r]; }
            ssq += __shfl_xor(ssq, 32);
            if (hh == 0) atomicAdd((float*)(HSQ + cur * 64 + l), ssq);
        }
#endif
        if (j > 0) flush(j - 1);
        __syncthreads();
        {
            const float rstd = rsqrtf(HSQ[cur * 64 + l] * (1.0f / 128.0f) + EPS);
#pragma unroll
            for (int g4 = 0; g4 < 4; ++g4) {
                typedef unsigned u32x2_t __attribute__((ext_vector_type(2)));
                const int e0 = 32 * et + 8 * g4 + 4 * hh;
                const f32x4 gv = *(const LAS f32x4*)(L + ML_NG + e0 * 4);
                u32x2_t w;
                w.x = cvtpk(accH[4 * g4] * rstd * gv.x, accH[4 * g4 + 1] * rstd * gv.y);
                w.y = cvtpk(accH[4 * g4 + 2] * rstd * gv.z, accH[4 * g4 + 3] * rstd * gv.w);
                *(LAS u32x2_t*)(L + ML_YT + l * ML_P + e0 * 2) = w;
            }
#pragma unroll
            for (int g4 = 0; g4 < 4; ++g4) {
                typedef unsigned u32x2_t __attribute__((ext_vector_type(2)));
                u32x2_t w0, w1;
                w0.x = cvtpk(accC0[4 * g4], accC0[4 * g4 + 1]); w0.y = cvtpk(accC0[4 * g4 + 2], accC0[4 * g4 + 3]);
                w1.x = cvtpk(accC1[4 * g4], accC1[4 * g4 + 1]); w1.y = cvtpk(accC1[4 * g4 + 2], accC1[4 * g4 + 3]);
                *(LAS u32x2_t*)(L + ML_CT + (32 * eb + q32) * ML_P + (64 * dbp + 8 * g4 + 4 * hh) * 2) = w0;
                *(LAS u32x2_t*)(L + ML_CT + (32 * eb + q32) * ML_P + (64 * dbp + 32 + 8 * g4 + 4 * hh) * 2) = w1;
            }
            if (tid < 64) HSQ[(cur ^ 1) * 64 + tid] = 0.f;
        }
    }
    load_ob(63);
    __syncthreads();
    flush(63);
    __syncthreads();
}

__device__ __forceinline__ void mlstm_ref_unit(Frame& F, int b, int h) {
    const unsigned short* QKB = (const unsigned short*)(F.ws + WS_QKB);
    const unsigned short* VB = (const unsigned short*)(F.ws + WS_VB);
    const unsigned short* OB = (const unsigned short*)(F.ws + WS_OB);
    const float* GATES = (const float*)(F.ws + WS_GATES);
    const float* conv_w = F.in[6]; const float* conv_b = F.in[7]; const float* ng = F.in[11];
    float* qs = (float*)F.lds; float* ks = qs + 128; float* vs = ks + 128; float* sc = vs + 128;
    float* part = sc + 16;
    float* red = part + 512;
    const int tid = F.tid, e = tid & 127, dq = tid >> 7;
    float C[32];
#pragma unroll
    for (int i = 0; i < 32; ++i) C[i] = 0.f;
    float nst = 0.f;
    float cw[4] = {0.f, 0.f, 0.f, 0.f}; float cb = 0.f; int ccol = 0;
    if (tid < 256) { ccol = (tid < 128 ? 0 : 512) + h * 128 + (tid & 127);
#pragma unroll
        for (int j = 0; j < 4; ++j) cw[j] = conv_w[j * 1024 + ccol]; cb = conv_b[ccol]; }
    const float gsc = ng[h * 128 + e];
    for (int tok = 0; tok < SEQ; ++tok) {
        const size_t t = (size_t)b * SEQ + tok;
        if (tid < 256) {
            float a = cb;
#pragma unroll
            for (int j = 0; j < 4; ++j) { const int tt = tok - 3 + j; if (tt >= 0) a += cw[j] * bf2f(QKB[((size_t)b * SEQ + tt) * 1024 + ccol]); }
            a = a / (1.0f + __expf(-a));
            if (tid < 128) qs[tid] = a; else ks[tid - 128] = a * 0.08838834764831845f;
        } else if (tid < 384) { vs[tid - 256] = bf2f(VB[t * 512 + h * 128 + (tid - 256)]); }
        else if (tid == 384) { sc[0] = sigmoidf_(GATES[t * 8 + 4 + h]); sc[1] = __expf(GATES[t * 8 + h]); }
        __syncthreads();
        const float fg = sc[0], ig = sc[1], ve = vs[e];
        float acc = 0.f;
#pragma unroll
        for (int i = 0; i < 32; ++i) { const int d = dq * 32 + i; C[i] = fg * C[i] + (ig * ks[d]) * ve; acc += qs[d] * C[i]; }
        part[dq * 128 + e] = acc;
        if (tid < 128) { nst = fg * nst + ig * ks[tid]; const float qn = wave_sum(qs[tid] * nst); if (F.lane == 0) red[F.wave] = qn; }
        __syncthreads();
        float hv = 0.f;
        if (tid < 128) { const float num = (part[e] + part[128 + e]) + (part[256 + e] + part[384 + e]); const float den = red[0] + red[1];
            hv = num / fmaxf(fabsf(den), 1.0f); const float ss = wave_sum(hv * hv); if (F.lane == 0) red[2 + F.wave] = ss; }
        __syncthreads();
        if (tid < 128) { const float rstd = rsqrtf((red[2] + red[3]) * (1.0f / 128.0f) + EPS);
            const float y = hv * rstd * gsc * bf2f(OB[t * 512 + h * 128 + e]);
            ((unsigned short*)(F.ws + WS_YB))[t * 512 + h * 128 + e] = (unsigned short)f2bf(y); }
        __syncthreads();
    }
}

__device__ __forceinline__ void argmax_step(float& bv, int& bi) {
#pragma unroll
    for (int o = 1; o < 64; o <<= 1) { const float ov = __shfl_xor(bv, o); const int oi = __shfl_xor(bi, o); if (ov > bv || (ov == bv && oi < bi)) { bv = ov; bi = oi; } }
}
__device__ __forceinline__ void peer_route_ref(Frame& F) {
    const unsigned short* PQ = (const unsigned short*)(F.ws + WS_PQ);
    const unsigned short* SUBK = (const unsigned short*)(F.ws + WS_SUBK);
    unsigned* ROUTE = (unsigned*)(F.ws + WS_ROUTE);
    unsigned char* wl = F.lds + F.wave * 8192;
    unsigned short* ql = (unsigned short*)wl;
    float* tv = (float*)(wl + 4096);
    int* ti = (int*)(wl + 4096 + 1024);
    const int lane = F.lane;
    for (int t = F.gw; t < T; t += F.NGW) {
        { const v4u* src = (const v4u*)(PQ + (size_t)t * 2048); v4u* dst = (v4u*)ql;
#pragma unroll
          for (int i = 0; i < 4; ++i) dst[lane + 64 * i] = src[lane + 64 * i]; }
        LDS_WAIT(); asm volatile("" ::: "memory");
        for (int g = 0; g < 16; ++g) {
            const v4u* k0 = (const v4u*)(SUBK + (size_t)(g * 128 + lane) * 128);
            const v4u* k1 = (const v4u*)(SUBK + (size_t)(g * 128 + 64 + lane) * 128);
            const v4u* qg = (const v4u*)(ql + g * 128);
            float s0 = 0.f, s1 = 0.f;
#pragma unroll 4
            for (int ch = 0; ch < 16; ++ch) { const v4u q = qg[ch], a = k0[ch], c = k1[ch];
                s0 = dot2c(s0, q.x, a.x); s0 = dot2c(s0, q.y, a.y); s0 = dot2c(s0, q.z, a.z); s0 = dot2c(s0, q.w, a.w);
                s1 = dot2c(s1, q.x, c.x); s1 = dot2c(s1, q.y, c.y); s1 = dot2c(s1, q.z, c.z); s1 = dot2c(s1, q.w, c.w); }
            float myv = 0.f; int myi = 0;
            for (int it = 0; it < 16; ++it) {
                float bv; int bi; if (s0 >= s1) { bv = s0; bi = lane; } else { bv = s1; bi = lane + 64; }
                argmax_step(bv, bi);
                if (it == lane) { myv = bv; myi = bi; }
                if (bi == lane) s0 = -INFINITY; if (bi == lane + 64) s1 = -INFINITY;
            }
            if (lane < 16) { tv[g * 16 + lane] = myv; ti[g * 16 + lane] = myi; }
        }
        LDS_WAIT(); asm volatile("" ::: "memory");
        for (int h = 0; h < 8; ++h) {
            float cv[4];
#pragma unroll
            for (int r = 0; r < 4; ++r) cv[r] = tv[(2 * h) * 16 + (lane >> 2)] + tv[(2 * h + 1) * 16 + 4 * (lane & 3) + r];
            float myv = -INFINITY; int myc = 0;
            for (int it = 0; it < 16; ++it) {
                float bv = cv[0]; int bi = 4 * lane;
#pragma unroll
                for (int r = 1; r < 4; ++r) if (cv[r] > bv) { bv = cv[r]; bi = 4 * lane + r; }
                argmax_step(bv, bi);
                if (it == lane) { myv = bv; myc = bi; }
#pragma unroll
                for (int r = 0; r < 4; ++r) if (bi == 4 * lane + r) cv[r] = -INFINITY;
            }
            const float mx = __shfl(myv, 0);
            float ex = lane < 16 ? __expf(myv - mx) : 0.f;
            const float sum = wave_sum(ex);
            if (lane < 16) { const int e = ti[(2 * h) * 16 + (myc >> 4)] * 128 + ti[(2 * h + 1) * 16 + (myc & 15)];
                ROUTE[(size_t)t * 128 + h * 16 + lane] = ((unsigned)e << 16) | f2bf(ex / sum); }
        }
        LDS_WAIT(); asm volatile("" ::: "memory");
    }
}


__device__ __forceinline__ void sort_insert16(float (&a)[16], float x) {
#pragma unroll
    for (int k = 15; k >= 1; --k) a[k] = __builtin_amdgcn_fmed3f(a[k - 1], x, a[k]);
    a[0] = fmaxf(a[0], x);
}
__device__ __forceinline__ void merge_halves16(float (&a)[16]) {
    float c[16];
#pragma unroll
    for (int k = 0; k < 16; ++k) c[k] = __shfl_xor(a[k], 32);
#pragma unroll
    for (int k = 0; k < 16; ++k) a[k] = fmaxf(a[k], c[15 - k]);
#pragma unroll
    for (int st = 8; st >= 1; st >>= 1)
#pragma unroll
        for (int i = 0; i < 16; ++i) if ((i & st) == 0) { const float hi = fmaxf(a[i], a[i + st]), lo = fminf(a[i], a[i + st]); a[i] = hi; a[i + st] = lo; }
}
__device__ __forceinline__ void peer_route_mfma(Frame& F) {
    const unsigned short* PQ = (const unsigned short*)(F.ws + WS_PQ);
    const unsigned short* SUBK = (const unsigned short*)(F.ws + WS_SUBK);
    unsigned* ROUTE = (unsigned*)(F.ws + WS_ROUTE);
    constexpr int SKP = 272;
    LAS unsigned char* L = (LAS unsigned char*)F.lds;
    LAS unsigned* lst = (LAS unsigned*)(L + 2 * 128 * SKP) + F.wave * 1024;
    const int lane = F.lane, hh = lane >> 5, q32 = lane & 31, tid = F.tid;
    for (int tile = F.gw; tile < T / 32; tile += F.NGW) {
    const size_t t = (size_t)tile * 32 + q32;
    for (int h = 0; h < 8; ++h) {
        __syncthreads();
#pragma unroll
        for (int i = 0; i < 8; ++i) { const int pc = tid + 512 * i, row = pc >> 4, ch = pc & 15;
            *(LAS v4u*)(L + row * SKP + ch * 16) = *(const v4u*)(SUBK + ((size_t)(2 * h) * 128 + row) * 128 + ch * 8); }
        __syncthreads();
        float kk[2][16];
#pragma unroll
        for (int p = 0; p < 2; ++p) {
            const int g = 2 * h + p;
            bf16x8 bq[8];
#pragma unroll
            for (int ks = 0; ks < 8; ++ks) bq[ks] = *(const bf16x8*)(PQ + t * 2048 + g * 128 + 16 * ks + 8 * hh);
            float a[16];
#pragma unroll
            for (int k = 0; k < 16; ++k) a[k] = -INFINITY;
#pragma unroll
            for (int nt = 0; nt < 4; ++nt) {
                f32x16 acc = {};
                const LAS unsigned char* arow = L + (p * 128 + 32 * nt + q32) * SKP + 16 * hh;
#pragma unroll
                for (int ks = 0; ks < 8; ++ks) acc = __builtin_amdgcn_mfma_f32_32x32x16_bf16(*(const LAS bf16x8*)(arow + 32 * ks), bq[ks], acc, 0, 0, 0);
#pragma unroll
                for (int r = 0; r < 16; ++r) { const int nconst = 32 * nt + (r & 3) + 8 * (r >> 2);
                    const float sv = acc[r];
                    const unsigned key = (__float_as_uint(sv) & 0xFFFFFF80u) | (unsigned)(127 - nconst - 4 * hh);
                    sort_insert16(a, __builtin_bit_cast(float, key)); }
            }
            merge_halves16(a);
#pragma unroll
            for (int k = 0; k < 16; ++k) { kk[p][k] = a[k]; lst[(p * 16 + k) * 32 + q32] = __builtin_bit_cast(unsigned, a[k]); }
        }
        float c2[16];
#pragma unroll
        for (int k = 0; k < 16; ++k) c2[k] = -INFINITY;
#pragma unroll
        for (int i = 0; i < 16; ++i)
#pragma unroll
            for (int j = 0; j < 16; ++j) if ((i + 1) * (j + 1) <= 16) {
                const float sm = kk[0][i] + kk[1][j];
                const unsigned key = (__builtin_bit_cast(unsigned, sm) & 0xFFFFFF00u) | (unsigned)(255 - (i * 16 + j));
                sort_insert16(c2, __builtin_bit_cast(float, key)); }
        LDS_WAIT(); asm volatile("" ::: "memory");
        float ex[16]; float sum = 0.f;
#pragma unroll
        for (int k = 0; k < 16; ++k) { ex[k] = __expf(c2[k] - c2[0]); sum += ex[k]; }
        const float inv = 1.0f / sum;
        unsigned outw[16];
#pragma unroll
        for (int k = 0; k < 16; ++k) { const unsigned pidx = 255u - (__builtin_bit_cast(unsigned, c2[k]) & 255u);
            const unsigned n0 = 127u - (lst[(pidx >> 4) * 32 + q32] & 127u), n1 = 127u - (lst[(16 + (pidx & 15u)) * 32 + q32] & 127u);
            outw[k] = ((n0 * 128u + n1) << 16) | f2bf(ex[k] * inv); }
        v4u w0, w1;
        w0.x = hh ? outw[8] : outw[0]; w0.y = hh ? outw[9] : outw[1]; w0.z = hh ? outw[10] : outw[2]; w0.w = hh ? outw[11] : outw[3];
        w1.x = hh ? outw[12] : outw[4]; w1.y = hh ? outw[13] : outw[5]; w1.z = hh ? outw[14] : outw[6]; w1.w = hh ? outw[15] : outw[7];
        v4u* dst = (v4u*)(ROUTE + t * 128 + h * 16 + 8 * hh);
        dst[0] = w0; dst[1] = w1;
        LDS_WAIT(); asm volatile("" ::: "memory");
    }
    }
}

__device__ __forceinline__ float gelu_tanh(float x) { const float z = 0.7978845608028654f * (x + 0.044715f * x * x * x); const float th = 1.0f - 2.0f / (1.0f + __expf(2.0f * z)); return 0.5f * x * (1.0f + th); }
__device__ __forceinline__ void peer_gather(Frame& F) {
    const unsigned short* H2 = (const unsigned short*)(F.ws + WS_H2);
    const unsigned short* U = (const unsigned short*)(F.ws + WS_U);
    const unsigned short* V = (const unsigned short*)(F.ws + WS_V);
    const unsigned* ROUTE = (const unsigned*)(F.ws + WS_ROUTE);
    const float* MOD = (const float*)(F.ws + WS_MOD);
    const float* fg = F.in[20];
    float* pp = (float*)(F.lds + F.wave * (64 * 65 * 4));
    const int lane = F.lane;
    for (int t = F.gw; t < T; t += F.NGW) {
        const int b = t >> 12;
        const v4u ha = ((const v4u*)(H2 + (size_t)t * 1024))[lane], hb = ((const v4u*)(H2 + (size_t)t * 1024))[64 + lane];
        const unsigned r0 = ROUTE[(size_t)t * 128 + lane], r1 = ROUTE[(size_t)t * 128 + 64 + lane];
        float coef0, coef1;
#pragma unroll
        for (int half = 0; half < 2; ++half) {
            const unsigned rr = half ? r1 : r0;
            for (int k = 0; k < 64; k += 4) {
                v4u ua[4], ub[4];
#pragma unroll
                for (int q = 0; q < 4; ++q) { const unsigned id = __builtin_amdgcn_readlane(rr, k + q) >> 16; const v4u* row = (const v4u*)(U + (size_t)id * 1024); ua[q] = row[lane]; ub[q] = row[64 + lane]; }
#pragma unroll
                for (int q = 0; q < 4; ++q) { float d = 0.f;
                    d = dot2c(d, ua[q].x, ha.x); d = dot2c(d, ua[q].y, ha.y); d = dot2c(d, ua[q].z, ha.z); d = dot2c(d, ua[q].w, ha.w);
                    d = dot2c(d, ub[q].x, hb.x); d = dot2c(d, ub[q].y, hb.y); d = dot2c(d, ub[q].z, hb.z); d = dot2c(d, ub[q].w, hb.w);
                    pp[(k + q) * 65 + lane] = d; }
            }
            LDS_WAIT(); asm volatile("" ::: "memory");
            float tot = 0.f;
#pragma unroll 8
            for (int i = 0; i < 64; ++i) tot += pp[lane * 65 + i];
            LDS_WAIT(); asm volatile("" ::: "memory");
            const float cf = bflo(rr) * gelu_tanh(tot);
            if (half) coef1 = cf; else coef0 = cf;
        }
        float o[16];
#pragma unroll
        for (int i = 0; i < 16; ++i) o[i] = 0.f;
#pragma unroll
        for (int half = 0; half < 2; ++half) {
            const unsigned rr = half ? r1 : r0; const float cfv = half ? coef1 : coef0;
            for (int k = 0; k < 64; k += 4) {
                v4u va[4], vb[4]; float cs[4];
#pragma unroll
                for (int q = 0; q < 4; ++q) { const unsigned id = __builtin_amdgcn_readlane(rr, k + q) >> 16; cs[q] = __builtin_bit_cast(float, __builtin_amdgcn_readlane(__builtin_bit_cast(unsigned, cfv), k + q));
                    const v4u* row = (const v4u*)(V + (size_t)id * 1024); va[q] = row[lane]; vb[q] = row[64 + lane]; }
#pragma unroll
                for (int q = 0; q < 4; ++q) { const float c = cs[q];
                    o[0] += c * bflo(va[q].x); o[1] += c * bfhi(va[q].x); o[2] += c * bflo(va[q].y); o[3] += c * bfhi(va[q].y);
                    o[4] += c * bflo(va[q].z); o[5] += c * bfhi(va[q].z); o[6] += c * bflo(va[q].w); o[7] += c * bfhi(va[q].w);
                    o[8] += c * bflo(vb[q].x); o[9] += c * bfhi(vb[q].x); o[10] += c * bflo(vb[q].y); o[11] += c * bfhi(vb[q].y);
                    o[12] += c * bflo(vb[q].z); o[13] += c * bfhi(vb[q].z); o[14] += c * bflo(vb[q].w); o[15] += c * bfhi(vb[q].w); }
            }
        }
        float* xrow = F.out + (size_t)t * 1024;
        const float* gt2 = MOD + b * 6144 + 5120;
        float x2[16]; float ss = 0.f;
#pragma unroll
        for (int c4 = 0; c4 < 4; ++c4) { const int e0 = (c4 < 2 ? 8 * lane + 4 * c4 : 512 + 8 * lane + 4 * (c4 - 2));
            const f32x4 xv = *(const f32x4*)(xrow + e0), gv = *(const f32x4*)(gt2 + e0);
#pragma unroll
            for (int i = 0; i < 4; ++i) { const float v = xv[i] + gv[i] * o[4 * c4 + i]; x2[4 * c4 + i] = v; ss += v * v; } }
        const float rstd = rsqrtf(wave_sum(ss) * (1.0f / 1024.0f) + EPS);
#pragma unroll
        for (int c4 = 0; c4 < 4; ++c4) { const int e0 = (c4 < 2 ? 8 * lane + 4 * c4 : 512 + 8 * lane + 4 * (c4 - 2));
            const f32x4 gv = *(const f32x4*)(fg + e0); f32x4 ov;
#pragma unroll
            for (int i = 0; i < 4; ++i) ov[i] = x2[4 * c4 + i] * rstd * gv[i];
            *(f32x4*)(xrow + e0) = ov; }
    }
}


__device__ __forceinline__ void peer_gather_fp8(Frame& F) {
    const unsigned short* H2 = (const unsigned short*)(F.ws + WS_H2);
    const unsigned char* U = F.ws + WS_U; const unsigned char* V = F.ws + WS_V;
    const float* USC = (const float*)(F.ws + WS_USC); const float* VSC = (const float*)(F.ws + WS_VSC);
    const unsigned* ROUTE = (const unsigned*)(F.ws + WS_ROUTE);
    const float* MOD = (const float*)(F.ws + WS_MOD);
    const float* fg = F.in[20];
    LAS float* pp = (LAS float*)F.lds + F.wave * (64 * 65);
    const int lane = F.lane;
    for (int t = F.gw; t < T; t += F.NGW) {
        const int b = t >> 12;
        f32x2_t hf[8];
        { const v4u ha = ((const v4u*)(H2 + (size_t)t * 1024))[2 * lane], hb = ((const v4u*)(H2 + (size_t)t * 1024))[2 * lane + 1];
          hf[0] = (f32x2_t){bflo(ha.x), bfhi(ha.x)}; hf[1] = (f32x2_t){bflo(ha.y), bfhi(ha.y)}; hf[2] = (f32x2_t){bflo(ha.z), bfhi(ha.z)}; hf[3] = (f32x2_t){bflo(ha.w), bfhi(ha.w)};
          hf[4] = (f32x2_t){bflo(hb.x), bfhi(hb.x)}; hf[5] = (f32x2_t){bflo(hb.y), bfhi(hb.y)}; hf[6] = (f32x2_t){bflo(hb.z), bfhi(hb.z)}; hf[7] = (f32x2_t){bflo(hb.w), bfhi(hb.w)}; }
        const unsigned r0 = ROUTE[(size_t)t * 128 + lane], r1 = ROUTE[(size_t)t * 128 + 64 + lane];
        const float su0 = USC[r0 >> 16], su1 = USC[r1 >> 16], sv0 = VSC[r0 >> 16], sv1 = VSC[r1 >> 16];
        float coef0 = 0.f, coef1 = 0.f;
#define LOAD8(dst, tab, rr, k0) do { _Pragma("unroll") for (int q = 0; q < 8; ++q) { const unsigned id = (__builtin_amdgcn_readlane(rr, (k0) + q) >> 16) & DBG_IDMASK; dst[q] = ((const v4u*)((tab) + (size_t)id * 1024))[lane]; } } while (0)
#define UDOT8(src, k0) do { _Pragma("unroll") for (int q = 0; q < 8; ++q) { const unsigned w[4] = {src[q].x, src[q].y, src[q].z, src[q].w}; f32x2_t acc = {0.f, 0.f}; \
            _Pragma("unroll") for (int j = 0; j < 4; ++j) { acc = __builtin_elementwise_fma(__builtin_amdgcn_cvt_pk_f32_fp8(w[j], false), hf[2 * j], acc); acc = __builtin_elementwise_fma(__builtin_amdgcn_cvt_pk_f32_fp8(w[j], true), hf[2 * j + 1], acc); } \
            pp[((k0) + q) * 65 + lane] = acc.x + acc.y; } } while (0)
#pragma unroll
        for (int half = 0; half < 2; ++half) {
            const unsigned rr = half ? r1 : r0;
            v4u ra[8], rb[8];
            LOAD8(ra, U, rr, 0);
            for (int kb = 0; kb < 64; kb += 16) {
                LOAD8(rb, U, rr, kb + 8);
                UDOT8(ra, kb);
                if (kb + 16 < 64) LOAD8(ra, U, rr, kb + 16);
                UDOT8(rb, kb + 8);
            }
            LDS_WAIT(); asm volatile("" ::: "memory");
            float tot = 0.f;
#pragma unroll 8
            for (int i = 0; i < 64; ++i) tot += pp[lane * 65 + i];
            LDS_WAIT(); asm volatile("" ::: "memory");
            const float cf = bflo(rr) * gelu_tanh(tot * (half ? su1 : su0)) * (half ? sv1 : sv0);
            if (half) coef1 = cf; else coef0 = cf;
        }
        f32x2_t o[8];
#pragma unroll
        for (int i = 0; i < 8; ++i) o[i] = (f32x2_t){0.f, 0.f};
#define VACC8(src, cfv, k0) do { _Pragma("unroll") for (int q = 0; q < 8; ++q) { const unsigned w[4] = {src[q].x, src[q].y, src[q].z, src[q].w}; \
            const float c = __uint_as_float(__builtin_amdgcn_readlane(__float_as_uint(cfv), (k0) + q)); const f32x2_t cc = {c, c}; \
            _Pragma("unroll") for (int j = 0; j < 4; ++j) { o[2 * j] = __builtin_elementwise_fma(__builtin_amdgcn_cvt_pk_f32_fp8(w[j], false), cc, o[2 * j]); o[2 * j + 1] = __builtin_elementwise_fma(__builtin_amdgcn_cvt_pk_f32_fp8(w[j], true), cc, o[2 * j + 1]); } } } while (0)
#pragma unroll
        for (int half = 0; half < 2; ++half) {
            const unsigned rr = half ? r1 : r0; const float cfv = half ? coef1 : coef0;
            v4u ra[8], rb[8];
            LOAD8(ra, V, rr, 0);
            for (int kb = 0; kb < 64; kb += 16) {
                LOAD8(rb, V, rr, kb + 8);
                VACC8(ra, cfv, kb);
                if (kb + 16 < 64) LOAD8(ra, V, rr, kb + 16);
                VACC8(rb, cfv, kb + 8);
            }
        }
#undef LOAD8
#undef UDOT8
#undef VACC8
        float* xrow = F.out + (size_t)t * 1024 + 16 * lane;
        const float* gt2 = MOD + b * 6144 + 5120 + 16 * lane;
        f32x4 x2[4]; float ss = 0.f;
#pragma unroll
        for (int c4 = 0; c4 < 4; ++c4) { const f32x4 xv = ((const f32x4*)xrow)[c4], gv = ((const f32x4*)gt2)[c4];
            f32x4 ov; ov.x = o[2 * c4].x; ov.y = o[2 * c4].y; ov.z = o[2 * c4 + 1].x; ov.w = o[2 * c4 + 1].y;
            x2[c4] = xv + gv * ov; ss += (x2[c4].x * x2[c4].x + x2[c4].y * x2[c4].y) + (x2[c4].z * x2[c4].z + x2[c4].w * x2[c4].w); }
        const float rstd = rsqrtf(wave_sum(ss) * (1.0f / 1024.0f) + EPS);
#pragma unroll
        for (int c4 = 0; c4 < 4; ++c4) { const f32x4 gv = ((const f32x4*)(fg + 16 * lane))[c4]; ((f32x4*)xrow)[c4] = x2[c4] * rstd * gv; }
    }
}


typedef unsigned u32x8_t __attribute__((ext_vector_type(8)));
typedef float f32x8_t __attribute__((ext_vector_type(8)));
__device__ __forceinline__ f32x2_t dot16_fp8(const v4u row, const f32x2_t (&h)[8]) {
    const unsigned w[4] = {row.x, row.y, row.z, row.w}; f32x2_t acc = {0.f, 0.f};
#pragma unroll
    for (int j = 0; j < 4; ++j) { acc = __builtin_elementwise_fma(__builtin_amdgcn_cvt_pk_f32_fp8(w[j], false), h[2 * j], acc); acc = __builtin_elementwise_fma(__builtin_amdgcn_cvt_pk_f32_fp8(w[j], true), h[2 * j + 1], acc); }
    return acc;
}
__device__ __forceinline__ void axpy16_fp8(const v4u row, const float c, f32x2_t (&o)[8]) {
    const unsigned w[4] = {row.x, row.y, row.z, row.w}; const f32x2_t cc = {c, c};
#pragma unroll
    for (int j = 0; j < 4; ++j) { o[2 * j] = __builtin_elementwise_fma(__builtin_amdgcn_cvt_pk_f32_fp8(w[j], false), cc, o[2 * j]); o[2 * j + 1] = __builtin_elementwise_fma(__builtin_amdgcn_cvt_pk_f32_fp8(w[j], true), cc, o[2 * j + 1]); }
}
__device__ __forceinline__ void load_h16(const unsigned short* H2, size_t t, int lane, f32x2_t (&hf)[8]) {
    const v4u ha = ((const v4u*)(H2 + t * 1024))[2 * lane], hb = ((const v4u*)(H2 + t * 1024))[2 * lane + 1];
    hf[0] = (f32x2_t){bflo(ha.x), bfhi(ha.x)}; hf[1] = (f32x2_t){bflo(ha.y), bfhi(ha.y)}; hf[2] = (f32x2_t){bflo(ha.z), bfhi(ha.z)}; hf[3] = (f32x2_t){bflo(ha.w), bfhi(ha.w)};
    hf[4] = (f32x2_t){bflo(hb.x), bfhi(hb.x)}; hf[5] = (f32x2_t){bflo(hb.y), bfhi(hb.y)}; hf[6] = (f32x2_t){bflo(hb.z), bfhi(hb.z)}; hf[7] = (f32x2_t){bflo(hb.w), bfhi(hb.w)};
}
__device__ __forceinline__ void peer_gather_sweep(Frame& F) {
    const unsigned short* H2 = (const unsigned short*)(F.ws + WS_H2);
    const unsigned char* U = F.ws + WS_U; const unsigned char* V = F.ws + WS_V;
    const float* USC = (const float*)(F.ws + WS_USC); const float* VSC = (const float*)(F.ws + WS_VSC);
    const unsigned* ROUTE = (const unsigned*)(F.ws + WS_ROUTE);
    const float* MOD = (const float*)(F.ws + WS_MOD);
    const float* fg = F.in[20];
    LAS float* pp = (LAS float*)F.lds + F.wave * (64 * 65);
    const int lane = F.lane;
    for (int bt = F.gw; bt < T / 4; bt += F.NGW) {
        const size_t tb = (size_t)bt * 4; const int b = (int)(tb >> 12);
        unsigned keys[8];
#pragma unroll
        for (int tk = 0; tk < 4; ++tk) { const unsigned r0 = ROUTE[(tb + tk) * 128 + lane], r1 = ROUTE[(tb + tk) * 128 + 64 + lane];
            keys[2 * tk] = ((r0 >> 16) << 18) | ((unsigned)tk << 16) | (r0 & 0xffffu); keys[2 * tk + 1] = ((r1 >> 16) << 18) | ((unsigned)tk << 16) | (r1 & 0xffffu); }
#pragma unroll
        for (int k = 2; k <= SW_SORT_MAX; k <<= 1) {
#pragma unroll
            for (int j = k >> 1; j > 0; j >>= 1) {
                if (j >= 64) { const int jr = j >> 6;
#pragma unroll
                    for (int r = 0; r < 8; ++r) if ((r & jr) == 0) { const bool asc = ((r * 64) & k) == 0; const unsigned a = keys[r], c = keys[r | jr], lo = a < c ? a : c, hi = a < c ? c : a; keys[r] = asc ? lo : hi; keys[r | jr] = asc ? hi : lo; }
                } else {
#pragma unroll
                    for (int r = 0; r < 8; ++r) { const unsigned o = (unsigned)__shfl_xor((int)keys[r], j); const bool asc = (((r * 64 + lane) & k) == 0), lower = (lane & j) == 0;
                        const unsigned mn = keys[r] < o ? keys[r] : o, mx = keys[r] < o ? o : keys[r]; keys[r] = (asc == lower) ? mn : mx; }
                }
            }
        }
        u32x8_t kv; kv[0] = keys[0]; kv[1] = keys[1]; kv[2] = keys[2]; kv[3] = keys[3]; kv[4] = keys[4]; kv[5] = keys[5]; kv[6] = keys[6]; kv[7] = keys[7];
        f32x8_t cfv = {};
        {
            f32x2_t h0[8], h1[8], h2[8], h3[8];
            load_h16(H2, tb, lane, h0); load_h16(H2, tb + 1, lane, h1); load_h16(H2, tb + 2, lane, h2); load_h16(H2, tb + 3, lane, h3);
            for (int c = 0; c < 8; ++c) {
                const unsigned kc = kv[c];
                v4u ra[4], rb[4];
#define SW_LOAD4(dst, tab, k0) do { _Pragma("unroll") for (int q = 0; q < 4; ++q) { const unsigned id = (unsigned)__builtin_amdgcn_readlane(kc, (k0) + q) >> 18; dst[q] = ((const v4u*)((tab) + (size_t)id * 1024))[lane]; } } while (0)
#define SW_UDOT4(src, k0) do { _Pragma("unroll") for (int q = 0; q < 4; ++q) { const unsigned tk = ((unsigned)__builtin_amdgcn_readlane(kc, (k0) + q) >> 16) & 3u; f32x2_t acc; \
                    if (tk == 0) acc = dot16_fp8(src[q], h0); else if (tk == 1) acc = dot16_fp8(src[q], h1); else if (tk == 2) acc = dot16_fp8(src[q], h2); else acc = dot16_fp8(src[q], h3); \
                    pp[((k0) + q) * 65 + lane] = acc.x + acc.y; } } while (0)
                SW_LOAD4(ra, U, 0);
                for (int kb = 0; kb < 64; kb += 8) {
                    SW_LOAD4(rb, U, kb + 4);
                    SW_UDOT4(ra, kb);
                    if (kb + 8 < 64) SW_LOAD4(ra, U, kb + 8);
                    SW_UDOT4(rb, kb + 4);
                }
#undef SW_UDOT4
                LDS_WAIT(); asm volatile("" ::: "memory");
                float tot = 0.f;
#pragma unroll 8
                for (int i = 0; i < 64; ++i) tot += pp[lane * 65 + i];
                LDS_WAIT(); asm volatile("" ::: "memory");
                const unsigned myid = kc >> 18;
                cfv[c] = bflo(kc) * gelu_tanh(tot * USC[myid]) * VSC[myid];
            }
        }
        f32x2_t o0[8], o1[8], o2[8], o3[8];
#pragma unroll
        for (int i = 0; i < 8; ++i) { o0[i] = (f32x2_t){0.f, 0.f}; o1[i] = o0[i]; o2[i] = o0[i]; o3[i] = o0[i]; }
        for (int c = 0; c < 8; ++c) {
            const unsigned kc = kv[c]; const unsigned cfb = __float_as_uint(cfv[c]);
            v4u ra[4], rb[4];
#define SW_VACC4(src, k0) do { _Pragma("unroll") for (int q = 0; q < 4; ++q) { const unsigned tk = ((unsigned)__builtin_amdgcn_readlane(kc, (k0) + q) >> 16) & 3u; const float cf = __uint_as_float(__builtin_amdgcn_readlane(cfb, (k0) + q)); \
                if (tk == 0) axpy16_fp8(src[q], cf, o0); else if (tk == 1) axpy16_fp8(src[q], cf, o1); else if (tk == 2) axpy16_fp8(src[q], cf, o2); else axpy16_fp8(src[q], cf, o3); } } while (0)
            SW_LOAD4(ra, V, 0);
            for (int kb = 0; kb < 64; kb += 8) {
                SW_LOAD4(rb, V, kb + 4);
                SW_VACC4(ra, kb);
                if (kb + 8 < 64) SW_LOAD4(ra, V, kb + 8);
                SW_VACC4(rb, kb + 4);
            }
#undef SW_VACC4
#undef SW_LOAD4
        }
#define SW_FIN(tk, oo) do { float* xrow = F.out + (tb + (tk)) * 1024 + 16 * lane; const float* gt2 = MOD + b * 6144 + 5120 + 16 * lane; f32x4 x2[4]; float ss = 0.f; \
            _Pragma("unroll") for (int c4 = 0; c4 < 4; ++c4) { const f32x4 xv = ((const f32x4*)xrow)[c4], gv = ((const f32x4*)gt2)[c4]; f32x4 ov; ov.x = oo[2 * c4].x; ov.y = oo[2 * c4].y; ov.z = oo[2 * c4 + 1].x; ov.w = oo[2 * c4 + 1].y; \
                x2[c4] = xv + gv * ov; ss += (x2[c4].x * x2[c4].x + x2[c4].y * x2[c4].y) + (x2[c4].z * x2[c4].z + x2[c4].w * x2[c4].w); } \
            const float rstd = rsqrtf(wave_sum(ss) * (1.0f / 1024.0f) + EPS); \
            _Pragma("unroll") for (int c4 = 0; c4 < 4; ++c4) { const f32x4 gv = ((const f32x4*)(fg + 16 * lane))[c4]; ((f32x4*)xrow)[c4] = x2[c4] * rstd * gv; } } while (0)
        SW_FIN(0, o0); SW_FIN(1, o1); SW_FIN(2, o2); SW_FIN(3, o3);
#undef SW_FIN
    }
}


__device__ __forceinline__ f32x2_t dot16_fp4(unsigned wx, unsigned wy, const f32x2_t (&h)[8]) {
    f32x2_t acc = {0.f, 0.f};
    acc = __builtin_elementwise_fma(__builtin_amdgcn_cvt_scalef32_pk_f32_fp4(wx, 1.0f, 0), h[0], acc); acc = __builtin_elementwise_fma(__builtin_amdgcn_cvt_scalef32_pk_f32_fp4(wx, 1.0f, 1), h[1], acc);
    acc = __builtin_elementwise_fma(__builtin_amdgcn_cvt_scalef32_pk_f32_fp4(wx, 1.0f, 2), h[2], acc); acc = __builtin_elementwise_fma(__builtin_amdgcn_cvt_scalef32_pk_f32_fp4(wx, 1.0f, 3), h[3], acc);
    acc = __builtin_elementwise_fma(__builtin_amdgcn_cvt_scalef32_pk_f32_fp4(wy, 1.0f, 0), h[4], acc); acc = __builtin_elementwise_fma(__builtin_amdgcn_cvt_scalef32_pk_f32_fp4(wy, 1.0f, 1), h[5], acc);
    acc = __builtin_elementwise_fma(__builtin_amdgcn_cvt_scalef32_pk_f32_fp4(wy, 1.0f, 2), h[6], acc); acc = __builtin_elementwise_fma(__builtin_amdgcn_cvt_scalef32_pk_f32_fp4(wy, 1.0f, 3), h[7], acc);
    return acc;
}
__device__ __forceinline__ void axpy16_fp4(unsigned wx, unsigned wy, const float c, f32x2_t (&o)[8]) {
    const f32x2_t cc = {c, c};
    o[0] = __builtin_elementwise_fma(__builtin_amdgcn_cvt_scalef32_pk_f32_fp4(wx, 1.0f, 0), cc, o[0]); o[1] = __builtin_elementwise_fma(__builtin_amdgcn_cvt_scalef32_pk_f32_fp4(wx, 1.0f, 1), cc, o[1]);
    o[2] = __builtin_elementwise_fma(__builtin_amdgcn_cvt_scalef32_pk_f32_fp4(wx, 1.0f, 2), cc, o[2]); o[3] = __builtin_elementwise_fma(__builtin_amdgcn_cvt_scalef32_pk_f32_fp4(wx, 1.0f, 3), cc, o[3]);
    o[4] = __builtin_elementwise_fma(__builtin_amdgcn_cvt_scalef32_pk_f32_fp4(wy, 1.0f, 0), cc, o[4]); o[5] = __builtin_elementwise_fma(__builtin_amdgcn_cvt_scalef32_pk_f32_fp4(wy, 1.0f, 1), cc, o[5]);
    o[6] = __builtin_elementwise_fma(__builtin_amdgcn_cvt_scalef32_pk_f32_fp4(wy, 1.0f, 2), cc, o[6]); o[7] = __builtin_elementwise_fma(__builtin_amdgcn_cvt_scalef32_pk_f32_fp4(wy, 1.0f, 3), cc, o[7]);
}

__device__ __forceinline__ float dot16_fp4_bf16(unsigned wx, unsigned wy, const v4u ha, const v4u hb) {
    float acc = 0.f;
    acc = __builtin_amdgcn_fdot2_f32_bf16(__builtin_amdgcn_cvt_scalef32_pk_bf16_fp4(wx, 1.0f, 0), __builtin_bit_cast(bf16x2_t, ha.x), acc, false);
    acc = __builtin_amdgcn_fdot2_f32_bf16(__builtin_amdgcn_cvt_scalef32_pk_bf16_fp4(wx, 1.0f, 1), __builtin_bit_cast(bf16x2_t, ha.y), acc, false);
    acc = __builtin_amdgcn_fdot2_f32_bf16(__builtin_amdgcn_cvt_scalef32_pk_bf16_fp4(wx, 1.0f, 2), __builtin_bit_cast(bf16x2_t, ha.z), acc, false);
    acc = __builtin_amdgcn_fdot2_f32_bf16(__builtin_amdgcn_cvt_scalef32_pk_bf16_fp4(wx, 1.0f, 3), __builtin_bit_cast(bf16x2_t, ha.w), acc, false);
    acc = __builtin_amdgcn_fdot2_f32_bf16(__builtin_amdgcn_cvt_scalef32_pk_bf16_fp4(wy, 1.0f, 0), __builtin_bit_cast(bf16x2_t, hb.x), acc, false);
    acc = __builtin_amdgcn_fdot2_f32_bf16(__builtin_amdgcn_cvt_scalef32_pk_bf16_fp4(wy, 1.0f, 1), __builtin_bit_cast(bf16x2_t, hb.y), acc, false);
    acc = __builtin_amdgcn_fdot2_f32_bf16(__builtin_amdgcn_cvt_scalef32_pk_bf16_fp4(wy, 1.0f, 2), __builtin_bit_cast(bf16x2_t, hb.z), acc, false);
    acc = __builtin_amdgcn_fdot2_f32_bf16(__builtin_amdgcn_cvt_scalef32_pk_bf16_fp4(wy, 1.0f, 3), __builtin_bit_cast(bf16x2_t, hb.w), acc, false);
    return acc;
}
__device__ __forceinline__ void peer_gather_fp4(Frame& F) {
    constexpr int GB = PEER_GB;
    typedef unsigned u32x2_t __attribute__((ext_vector_type(2)));
    const unsigned short* H2 = (const unsigned short*)(F.ws + WS_H2);
    const unsigned char* U = F.ws + WS_U; const unsigned char* V = F.ws + WS_V;
    const float* USC = (const float*)(F.ws + WS_USC); const float* VSC = (const float*)(F.ws + WS_VSC);
    const unsigned* ROUTE = (const unsigned*)(F.ws + WS_ROUTE);
    const float* MOD = (const float*)(F.ws + WS_MOD);
    const float* fg = F.in[20];
    LAS float* pp = (LAS float*)F.lds + F.wave * (64 * 65);
    const int lane = F.lane;
#define LOAD8(dst, tab, rr, k0) do { _Pragma("unroll") for (int q = 0; q < GB; ++q) { const unsigned id = (unsigned)__builtin_amdgcn_readlane(rr, (k0) + q) >> 16; dst[q] = ((const u32x2_t*)((tab) + (size_t)id * 512))[lane]; } } while (0)
    for (int tile = F.gw; tile < T / 32; tile += F.NGW) {
    unsigned r0n = ROUTE[(size_t)tile * 32 * 128 + lane], r1n = ROUTE[(size_t)tile * 32 * 128 + 64 + lane];
    for (int t = tile * 32; t < tile * 32 + 32; ++t) {
        const int b = t >> 12;
        const unsigned r0 = r0n, r1 = r1n;
        if (t + 1 < tile * 32 + 32) { r0n = ROUTE[(size_t)(t + 1) * 128 + lane]; r1n = ROUTE[(size_t)(t + 1) * 128 + 64 + lane]; }
        const float su0 = USC[r0 >> 16], su1 = USC[r1 >> 16], sv0 = VSC[r0 >> 16], sv1 = VSC[r1 >> 16];
        float coef0 = 0.f, coef1 = 0.f;
        {
            typedef int v8i_t __attribute__((ext_vector_type(8)));
            f32x2_t hf[8];
            load_h16(H2, (size_t)t, lane, hf);
            float mx = 0.f;
#pragma unroll
            for (int i2 = 0; i2 < 8; ++i2) mx = fmaxf(mx, fmaxf(fabsf(hf[i2].x), fabsf(hf[i2].y)));
            const float sc1 = 6.0f / fmaxf(lane63(scan_max64(mx)), 1e-30f);
            unsigned q1x = 0u, q1y = 0u;
            q1x = __builtin_amdgcn_cvt_scalef32_pk_fp4_f32(q1x, hf[0].x * sc1, hf[0].y * sc1, 1.0f, 0); q1x = __builtin_amdgcn_cvt_scalef32_pk_fp4_f32(q1x, hf[1].x * sc1, hf[1].y * sc1, 1.0f, 1);
            q1x = __builtin_amdgcn_cvt_scalef32_pk_fp4_f32(q1x, hf[2].x * sc1, hf[2].y * sc1, 1.0f, 2); q1x = __builtin_amdgcn_cvt_scalef32_pk_fp4_f32(q1x, hf[3].x * sc1, hf[3].y * sc1, 1.0f, 3);
            q1y = __builtin_amdgcn_cvt_scalef32_pk_fp4_f32(q1y, hf[4].x * sc1, hf[4].y * sc1, 1.0f, 0); q1y = __builtin_amdgcn_cvt_scalef32_pk_fp4_f32(q1y, hf[5].x * sc1, hf[5].y * sc1, 1.0f, 1);
            q1y = __builtin_amdgcn_cvt_scalef32_pk_fp4_f32(q1y, hf[6].x * sc1, hf[6].y * sc1, 1.0f, 2); q1y = __builtin_amdgcn_cvt_scalef32_pk_fp4_f32(q1y, hf[7].x * sc1, hf[7].y * sc1, 1.0f, 3);
            f32x2_t rs[8];
            rs[0] = hf[0] * sc1 - __builtin_amdgcn_cvt_scalef32_pk_f32_fp4(q1x, 1.0f, 0); rs[1] = hf[1] * sc1 - __builtin_amdgcn_cvt_scalef32_pk_f32_fp4(q1x, 1.0f, 1);
            rs[2] = hf[2] * sc1 - __builtin_amdgcn_cvt_scalef32_pk_f32_fp4(q1x, 1.0f, 2); rs[3] = hf[3] * sc1 - __builtin_amdgcn_cvt_scalef32_pk_f32_fp4(q1x, 1.0f, 3);
            rs[4] = hf[4] * sc1 - __builtin_amdgcn_cvt_scalef32_pk_f32_fp4(q1y, 1.0f, 0); rs[5] = hf[5] * sc1 - __builtin_amdgcn_cvt_scalef32_pk_f32_fp4(q1y, 1.0f, 1);
            rs[6] = hf[6] * sc1 - __builtin_amdgcn_cvt_scalef32_pk_f32_fp4(q1y, 1.0f, 2); rs[7] = hf[7] * sc1 - __builtin_amdgcn_cvt_scalef32_pk_f32_fp4(q1y, 1.0f, 3);
            float mr = 0.f;
#pragma unroll
            for (int i2 = 0; i2 < 8; ++i2) mr = fmaxf(mr, fmaxf(fabsf(rs[i2].x), fabsf(rs[i2].y)));
            const float sc2 = 6.0f / fmaxf(lane63(scan_max64(mr)), 1e-30f);
            unsigned q2x = 0u, q2y = 0u;
            q2x = __builtin_amdgcn_cvt_scalef32_pk_fp4_f32(q2x, rs[0].x * sc2, rs[0].y * sc2, 1.0f, 0); q2x = __builtin_amdgcn_cvt_scalef32_pk_fp4_f32(q2x, rs[1].x * sc2, rs[1].y * sc2, 1.0f, 1);
            q2x = __builtin_amdgcn_cvt_scalef32_pk_fp4_f32(q2x, rs[2].x * sc2, rs[2].y * sc2, 1.0f, 2); q2x = __builtin_amdgcn_cvt_scalef32_pk_fp4_f32(q2x, rs[3].x * sc2, rs[3].y * sc2, 1.0f, 3);
            q2y = __builtin_amdgcn_cvt_scalef32_pk_fp4_f32(q2y, rs[4].x * sc2, rs[4].y * sc2, 1.0f, 0); q2y = __builtin_amdgcn_cvt_scalef32_pk_fp4_f32(q2y, rs[5].x * sc2, rs[5].y * sc2, 1.0f, 1);
            q2y = __builtin_amdgcn_cvt_scalef32_pk_fp4_f32(q2y, rs[6].x * sc2, rs[6].y * sc2, 1.0f, 2); q2y = __builtin_amdgcn_cvt_scalef32_pk_fp4_f32(q2y, rs[7].x * sc2, rs[7].y * sc2, 1.0f, 3);
            LAS unsigned char* wl = (LAS unsigned char*)pp;
            *(LAS u32x2_t*)(wl + 8 * lane) = (u32x2_t){q1x, q1y}; *(LAS u32x2_t*)(wl + 512 + 8 * lane) = (u32x2_t){q2x, q2y};
            LDS_WAIT(); asm volatile("" ::: "memory");
            const int g = lane >> 4;
            v8i_t B1[8], B2[8];
#pragma unroll
            for (int s2 = 0; s2 < 8; ++s2) { const v4u b1 = *(const LAS v4u*)(wl + 64 * s2 + 16 * g), b2 = *(const LAS v4u*)(wl + 512 + 64 * s2 + 16 * g);
                B1[s2] = (v8i_t){(int)b1.x, (int)b1.y, (int)b1.z, (int)b1.w, 0, 0, 0, 0}; B2[s2] = (v8i_t){(int)b2.x, (int)b2.y, (int)b2.z, (int)b2.w, 0, 0, 0, 0}; }
            const float inv1 = 1.0f / sc1, inv12 = inv1 / sc2;
            LAS float* ttl = (LAS float*)(wl + 1024);
            v4u A0[8], A1[8];
#define LOADG(dst, eg) do { const unsigned idv = (unsigned)__shfl((int)((eg) < 4 ? r0 : r1), 16 * ((eg) & 3) + (lane & 15)) >> 16; const unsigned char* p_ = U + (size_t)idv * 512 + 16 * g; \
                _Pragma("unroll") for (int s2 = 0; s2 < 8; ++s2) dst[s2] = *(const v4u*)(p_ + 64 * s2); } while (0)
#define SCOREG(src, eg) do { f32x4 c1 = {0.f, 0.f, 0.f, 0.f}, c2 = {0.f, 0.f, 0.f, 0.f}; \
                _Pragma("unroll") for (int s2 = 0; s2 < 8; ++s2) { const v8i_t a8 = (v8i_t){(int)src[s2].x, (int)src[s2].y, (int)src[s2].z, (int)src[s2].w, 0, 0, 0, 0}; \
                    c1 = __builtin_amdgcn_mfma_scale_f32_16x16x128_f8f6f4(a8, B1[s2], c1, 4, 4, 0, 0, 0, 0); c2 = __builtin_amdgcn_mfma_scale_f32_16x16x128_f8f6f4(a8, B2[s2], c2, 4, 4, 0, 0, 0, 0); } \
                if ((lane & 15) == 0) { *(LAS f32x4*)(ttl + 16 * (eg) + 4 * g) = c1 * inv1 + c2 * inv12; } } while (0)
            LOADG(A0, 0);
#pragma unroll
            for (int eg = 0; eg < 8; eg += 2) {
                LOADG(A1, eg + 1);
                SCOREG(A0, eg);
                if (eg + 2 < 8) LOADG(A0, eg + 2);
                SCOREG(A1, eg + 1);
            }
#undef LOADG
#undef SCOREG
            LDS_WAIT(); asm volatile("" ::: "memory");
            const float tot0 = ttl[lane], tot1 = ttl[64 + lane];
            LDS_WAIT(); asm volatile("" ::: "memory");
            coef0 = bflo(r0) * gelu_tanh(tot0 * su0) * sv0;
            coef1 = bflo(r1) * gelu_tanh(tot1 * su1) * sv1;
        }
        f32x2_t o[8];
#pragma unroll
        for (int i = 0; i < 8; ++i) o[i] = (f32x2_t){0.f, 0.f};
#define VACC8(src, cfv, k0) do { _Pragma("unroll") for (int q = 0; q < GB; ++q) { \
            const float c = __uint_as_float(__builtin_amdgcn_readlane(__float_as_uint(cfv), (k0) + q)); axpy16_fp4(src[q].x, src[q].y, c, o); } } while (0)
#pragma unroll
        for (int half = 0; half < 2; ++half) {
            const unsigned rr = half ? r1 : r0; const float cfv = half ? coef1 : coef0;
            u32x2_t ra[GB], rb[GB];
            LOAD8(ra, V, rr, 0);
            for (int kb = 0; kb < 64; kb += 2 * GB) {
                LOAD8(rb, V, rr, kb + GB);
                VACC8(ra, cfv, kb);
                if (kb + 2 * GB < 64) LOAD8(ra, V, rr, kb + 2 * GB);
                VACC8(rb, cfv, kb + GB);
            }
        }
#undef VACC8
        float* xrow = F.out + (size_t)t * 1024 + 16 * lane;
        const float* gt2 = MOD + b * 6144 + 5120 + 16 * lane;
        const v4u xa = ((const v4u*)((const unsigned short*)(F.ws + WS_X1) + (size_t)t * 1024))[2 * lane], xb = ((const v4u*)((const unsigned short*)(F.ws + WS_X1) + (size_t)t * 1024))[2 * lane + 1];
        const f32x4 xin4[4] = {(f32x4){bflo(xa.x), bfhi(xa.x), bflo(xa.y), bfhi(xa.y)}, (f32x4){bflo(xa.z), bfhi(xa.z), bflo(xa.w), bfhi(xa.w)}, (f32x4){bflo(xb.x), bfhi(xb.x), bflo(xb.y), bfhi(xb.y)}, (f32x4){bflo(xb.z), bfhi(xb.z), bflo(xb.w), bfhi(xb.w)}};
        f32x4 x2[4]; float ss = 0.f;
#pragma unroll
        for (int c4 = 0; c4 < 4; ++c4) { const f32x4 xv = xin4[c4], gv = ((const f32x4*)gt2)[c4];
            f32x4 ov; ov.x = o[2 * c4].x; ov.y = o[2 * c4].y; ov.z = o[2 * c4 + 1].x; ov.w = o[2 * c4 + 1].y;
            x2[c4] = xv + gv * ov; ss += (x2[c4].x * x2[c4].x + x2[c4].y * x2[c4].y) + (x2[c4].z * x2[c4].z + x2[c4].w * x2[c4].w); }
        const float rstd = rsqrtf(wave_sum_u(ss) * (1.0f / 1024.0f) + EPS);
#pragma unroll
        for (int c4 = 0; c4 < 4; ++c4) { const f32x4 gv = ((const f32x4*)(fg + 16 * lane))[c4]; ((f32x4*)xrow)[c4] = x2[c4] * rstd * gv; }
    }
    }
#undef LOAD8
}


__device__ __forceinline__ void peer_gather_pipe(Frame& F) {
    typedef unsigned u32x2_t __attribute__((ext_vector_type(2)));
    typedef int v8i_t __attribute__((ext_vector_type(8)));
    const unsigned short* H2 = (const unsigned short*)(F.ws + WS_H2);
    const unsigned char* U = F.ws + WS_U; const unsigned char* V = F.ws + WS_V;
    const float* USC = (const float*)(F.ws + WS_USC); const float* VSC = (const float*)(F.ws + WS_VSC);
    const unsigned* ROUTE = (const unsigned*)(F.ws + WS_ROUTE);
    const float* MOD = (const float*)(F.ws + WS_MOD);
    const float* fg = F.in[20];
    LAS unsigned char* wl = (LAS unsigned char*)F.lds + F.wave * 2048;
    LAS float* ttl = (LAS float*)(wl + 1024);
    const int lane = F.lane, g = lane >> 4;
    v8i_t B1[8], B2[8]; float inv1 = 0.f, inv12 = 0.f;
    auto prep = [&](const v4u ha, const v4u hb) {
        f32x2_t hf[8];
        hf[0] = (f32x2_t){bflo(ha.x), bfhi(ha.x)}; hf[1] = (f32x2_t){bflo(ha.y), bfhi(ha.y)}; hf[2] = (f32x2_t){bflo(ha.z), bfhi(ha.z)}; hf[3] = (f32x2_t){bflo(ha.w), bfhi(ha.w)};
        hf[4] = (f32x2_t){bflo(hb.x), bfhi(hb.x)}; hf[5] = (f32x2_t){bflo(hb.y), bfhi(hb.y)}; hf[6] = (f32x2_t){bflo(hb.z), bfhi(hb.z)}; hf[7] = (f32x2_t){bflo(hb.w), bfhi(hb.w)};
        float mx = 0.f;
#pragma unroll
        for (int i2 = 0; i2 < 8; ++i2) mx = fmaxf(mx, fmaxf(fabsf(hf[i2].x), fabsf(hf[i2].y)));
        const float sc1 = 6.0f / fmaxf(lane63(scan_max64(mx)), 1e-30f);
        unsigned q1x = 0u, q1y = 0u;
        q1x = __builtin_amdgcn_cvt_scalef32_pk_fp4_f32(q1x, hf[0].x * sc1, hf[0].y * sc1, 1.0f, 0); q1x = __builtin_amdgcn_cvt_scalef32_pk_fp4_f32(q1x, hf[1].x * sc1, hf[1].y * sc1, 1.0f, 1);
        q1x = __builtin_amdgcn_cvt_scalef32_pk_fp4_f32(q1x, hf[2].x * sc1, hf[2].y * sc1, 1.0f, 2); q1x = __builtin_amdgcn_cvt_scalef32_pk_fp4_f32(q1x, hf[3].x * sc1, hf[3].y * sc1, 1.0f, 3);
        q1y = __builtin_amdgcn_cvt_scalef32_pk_fp4_f32(q1y, hf[4].x * sc1, hf[4].y * sc1, 1.0f, 0); q1y = __builtin_amdgcn_cvt_scalef32_pk_fp4_f32(q1y, hf[5].x * sc1, hf[5].y * sc1, 1.0f, 1);
        q1y = __builtin_amdgcn_cvt_scalef32_pk_fp4_f32(q1y, hf[6].x * sc1, hf[6].y * sc1, 1.0f, 2); q1y = __builtin_amdgcn_cvt_scalef32_pk_fp4_f32(q1y, hf[7].x * sc1, hf[7].y * sc1, 1.0f, 3);
        f32x2_t rs[8];
        rs[0] = hf[0] * sc1 - __builtin_amdgcn_cvt_scalef32_pk_f32_fp4(q1x, 1.0f, 0); rs[1] = hf[1] * sc1 - __builtin_amdgcn_cvt_scalef32_pk_f32_fp4(q1x, 1.0f, 1);
        rs[2] = hf[2] * sc1 - __builtin_amdgcn_cvt_scalef32_pk_f32_fp4(q1x, 1.0f, 2); rs[3] = hf[3] * sc1 - __builtin_amdgcn_cvt_scalef32_pk_f32_fp4(q1x, 1.0f, 3);
        rs[4] = hf[4] * sc1 - __builtin_amdgcn_cvt_scalef32_pk_f32_fp4(q1y, 1.0f, 0); rs[5] = hf[5] * sc1 - __builtin_amdgcn_cvt_scalef32_pk_f32_fp4(q1y, 1.0f, 1);
        rs[6] = hf[6] * sc1 - __builtin_amdgcn_cvt_scalef32_pk_f32_fp4(q1y, 1.0f, 2); rs[7] = hf[7] * sc1 - __builtin_amdgcn_cvt_scalef32_pk_f32_fp4(q1y, 1.0f, 3);
        float mr = 0.f;
#pragma unroll
        for (int i2 = 0; i2 < 8; ++i2) mr = fmaxf(mr, fmaxf(fabsf(rs[i2].x), fabsf(rs[i2].y)));
        const float sc2 = 6.0f / fmaxf(lane63(scan_max64(mr)), 1e-30f);
        unsigned q2x = 0u, q2y = 0u;
        q2x = __builtin_amdgcn_cvt_scalef32_pk_fp4_f32(q2x, rs[0].x * sc2, rs[0].y * sc2, 1.0f, 0); q2x = __builtin_amdgcn_cvt_scalef32_pk_fp4_f32(q2x, rs[1].x * sc2, rs[1].y * sc2, 1.0f, 1);
        q2x = __builtin_amdgcn_cvt_scalef32_pk_fp4_f32(q2x, rs[2].x * sc2, rs[2].y * sc2, 1.0f, 2); q2x = __builtin_amdgcn_cvt_scalef32_pk_fp4_f32(q2x, rs[3].x * sc2, rs[3].y * sc2, 1.0f, 3);
        q2y = __builtin_amdgcn_cvt_scalef32_pk_fp4_f32(q2y, rs[4].x * sc2, rs[4].y * sc2, 1.0f, 0); q2y = __builtin_amdgcn_cvt_scalef32_pk_fp4_f32(q2y, rs[5].x * sc2, rs[5].y * sc2, 1.0f, 1);
        q2y = __builtin_amdgcn_cvt_scalef32_pk_fp4_f32(q2y, rs[6].x * sc2, rs[6].y * sc2, 1.0f, 2); q2y = __builtin_amdgcn_cvt_scalef32_pk_fp4_f32(q2y, rs[7].x * sc2, rs[7].y * sc2, 1.0f, 3);
        *(LAS u32x2_t*)(wl + 8 * lane) = (u32x2_t){q1x, q1y}; *(LAS u32x2_t*)(wl + 512 + 8 * lane) = (u32x2_t){q2x, q2y};
        LDS_WAIT(); asm volatile("" ::: "memory");
#pragma unroll
        for (int s2 = 0; s2 < 8; ++s2) { const v4u b1 = *(const LAS v4u*)(wl + 64 * s2 + 16 * g), b2 = *(const LAS v4u*)(wl + 512 + 64 * s2 + 16 * g);
            B1[s2] = (v8i_t){(int)b1.x, (int)b1.y, (int)b1.z, (int)b1.w, 0, 0, 0, 0}; B2[s2] = (v8i_t){(int)b2.x, (int)b2.y, (int)b2.z, (int)b2.w, 0, 0, 0, 0}; }
        LDS_WAIT(); asm volatile("" ::: "memory");
        inv1 = 1.0f / sc1; inv12 = inv1 / sc2;
    };
#define PLOADG(dst, ra_, rb_, eg) do { const unsigned idv = (unsigned)__shfl((int)((eg) < 4 ? ra_ : rb_), 16 * ((eg) & 3) + (lane & 15)) >> 16; const unsigned char* p_ = U + (size_t)idv * 512 + 16 * g; \
        _Pragma("unroll") for (int s2 = 0; s2 < 8; ++s2) dst[s2] = *(const v4u*)(p_ + 64 * s2); } while (0)
#define PSCOREG(src, eg) do { f32x4 c1 = {0.f, 0.f, 0.f, 0.f}, c2 = {0.f, 0.f, 0.f, 0.f}; \
        _Pragma("unroll") for (int s2 = 0; s2 < 8; ++s2) { const v8i_t a8 = (v8i_t){(int)src[s2].x, (int)src[s2].y, (int)src[s2].z, (int)src[s2].w, 0, 0, 0, 0}; \
            c1 = __builtin_amdgcn_mfma_scale_f32_16x16x128_f8f6f4(a8, B1[s2], c1, 4, 4, 0, 0, 0, 0); c2 = __builtin_amdgcn_mfma_scale_f32_16x16x128_f8f6f4(a8, B2[s2], c2, 4, 4, 0, 0, 0, 0); } \
        if ((lane & 15) == 0) { *(LAS f32x4*)(ttl + 16 * (eg) + 4 * g) = c1 * inv1 + c2 * inv12; } } while (0)
#define PLOADV(dst, rr, k0) do { _Pragma("unroll") for (int q = 0; q < 8; ++q) { const unsigned id = (unsigned)__builtin_amdgcn_readlane(rr, (k0) + q) >> 16; dst[q] = ((const u32x2_t*)(V + (size_t)id * 512))[lane]; } } while (0)
#define PVACC(src, cfv, k0) do { _Pragma("unroll") for (int q = 0; q < 8; ++q) { const float c = __uint_as_float(__builtin_amdgcn_readlane(__float_as_uint(cfv), (k0) + q)); axpy16_fp4(src[q].x, src[q].y, c, o); } } while (0)
    for (int tile = F.gw; tile < T / 32; tile += F.NGW) {
        const int t0 = tile * 32, t1 = t0 + 32;
        unsigned r0c = ROUTE[(size_t)t0 * 128 + lane], r1c = ROUTE[(size_t)t0 * 128 + 64 + lane];
        unsigned r0n = ROUTE[(size_t)(t0 + 1) * 128 + lane], r1n = ROUTE[(size_t)(t0 + 1) * 128 + 64 + lane];
        v4u han = ((const v4u*)(H2 + (size_t)(t0 + 1) * 1024))[2 * lane], hbn = ((const v4u*)(H2 + (size_t)(t0 + 1) * 1024))[2 * lane + 1];
        float coef0c, coef1c;
        {
            const v4u ha = ((const v4u*)(H2 + (size_t)t0 * 1024))[2 * lane], hb = ((const v4u*)(H2 + (size_t)t0 * 1024))[2 * lane + 1];
            const float su0 = USC[r0c >> 16], su1 = USC[r1c >> 16], sv0 = VSC[r0c >> 16], sv1 = VSC[r1c >> 16];
            prep(ha, hb);
            v4u A0[8], A1[8];
            PLOADG(A0, r0c, r1c, 0);
#pragma unroll
            for (int eg = 0; eg < 8; eg += 2) { PLOADG(A1, r0c, r1c, eg + 1); PSCOREG(A0, eg); if (eg + 2 < 8) PLOADG(A0, r0c, r1c, eg + 2); PSCOREG(A1, eg + 1); }
            LDS_WAIT(); asm volatile("" ::: "memory");
            const float tot0 = ttl[lane], tot1 = ttl[64 + lane];
            LDS_WAIT(); asm volatile("" ::: "memory");
            coef0c = bflo(r0c) * gelu_tanh(tot0 * su0) * sv0; coef1c = bflo(r1c) * gelu_tanh(tot1 * su1) * sv1;
        }
        for (int t = t0; t < t1; ++t) {
            const int b = t >> 12;
            const int t2 = (t + 2 < t1) ? t + 2 : t1 - 1;
            const unsigned r0nn = ROUTE[(size_t)t2 * 128 + lane], r1nn = ROUTE[(size_t)t2 * 128 + 64 + lane];
            const v4u hann = ((const v4u*)(H2 + (size_t)t2 * 1024))[2 * lane], hbnn = ((const v4u*)(H2 + (size_t)t2 * 1024))[2 * lane + 1];
            const float su0 = USC[r0n >> 16], su1 = USC[r1n >> 16], sv0 = VSC[r0n >> 16], sv1 = VSC[r1n >> 16];
            const bool has_next = (t + 1 < t1);
            v4u A0[8];
            if (has_next) { prep(han, hbn);
                PLOADG(A0, r0n, r1n, 0); }
            f32x2_t o[8];
#pragma unroll
            for (int i2 = 0; i2 < 8; ++i2) o[i2] = (f32x2_t){0.f, 0.f};
            u32x2_t va[8], vb[8];
            PLOADV(va, r0c, 0);
#pragma unroll 1
            for (int kk = 0; kk < 4; ++kk) {
                const unsigned rr = (kk < 2) ? r0c : r1c, rr2 = (kk + 1 < 2) ? r0c : r1c; const float cfv = (kk < 2) ? coef0c : coef1c; const int kb = 32 * (kk & 1);
                PLOADV(vb, rr, kb + 8);
                PVACC(va, cfv, kb);
                PLOADV(va, rr, kb + 16);
                if (has_next) { PSCOREG(A0, 2 * kk);
                    PLOADG(A0, r0n, r1n, 2 * kk + 1); }
                PVACC(vb, cfv, kb + 8);
                PLOADV(vb, rr, kb + 24);
                PVACC(va, cfv, kb + 16);
                if (kk < 3) PLOADV(va, rr2, (kb + 32) & 63);
                if (has_next) { PSCOREG(A0, 2 * kk + 1);
                    if (kk < 3) PLOADG(A0, r0n, r1n, 2 * kk + 2); }
                PVACC(vb, cfv, kb + 24);
            }
            float coef0n, coef1n;
            {
                LDS_WAIT(); asm volatile("" ::: "memory");
                const float tot0 = ttl[lane], tot1 = ttl[64 + lane];
                LDS_WAIT(); asm volatile("" ::: "memory");
                coef0n = bflo(r0n) * gelu_tanh(tot0 * su0) * sv0; coef1n = bflo(r1n) * gelu_tanh(tot1 * su1) * sv1;
            }
            float* xrow = F.out + (size_t)t * 1024 + 16 * lane;
            const float* gt2 = MOD + b * 6144 + 5120 + 16 * lane;
            const v4u xa = ((const v4u*)((const unsigned short*)(F.ws + WS_X1) + (size_t)t * 1024))[2 * lane], xb = ((const v4u*)((const unsigned short*)(F.ws + WS_X1) + (size_t)t * 1024))[2 * lane + 1];
            const f32x4 xin4[4] = {(f32x4){bflo(xa.x), bfhi(xa.x), bflo(xa.y), bfhi(xa.y)}, (f32x4){bflo(xa.z), bfhi(xa.z), bflo(xa.w), bfhi(xa.w)}, (f32x4){bflo(xb.x), bfhi(xb.x), bflo(xb.y), bfhi(xb.y)}, (f32x4){bflo(xb.z), bfhi(xb.z), bflo(xb.w), bfhi(xb.w)}};
            f32x4 x2[4]; float ss = 0.f;
#pragma unroll
            for (int c4 = 0; c4 < 4; ++c4) { const f32x4 xv = xin4[c4], gv = ((const f32x4*)gt2)[c4];
                f32x4 ov; ov.x = o[2 * c4].x; ov.y = o[2 * c4].y; ov.z = o[2 * c4 + 1].x; ov.w = o[2 * c4 + 1].y;
                x2[c4] = xv + gv * ov; ss += (x2[c4].x * x2[c4].x + x2[c4].y * x2[c4].y) + (x2[c4].z * x2[c4].z + x2[c4].w * x2[c4].w); }
            const float rstd = rsqrtf(wave_sum_u(ss) * (1.0f / 1024.0f) + EPS);
#pragma unroll
            for (int c4 = 0; c4 < 4; ++c4) { const f32x4 gv = ((const f32x4*)(fg + 16 * lane))[c4]; ((f32x4*)xrow)[c4] = x2[c4] * rstd * gv; }
            r0c = r0n; r1c = r1n; r0n = r0nn; r1n = r1nn; han = hann; hbn = hbnn; coef0c = coef0n; coef1c = coef1n;
        }
    }
#undef PLOADG
#undef PSCOREG
#undef PLOADV
#undef PVACC
}

constexpr int N_PHASES = 12;
#ifndef PEER_FP8
#define PEER_FP8 1
#endif
#ifndef USE_ROUTE_REF
#define USE_ROUTE_REF 0
#endif
#ifndef USE_MLSTM_REF
#define USE_MLSTM_REF 0
#endif
#ifndef USE_ATTN_REF
#define USE_ATTN_REF 0
#endif
#ifndef MK_ONE_LAUNCH
#define MK_ONE_LAUNCH 0
#endif
__global__ void __launch_bounds__(NWAVES * 64, 2) fwd_kernel(Args args) {
    extern __shared__ __attribute__((aligned(16))) unsigned char lds[];
    Frame F;
    F.lds = lds; F.tid = threadIdx.x; F.lane = F.tid & 63; F.wave = __builtin_amdgcn_readfirstlane(F.tid >> 6);
    F.G = gridDim.x; F.gw = blockIdx.x * NWAVES + F.wave; F.NGW = F.G * NWAVES;
#pragma unroll
    for (int i = 0; i < 21; ++i) F.in[i] = args.in[i];
    F.out = args.out; F.ws = args.ws;
    LAS unsigned char* ldsl = (LAS unsigned char*)lds;
    volatile LAS unsigned* MISC = (volatile LAS unsigned*)(ldsl + MISC_OFF);
    for (int u = F.tid; u < (LDS_BYTES - MISC_OFF) / 4; u += NWAVES * 64) ((LAS unsigned*)(ldsl + MISC_OFF))[u] = 0u;
    __syncthreads();
    unsigned* ctl = (unsigned*)(F.ws + WS_CTL);
    XcdBarrier bar; bar.bar = ctl + CW_BAR; bar.x = 0; bar.st = nullptr;
    const bool one = (args.ph_hi - args.ph_lo) > 1;
    if (one) bar = xcd_barrier_post(ctl + CW_BAR, MISC + 8);
    const int lo = args.ph_lo, hi = args.ph_hi;
#define IN(k) (lo <= (k) && (k) < hi)
#ifdef DBG_TIME
    unsigned long long dbg_t0 = __builtin_amdgcn_s_memrealtime(), dbg_t1 = 0;
#define SEAM(k) do { if (IN(k) && IN((k) + 1)) xcd_barrier(bar); if ((k) + 1 == DBG_TIME) dbg_t0 = __builtin_amdgcn_s_memrealtime(); if ((k) == DBG_TIME) dbg_t1 = __builtin_amdgcn_s_memrealtime(); } while (0)
#else
#define SEAM(k) do { if (IN(k) && IN((k) + 1)) xcd_barrier(bar); } while (0)
#endif
    if (IN(0)) { p0_prologue(F); } SEAM(0);
    if (IN(1)) { norm_mod_rows<true>(F, F.in[0], F.in[4], 0, 1024, (unsigned short*)(F.ws + WS_H1)); } SEAM(1);
#if PROJ_ALL_FP8
    if (IN(2)) { pg8::Gemm g{(const pg8::bf16_t*)(F.ws + WS_H1Q), (const pg8::bf16_t*)(F.ws + WS_WINQ), T, NPROJ_ALL, 512};
        pg8::StaticOrder S; S.init(T, NPROJ_ALL, F.G, (int)blockIdx.x);
        Epi<EPI_ROUTE> E{F.ws, F.in[0], F.out, 2}; pg8::gemm_phase<Epi<EPI_ROUTE>, pg8::StaticOrder, true, true, true>(ldsl, g, S, E); } SEAM(2);
#else
    if (IN(2)) {
        { pg8::Gemm g{(const pg8::bf16_t*)(F.ws + WS_H1), (const pg8::bf16_t*)(F.ws + WS_WIN), T, NPROJ_B, 1024}; pg8::StaticOrder S; S.init(T, NPROJ_B, F.G, (int)blockIdx.x);
          Epi<EPI_ROUTE> E{F.ws, F.in[0], F.out, 0}; pg8::gemm_phase<Epi<EPI_ROUTE>, pg8::StaticOrder, true, true>(ldsl, g, S, E); }
        { pg8::Gemm g{(const pg8::bf16_t*)(F.ws + WS_H1Q), (const pg8::bf16_t*)(F.ws + WS_WINQ), T, NPROJ_Q, 512};
          pg8::StaticOrder S; S.init(T, NPROJ_Q, F.G, (int)blockIdx.x);
          Epi<EPI_ROUTE> E{F.ws, F.in[0], F.out, 1}; pg8::gemm_phase<Epi<EPI_ROUTE>, pg8::StaticOrder, true, true, true>(ldsl, g, S, E); }
    } SEAM(2);
#endif
    if (IN(3)) { qk_conv_pass(F); } SEAM(3);
    if (IN(4)) {
#if USE_MLSTM_REF
        if (blockIdx.x < 64) mlstm_ref_unit(F, blockIdx.x >> 2, blockIdx.x & 3);
#else
#ifndef DBG_SKIP_MLSTM
        if (blockIdx.x < 64) mlstm_unit(F, blockIdx.x >> 2, blockIdx.x & 3);
#else
        if (0) {}
#endif
#endif
        else {
#if USE_ATTN_REF
            const int nw = (F.G - 64) * NWAVES, w0 = (blockIdx.x - 64) * NWAVES + F.wave; for (int it = w0; it < T * 8; it += nw) attn_ref_item(F, it >> 3, it & 7);
#else
#ifndef DBG_SKIP_ATTN
            for (int u = blockIdx.x - 64; u < 2048; u += F.G - 64) { attn_unit(F, u >> 7, (u >> 4) & 7, 4 * (u & 15)); }
#endif
            late_weight_copies(F, (blockIdx.x - 64) * NWAVES + F.wave, (F.G - 64) * NWAVES);
#endif
        }
    } SEAM(4);
    if (IN(5)) { pg8::Gemm g{(const pg8::bf16_t*)(F.ws + WS_YA), (const pg8::bf16_t*)(F.ws + WS_WA), T, 1024, 512, (const pg8::bf16_t*)(F.ws + WS_YB), (const pg8::bf16_t*)(F.ws + WS_WB)};
        pg8::TwoPassOrder S; S.init(T, 1024, F.G, (int)blockIdx.x);
        Epi<EPI_MERGE> E{F.ws, F.in[0], F.out}; pg8::gemm_phase<Epi<EPI_MERGE>, pg8::TwoPassOrder, true, true>(ldsl, g, S, E); }
    SEAM(6);
    if (IN(7)) { pg8::Gemm g{(const pg8::bf16_t*)(F.ws + WS_Y), (const pg8::bf16_t*)(F.ws + WS_WOUT), T, 1024, 1024}; pg8::StaticOrder S; S.init(T, 1024, F.G, (int)blockIdx.x);
        Epi<EPI_OUTPROJ> E{F.ws, F.in[0], F.out}; pg8::gemm_phase<Epi<EPI_OUTPROJ>, pg8::StaticOrder, true, true>(ldsl, g, S, E); } SEAM(7);
    if (IN(8)) { norm_mod_rows<false, true>(F, (const float*)(F.ws + WS_X1), F.in[15], 3072, 4096, (unsigned short*)(F.ws + WS_H2)); } SEAM(8);
    if (IN(9)) { pg8::Gemm g{(const pg8::bf16_t*)(F.ws + WS_H2), (const pg8::bf16_t*)(F.ws + WS_WPQ), T, 2048, 1024}; pg8::StaticOrder S; S.init(T, 2048, F.G, (int)blockIdx.x);
        Epi<EPI_PQ> E{F.ws, F.in[0], F.out}; pg8::gemm_phase<Epi<EPI_PQ>, pg8::StaticOrder, true, true>(ldsl, g, S, E); } SEAM(9);
#if USE_ROUTE_REF
    if (IN(10)) { peer_route_ref(F); } SEAM(10);
#else
    if (IN(10)) { peer_route_mfma(F); asm volatile("s_waitcnt vmcnt(0)" ::: "memory"); __syncthreads(); }
#endif
#if PEER_FP4 && PEER_PIPE
    if (IN(11)) { peer_gather_pipe(F); }
#elif PEER_FP4
    if (IN(11)) { peer_gather_fp4(F); }
#elif PEER_FP8 && PEER_SWEEP
    if (IN(11)) { peer_gather_sweep(F); }
#elif PEER_FP8
    if (IN(11)) { peer_gather_fp8(F); }
#else
    if (IN(11)) { peer_gather(F); }
#endif
#ifdef DBG_TIME
    if (DBG_TIME == 11 || DBG_TIME == 99) dbg_t1 = __builtin_amdgcn_s_memrealtime();
    __syncthreads();
    if (blockIdx.x == 0 && F.tid == 0) { asm volatile("s_waitcnt vmcnt(0)" ::: "memory"); F.out[0] = (float)((dbg_t1 - dbg_t0) / DBG_TQ) * (float)(DBG_TQ / 1000); }
#endif
#ifdef DBG_DUMP
    if (hi < N_PHASES) { xcd_barrier(bar);
        for (int t = F.gw; t < T; t += F.NGW) { float* o = F.out + (size_t)t * 1024;
            for (int c = F.lane; c < 1024; c += 64) { float v = 0.f;
                if (DBG_DUMP == 8) v = bf2f(((const unsigned short*)(F.ws + WS_H2))[(size_t)t * 1024 + c]);
                if (DBG_DUMP == 9) v = bf2f(((const unsigned short*)(F.ws + WS_PQ))[(size_t)t * 2048 + c]) + 3.0f * bf2f(((const unsigned short*)(F.ws + WS_PQ))[(size_t)t * 2048 + 1024 + c]);
                if (DBG_DUMP == 10) v = (float)(((const unsigned*)(F.ws + WS_ROUTE))[(size_t)t * 128 + (c & 127)] >> ((c & 128) ? 16 : 0) & 0xffff) * (1.0f / 4096.0f);
                o[c] = v; } } }
#endif
#undef IN
#undef SEAM
}

extern "C" void kernel_launch(void* const* d_in, const int* in_sizes, int n_in, void* d_out, int out_size, void* d_ws, size_t ws_size, hipStream_t stream) {
    static int grid = 0;
    if (grid == 0) {
        if (n_in != 21 || out_size != T * DM || ws_size < WS_END) { fprintf(stderr, "kernel_launch: unexpected shapes (n_in %d, out %d, ws %zu); nothing launched\n", n_in, out_size, ws_size); grid = -1; return; }
        int dev = 0, cus = 0;
        if (hipGetDevice(&dev) != hipSuccess || hipDeviceGetAttribute(&cus, hipDeviceAttributeMultiprocessorCount, dev) != hipSuccess) { grid = -1; return; }
        if (hipFuncSetAttribute((const void*)fwd_kernel, hipFuncAttributeMaxDynamicSharedMemorySize, LDS_BYTES) != hipSuccess) { fprintf(stderr, "kernel_launch: hipFuncSetAttribute failed\n"); grid = -1; return; }
        int per_cu = 0;
        if (hipOccupancyMaxActiveBlocksPerMultiprocessor(&per_cu, (const void*)fwd_kernel, NWAVES * 64, LDS_BYTES) != hipSuccess || per_cu < 1) fprintf(stderr, "kernel_launch: occupancy query reports %d\n", per_cu);
        (void)hipGetLastError();
        grid = cus < 256 ? cus : 256;
    }
    if (grid < 0) return;
    (void)hipMemsetAsync((char*)d_ws + WS_CTL, 0, CTL_ZERO_BYTES, stream);
    Args a{};
    for (int i = 0; i < 21; ++i) a.in[i] = (const float*)d_in[i];
    a.out = (float*)d_out; a.ws = (unsigned char*)d_ws;
#if MK_ONE_LAUNCH
#ifndef DBG_STOP
#define DBG_STOP N_PHASES
#endif
    a.ph_lo = 0; a.ph_hi = DBG_STOP; a.li = 0;
    hipLaunchKernelGGL(fwd_kernel, dim3(grid), dim3(NWAVES * 64), LDS_BYTES, stream, a);
#else
    for (int li = 0; li < N_PHASES; ++li) { a.ph_lo = li; a.ph_hi = li + 1; a.li = li; hipLaunchKernelGGL(fwd_kernel, dim3(grid), dim3(NWAVES * 64), LDS_BYTES, stream, a); }
#endif
}
```

```cpp
#include <hip/hip_runtime.h>
#include <cstdio>
#include <cstdint>
#include <cmath>
#define MK_ONE_LAUNCH 1
namespace pg8 {
#define PG8_LAS __attribute__((address_space(3)))
typedef unsigned short bf16_t;
typedef short bf16x8 __attribute__((ext_vector_type(8)));
typedef float f32x4 __attribute__((ext_vector_type(4)));
typedef unsigned u32x4 __attribute__((ext_vector_type(4)));
typedef int pg8_v4i __attribute__((ext_vector_type(4)));
typedef int pg8_v8i __attribute__((ext_vector_type(8)));
constexpr int BM = 256, BK = 64, HALF = 128, HTB = HALF * BK * 2  , STAGE_BYTES = 8 * HTB, NXCD = 8, WGM = 8;

__host__ __device__ __forceinline__ int lds_byte(int r, int c) { const int st = (r >> 4) * 2 + (c >> 5), rr = r & 15, cc = c & 31, ob = rr * 64 + cc * 2; return st * 1024 + (ob ^ (((ob >> 9) & 1) << 5)); }
__host__ __device__ __forceinline__ void stage_rc(int b, int& R, int& C) { const int st = b / 1024, sb = b % 1024, swz = sb ^ (((sb >> 9) & 1) << 5); R = (st >> 1) * 16 + swz / 64; C = (st & 1) * 32 + (swz % 64) / 2; }
__host__ __device__ __forceinline__ int perm32(int rho) { const int n = rho >> 4, i = rho & 15; return 8 * (i >> 2) + 4 * n + (i & 3); }

struct Unit { int pm, pn, half; };
struct Gemm { const bf16_t* A; const bf16_t* Bt; int M, N, K; const bf16_t* A2 = nullptr; const bf16_t* Bt2 = nullptr; };

struct StaticOrder {
    int nM, nN, nwg, G, c;
    __host__ __device__ void init(int M, int N, int G_, int c_) { nM = M / BM; nN = N / BM; nwg = nM * nN; G = G_; c = c_; }
    __host__ __device__ bool next(int i, Unit& u) const {
        const long L = (long)i * G + c; if (L >= nwg) return false;
        int wgid = (int)L; { const int q = nwg / NXCD, r = nwg % NXCD, xcd = wgid % NXCD, off = wgid / NXCD; wgid = (xcd < r ? xcd * (q + 1) : r * (q + 1) + (xcd - r) * q) + off; }
        const int nig = WGM * nN, gid = wgid / nig, fm = gid * WGM, gsz = (nM - fm) < WGM ? (nM - fm) : WGM;
        u.pm = fm + ((wgid % nig) % gsz); u.pn = (wgid % nig) / gsz; u.half = 0; return true;
    }
    __device__ __forceinline__ void a_ready(const Unit&) const {}
    __device__ __forceinline__ void done(const Unit&) const {}
};
struct TwoPassOrder {
    StaticOrder so;
    __host__ __device__ void init(int M, int N, int G_, int c_) { so.init(M, N, G_, c_); }
    __host__ __device__ bool next(int i, Unit& u) const { if (!so.next(i >> 1, u)) return false; u.half = i & 1; return true; }
    __device__ __forceinline__ void a_ready(const Unit&) const {}
    __device__ __forceinline__ void done(const Unit&) const {}
};
__device__ __forceinline__ unsigned cvt_pk_bf16(float lo, float hi) { unsigned r; asm volatile("v_cvt_pk_bf16_f32 %0, %1, %2" : "=v"(r) : "v"(lo), "v"(hi)); return r; }
template <class Epi, class Sched, bool ALIGN_EPI = false, bool SP2 = false, bool FP8 = false>
__device__ __forceinline__ void gemm_phase(PG8_LAS unsigned char* lds, const Gemm g, const Sched& S, const Epi& E) {
    const int tid = threadIdx.x, wid = __builtin_amdgcn_readfirstlane(tid >> 6), lane = tid & 63, wr = wid >> 2, wc = wid & 3, fr = lane & 15, fq = lane >> 4;
    const int K = g.K, nt = K / BK;
    unsigned voffA[2], voffB[2];
#pragma unroll
    for (int i = 0; i < 2; ++i) { int R, C; stage_rc(tid * 16 + i * 8192, R, C); const int Rb = Epi::PERM ? ((R & ~31) + perm32(R & 31)) : R;
        voffA[i] = (unsigned)(R * K + C) * 2u; voffB[i] = (unsigned)(Rb * K + C) * 2u; }
    const size_t kstep = (size_t)(BK * 2);
    const size_t hstep = (size_t)HALF * K * 2;
    const size_t tstep = 2 * hstep;
    const unsigned ldsw = (unsigned)wid * 1024u;
    const int aoff = lds_byte(wr * 64 + fr, fq * 8), boff = lds_byte(wc * 32 + fr, fq * 8);
#define PG8_SA(b, h) (((b) * 2 + (h)) * HTB)
#define PG8_SB(b, h) ((4 + (b) * 2 + (h)) * HTB)
#define PG8_STAGE(bufoff, gbase, voff) do { _Pragma("unroll") for (int _i = 0; _i < 2; ++_i) \
        __builtin_amdgcn_global_load_lds((const unsigned*)((const char*)(gbase) + (voff)[_i]), (PG8_LAS unsigned*)(lds + (bufoff) + ldsw + _i * 8192), 16, 0, 0); } while (0)
#define PG8_LDA(dst, b, h) do { _Pragma("unroll") for (int m = 0; m < 4; ++m) dst[m] = PG8_CAT(*(const PG8_LAS bf16x8*)(lds + PG8_SA(b, h) + aoff + m * 2048), *(const PG8_LAS bf16x8*)(lds + PG8_SA(b, h) + aoff + m * 2048 + 1024)); } while (0)
#define PG8_LDB(dst, b, h) do { _Pragma("unroll") for (int n = 0; n < 2; ++n) dst[n] = PG8_CAT(*(const PG8_LAS bf16x8*)(lds + PG8_SB(b, h) + boff + n * 2048), *(const PG8_LAS bf16x8*)(lds + PG8_SB(b, h) + boff + n * 2048 + 1024)); } while (0)
#define PG8_CAT(x, y) __builtin_shufflevector(__builtin_bit_cast(pg8_v4i, x), __builtin_bit_cast(pg8_v4i, y), 0, 1, 2, 3, 4, 5, 6, 7)
#define PG8_HALF(v, k) __builtin_bit_cast(bf16x8, __builtin_shufflevector(v, v, 4 * (k), 4 * (k) + 1, 4 * (k) + 2, 4 * (k) + 3))
#define PG8_MMA(ai, bj, At, Bt) do { __builtin_amdgcn_s_setprio(1); \
        if constexpr (FP8) { _Pragma("unroll") for (int m = 0; m < 4; ++m) _Pragma("unroll") for (int n = 0; n < 2; ++n) \
            asm volatile("v_mfma_f32_16x16x128_f8f6f4 %0, %1, %2, %0" : "+v"(acc[ai][bj][m][n]) : "v"(Bt[n]), "v"(At[m])); } \
        else { _Pragma("unroll") for (int m = 0; m < 4; ++m) _Pragma("unroll") for (int n = 0; n < 2; ++n) { \
            acc[ai][bj][m][n] = __builtin_amdgcn_mfma_f32_16x16x32_bf16(PG8_HALF(Bt[n], 0), PG8_HALF(At[m], 0), acc[ai][bj][m][n], 0, 0, 0); \
            acc[ai][bj][m][n] = __builtin_amdgcn_mfma_f32_16x16x32_bf16(PG8_HALF(Bt[n], 1), PG8_HALF(At[m], 1), acc[ai][bj][m][n], 0, 0, 0); } } \
        __builtin_amdgcn_s_setprio(0); } while (0)
#define PG8_WAIT_V(n) asm volatile("s_waitcnt vmcnt(" #n ")" ::: "memory")
#define PG8_WAIT_L(n) asm volatile("s_waitcnt lgkmcnt(" #n ")" ::: "memory")
#define PG8_BAR __builtin_amdgcn_s_barrier()
#define PG8_SCHED __builtin_amdgcn_sched_barrier(0)
    Unit cur, nxt; int ui = 0;
    if (!S.next(0, cur)) return;
    f32x4 acc[2][2][4][2];
#pragma unroll
    for (int a = 0; a < 2; ++a)
#pragma unroll
        for (int b = 0; b < 2; ++b)
#pragma unroll
            for (int m = 0; m < 4; ++m)
#pragma unroll
                for (int n = 0; n < 2; ++n) acc[a][b][m][n] = (f32x4){0.f, 0.f, 0.f, 0.f};
    pg8_v8i At[4], B0[2], B1[2];
    const char* cA = (const char*)((Epi::TWO_PASS && cur.half) ? g.A2 : g.A) + (size_t)cur.pm * tstep; const char* cB = (const char*)((Epi::TWO_PASS && cur.half) ? g.Bt2 : g.Bt) + (size_t)cur.pn * tstep;
    S.a_ready(cur);
    if constexpr (SP2) {
        PG8_STAGE(PG8_SB(0, 0), cB, voffB); PG8_STAGE(PG8_SB(0, 1), cB + hstep, voffB); PG8_STAGE(PG8_SA(0, 0), cA, voffA); PG8_STAGE(PG8_SA(0, 1), cA + hstep, voffA);
        if (wr == 1) PG8_BAR;
        PG8_WAIT_V(2); PG8_BAR;
        PG8_STAGE(PG8_SB(1, 0), cB + kstep, voffB); PG8_STAGE(PG8_SA(1, 0), cA + kstep, voffA); PG8_STAGE(PG8_SB(1, 1), cB + hstep + kstep, voffB);
        PG8_WAIT_V(6); PG8_BAR;
    } else {
        PG8_STAGE(PG8_SB(0, 0), cB, voffB); PG8_STAGE(PG8_SA(0, 0), cA, voffA); PG8_STAGE(PG8_SB(0, 1), cB + hstep, voffB); PG8_STAGE(PG8_SA(0, 1), cA + hstep, voffA);
        if (wr == 1) PG8_BAR;
        PG8_WAIT_V(4); PG8_BAR;
        PG8_STAGE(PG8_SB(1, 0), cB + kstep, voffB); PG8_STAGE(PG8_SA(1, 0), cA + kstep, voffA); PG8_STAGE(PG8_SB(1, 1), cB + hstep + kstep, voffB);
        PG8_WAIT_V(6); PG8_BAR;
    }
    for (;;) {
        const bool has_next = S.next(ui + 1, nxt);
        const char* nA = has_next ? (const char*)((Epi::TWO_PASS && nxt.half) ? g.A2 : g.A) + (size_t)nxt.pm * tstep : cA; const char* nB = has_next ? (const char*)((Epi::TWO_PASS && nxt.half) ? g.Bt2 : g.Bt) + (size_t)nxt.pn * tstep : cB;
        for (int t = 0; t < nt; t += 2) {
            const bool last = (t == nt - 2);
            const char* a1 = cA + (size_t)(t + 1) * kstep;
            const char* a2 = last ? nA : cA + (size_t)(t + 2) * kstep; const char* b2 = last ? nB : cB + (size_t)(t + 2) * kstep;
            const char* a3 = a2 + kstep; const char* b3 = b2 + kstep;
            if (last && has_next) S.a_ready(nxt);
            if constexpr (SP2) {
            PG8_LDB(B0, 0, 0); PG8_LDB(B1, 0, 1); PG8_SCHED; PG8_LDA(At, 0, 0); PG8_STAGE(PG8_SA(1, 1), a1 + hstep, voffA);
            PG8_WAIT_V(8); PG8_WAIT_L(0); PG8_BAR; PG8_MMA(0, 0, At, B0); PG8_MMA(0, 1, At, B1); PG8_BAR; PG8_SCHED;
            PG8_LDA(At, 0, 1); PG8_STAGE(PG8_SB(0, 0), b2, voffB); PG8_STAGE(PG8_SB(0, 1), b2 + hstep, voffB); PG8_STAGE(PG8_SA(0, 0), a2, voffA);
            PG8_WAIT_V(8); PG8_WAIT_L(0); PG8_BAR; PG8_MMA(1, 0, At, B0); PG8_MMA(1, 1, At, B1); PG8_BAR; PG8_SCHED;
            PG8_LDB(B0, 1, 0); PG8_LDB(B1, 1, 1); PG8_SCHED; PG8_LDA(At, 1, 0); PG8_STAGE(PG8_SA(0, 1), a2 + hstep, voffA);
            PG8_WAIT_V(8); PG8_WAIT_L(0); PG8_BAR; PG8_MMA(0, 0, At, B0); PG8_MMA(0, 1, At, B1); PG8_BAR; PG8_SCHED;
            PG8_LDA(At, 1, 1); PG8_STAGE(PG8_SB(1, 0), b3, voffB); PG8_STAGE(PG8_SB(1, 1), b3 + hstep, voffB); PG8_STAGE(PG8_SA(1, 0), a3, voffA);
            PG8_WAIT_V(8); PG8_WAIT_L(0); PG8_BAR; PG8_MMA(1, 0, At, B0); PG8_MMA(1, 1, At, B1); PG8_BAR; PG8_SCHED;
            } else {
            PG8_LDB(B0, 0, 0); PG8_SCHED; PG8_LDA(At, 0, 0); PG8_STAGE(PG8_SA(1, 1), a1 + hstep, voffA);
            PG8_WAIT_L(8); PG8_BAR; PG8_WAIT_L(0); PG8_MMA(0, 0, At, B0); PG8_BAR; PG8_SCHED;
            PG8_LDB(B1, 0, 1); PG8_STAGE(PG8_SB(0, 0), b2, voffB);
            PG8_BAR; PG8_WAIT_L(0); PG8_MMA(0, 1, At, B1); PG8_BAR;
            PG8_LDA(At, 0, 1); PG8_STAGE(PG8_SA(0, 0), a2, voffA);
            PG8_BAR; PG8_WAIT_L(0); PG8_MMA(1, 0, At, B0); PG8_BAR; PG8_SCHED;
            PG8_STAGE(PG8_SB(0, 1), b2 + hstep, voffB);
            PG8_WAIT_V(6); PG8_BAR; PG8_MMA(1, 1, At, B1); PG8_BAR;
            PG8_LDB(B0, 1, 0); PG8_SCHED; PG8_LDA(At, 1, 0); PG8_STAGE(PG8_SA(0, 1), a2 + hstep, voffA);
            PG8_WAIT_L(8); PG8_BAR; PG8_WAIT_L(0); PG8_MMA(0, 0, At, B0); PG8_BAR; PG8_SCHED;
            PG8_LDB(B1, 1, 1); PG8_STAGE(PG8_SB(1, 0), b3, voffB);
            PG8_BAR; PG8_WAIT_L(0); PG8_MMA(0, 1, At, B1); PG8_BAR;
            PG8_LDA(At, 1, 1); PG8_STAGE(PG8_SA(1, 0), a3, voffA);
            PG8_BAR; PG8_WAIT_L(0); PG8_MMA(1, 0, At, B0); PG8_BAR; PG8_SCHED;
            PG8_STAGE(PG8_SB(1, 1), b3 + hstep, voffB);
            PG8_WAIT_V(6); PG8_BAR; PG8_MMA(1, 1, At, B1); PG8_BAR;
            }
        }
        if constexpr (FP8) asm volatile("s_nop 15\n\ts_nop 15" ::: "memory");
        if constexpr (ALIGN_EPI) { if (wr == 0) PG8_BAR; }
        bool keep_acc = false;
        if constexpr (Epi::TWO_PASS) { if (cur.half == 0) { E.mid(acc, cur, wr, wc, fr, fq); keep_acc = true; } else { E(acc, cur, wr, wc, fr, fq); } }
        else if constexpr (!Epi::AFTER_DRAIN) { E(acc, cur, wr, wc, fr, fq); S.done(cur); }
        if (!has_next) break;
        if (!keep_acc)
#pragma unroll
        for (int a = 0; a < 2; ++a)
#pragma unroll
            for (int b = 0; b < 2; ++b)
#pragma unroll
                for (int m = 0; m < 4; ++m)
#pragma unroll
                    for (int n = 0; n < 2; ++n) acc[a][b][m][n] = (f32x4){0.f, 0.f, 0.f, 0.f};
        cur = nxt; cA = nA; cB = nB; ++ui;
        if constexpr (ALIGN_EPI) { if (wr == 1) PG8_BAR; }
    }
    PG8_WAIT_V(0);
    if constexpr (!ALIGN_EPI) { if (wr == 0) PG8_BAR; }
    PG8_BAR;
    if constexpr (Epi::AFTER_DRAIN) { E.fused(acc, cur, wr, wc, fr, fq, lds, wid, lane); S.done(cur); }
#undef PG8_SA
#undef PG8_SB
#undef PG8_STAGE
#undef PG8_LDA
#undef PG8_LDB
#undef PG8_MMA
#undef PG8_CAT
#undef PG8_HALF
#undef PG8_WAIT_V
#undef PG8_WAIT_L
#undef PG8_BAR
#undef PG8_SCHED
}
}
#define GAS __attribute__((address_space(1)))
#define LAS __attribute__((address_space(3)))
typedef unsigned short bf16;
typedef unsigned v4u __attribute__((ext_vector_type(4)));
typedef float f32x4 __attribute__((ext_vector_type(4)));
typedef short bf16x8 __attribute__((ext_vector_type(8)));
typedef GAS unsigned gu32;
typedef GAS unsigned long long gu64;
#define RLX_AGENT __ATOMIC_RELAXED, __HIP_MEMORY_SCOPE_AGENT
#define LDS_WAIT() asm volatile("s_waitcnt lgkmcnt(0)" ::: "memory")
#define VM_WAIT() asm volatile("s_waitcnt vmcnt(0)" ::: "memory")
__device__ __forceinline__ unsigned long long rt() { return __builtin_amdgcn_s_memrealtime(); }
__device__ __forceinline__ unsigned f2bf(float f) { unsigned u = __builtin_bit_cast(unsigned, f); return (u + 0x7fffu + ((u >> 16) & 1u)) >> 16; }
__device__ __forceinline__ unsigned pk2(float lo, float hi) { return f2bf(lo) | (f2bf(hi) << 16); }

#define XB_TMO      128
#define XB_XCNT(j)  (256  + 64 * (j))
#define XB_XSUB(j)  (1280 + 64 * (j))
#define XB_XGEN(j)  (2304 + 64 * (j))
#define XB_TOP      3328
#define XB_TOPGEN   3392
#define XCD_BAR_WORDS 3456
#define XB_SPIN_CAP (1u << 18)

__device__ __forceinline__ unsigned xb_ld(unsigned* p)              { return __hip_atomic_load(p, __ATOMIC_RELAXED, __HIP_MEMORY_SCOPE_AGENT); }
__device__ __forceinline__ unsigned xb_add(unsigned* p, unsigned v) { return __hip_atomic_fetch_add(p, v, __ATOMIC_RELAXED, __HIP_MEMORY_SCOPE_AGENT); }
__device__ __forceinline__ unsigned xb_xcc_id() { return (unsigned)__builtin_amdgcn_s_getreg((3 << 11) | 20) & 0xFu; }
#define XB_SPIN(cond, bar) do { unsigned _sp = 0; while (cond) { __builtin_amdgcn_s_sleep(1); \
    if ((++_sp & 255u) == 0u) { if (xb_ld(&(bar)[XB_TMO])) break; if (_sp > XB_SPIN_CAP) { atomicAdd(&(bar)[XB_TMO], 1u); break; } } } } while (0)

struct XcdBarrier {
    unsigned* bar; unsigned x;
    volatile LAS unsigned* st;
};

__device__ __forceinline__ XcdBarrier xcd_barrier_post(unsigned* bar, volatile LAS unsigned* st) {
    XcdBarrier b; b.bar = bar; b.x = xb_xcc_id(); b.st = st;
    if (threadIdx.x == 0) (void)xb_add(&bar[XB_XCNT(b.x)], 1u);
    return b;
}
__device__ __forceinline__ void xcd_barrier_complete(unsigned* bar, unsigned x, unsigned& nloc, unsigned& nx) {
    const unsigned G = gridDim.x * gridDim.y * gridDim.z;
    unsigned sum, cnt, mine, sp = 0u;
    for (;;) {
        sum = 0u; cnt = 0u; mine = 0u;
#pragma unroll
        for (unsigned j = 0; j < 16; ++j) { const unsigned c = xb_ld(&bar[XB_XCNT(j)]); sum += c; cnt += (c > 0u) ? 1u : 0u; mine = (j == x) ? c : mine; }
        if (sum == G) break;
        __builtin_amdgcn_s_sleep(1);
        if ((++sp & 255u) == 0u) { if (xb_ld(&bar[XB_TMO])) break; if (sp > XB_SPIN_CAP) { atomicAdd(&bar[XB_TMO], 1u); break; } }
    }
    nloc = mine > 0u ? mine : 1u; nx = cnt > 0u ? cnt : 1u;
}

__device__ __forceinline__ void xcd_barrier(const XcdBarrier& b) {
    asm volatile("s_waitcnt vmcnt(0)" ::: "memory");
    __syncthreads();
    if (threadIdx.x == 0) {
        unsigned* bar = b.bar;
        __builtin_amdgcn_s_waitcnt(0);
        unsigned nloc = b.st[0], nx = b.st[1];
        if (nloc == 0u) { xcd_barrier_complete(bar, b.x, nloc, nx); b.st[0] = nloc; b.st[1] = nx; }
        const unsigned old = xb_add(&bar[XB_XSUB(b.x)], 1u);
        const unsigned gen = old / nloc;
        if (old + 1u == (gen + 1u) * nloc) {
            __builtin_amdgcn_fence(__ATOMIC_RELEASE, "agent");
            asm volatile("s_waitcnt vmcnt(0)" ::: "memory");
            const unsigned og = xb_add(&bar[XB_TOP], 1u);
            const unsigned tg = og / nx;
            if (og + 1u == (tg + 1u) * nx) xb_add(&bar[XB_TOPGEN], 1u);
            else XB_SPIN(xb_ld(&bar[XB_TOPGEN]) == tg, bar);
            __builtin_amdgcn_fence(__ATOMIC_ACQUIRE, "agent");
            xb_add(&bar[XB_XGEN(b.x)], 1u);
            asm volatile("s_waitcnt vmcnt(0)" ::: "memory");
        } else {
            XB_SPIN(xb_ld(&bar[XB_XGEN(b.x)]) == gen, bar);
            __builtin_amdgcn_fence(__ATOMIC_ACQUIRE, "agent");
            asm volatile("s_waitcnt vmcnt(0)" ::: "memory");
        }
    }
    __syncthreads();
}

#ifndef PEER_FP8
#define PEER_FP8 1
#endif
#ifndef FP4_BF16_SWAP
#define FP4_BF16_SWAP 1
#endif
#ifndef ML_SHARE_P
#define ML_SHARE_P 1
#endif
#ifndef PEER_PIPE
#define PEER_PIPE 1
#endif
#ifndef PEER_GB
#define PEER_GB 16
#endif
#ifndef PEER_SWEEP
#define PEER_SWEEP 0
#endif
#ifndef PEER_FP4
#define PEER_FP4 1
#endif
#ifndef DBG_TQ
#define DBG_TQ 1000ull
#endif
#ifndef DBG_IDMASK
#define DBG_IDMASK 0xffffu
#endif
#ifndef SW_SORT_MAX
#define SW_SORT_MAX 512
#endif
constexpr int NB = 16, SEQ = 4096, DM = 1024, T = NB * SEQ;
#ifndef PROJ_ALL_FP8
#define PROJ_ALL_FP8 1
#endif
constexpr int NPROJ_ALL = 5632;
constexpr int NPROJ_B = 2048;
constexpr int NPROJ_Q = 3584;
constexpr float WQ_SCALE = 64.0f;
constexpr int IN_COLS = 5640;
constexpr float EPS = 1e-6f;
constexpr int NWAVES = 8;

constexpr size_t MiB = 1u << 20;
constexpr size_t WS_CTL = 0, CTL_ZERO_BYTES = 1 * MiB;
constexpr size_t WS_MOD = 1 * MiB;
constexpr size_t WS_W8 = 2 * MiB;
constexpr size_t WS_WIN = 4 * MiB;
constexpr size_t WS_WINQ = 9 * MiB;
constexpr size_t WS_H1Q = 960 * MiB;
constexpr size_t WS_WA = 15 * MiB;
constexpr size_t WS_WB = 16 * MiB;
constexpr size_t WS_WOUT = 17 * MiB;
constexpr size_t WS_WPQ = 19 * MiB;
constexpr size_t WS_SUBK = 23 * MiB;
constexpr size_t WS_U = 24 * MiB;
constexpr size_t WS_V = 56 * MiB;
constexpr size_t WS_USC = 40 * MiB, WS_VSC = 41 * MiB;
constexpr size_t WS_GATES = 88 * MiB;
constexpr size_t WS_ROUTE = 90 * MiB;
constexpr size_t WS_H1 = 128 * MiB;
constexpr size_t WS_QKC = 128 * MiB;
constexpr size_t WS_YA = 448 * MiB, WS_YB = 512 * MiB, WS_H2 = 128 * MiB;
constexpr size_t WS_QKVA = 256 * MiB;
constexpr size_t WS_Y = 256 * MiB;
constexpr size_t WS_QKB = 448 * MiB;
constexpr size_t WS_VB = 576 * MiB;
constexpr size_t WS_OB = 640 * MiB;
constexpr size_t WS_GAB = 704 * MiB;
constexpr size_t WS_PQ = 704 * MiB;
constexpr size_t WS_X1 = 448 * MiB;
constexpr size_t WS_COEF = 960 * MiB;
constexpr size_t WS_END = 992 * MiB;
constexpr int CW_BAR = 4096;

constexpr int LDS_BYTES = 151552;
constexpr int MISC_OFF = 147456;

struct Args { const float* in[21]; float* out; unsigned char* ws; int ph_lo, ph_hi, li, pad; };

struct Frame {
    unsigned char* lds;
    int tid, lane, wave, G, gw, NGW;
    const float* in[21]; float* out; unsigned char* ws;
};

__device__ __forceinline__ float bf2f(unsigned short h) { return __builtin_bit_cast(float, (unsigned)h << 16); }
__device__ __forceinline__ float bflo(unsigned w) { return __builtin_bit_cast(float, w << 16); }
__device__ __forceinline__ float bfhi(unsigned w) { return __builtin_bit_cast(float, w & 0xffff0000u); }
typedef __bf16 bf16x2_t __attribute__((ext_vector_type(2)));
__device__ __forceinline__ float dot2c(float acc, unsigned a, unsigned b) { return __builtin_amdgcn_fdot2_f32_bf16(__builtin_bit_cast(bf16x2_t, a), __builtin_bit_cast(bf16x2_t, b), acc, false); }
__device__ __forceinline__ float wave_sum(float v) {
#pragma unroll
    for (int o = 1; o < 64; o <<= 1) v += __shfl_xor(v, o);
    return v;
}
__device__ __forceinline__ float wave_max(float v) {
#pragma unroll
    for (int o = 1; o < 64; o <<= 1) v = fmaxf(v, __shfl_xor(v, o));
    return v;
}
typedef float f32x2_t __attribute__((ext_vector_type(2)));
typedef float f32x16 __attribute__((ext_vector_type(16)));
__device__ __forceinline__ unsigned cvtpk(float lo, float hi) { f32x2_t v = {lo, hi}; bf16x2_t b = __builtin_convertvector(v, bf16x2_t); return __builtin_bit_cast(unsigned, b); }
__device__ __forceinline__ float sigmoidf_(float v) { return 1.0f / (1.0f + __expf(-v)); }

#define DPPF(oldv, v, ctrl, rmask) __builtin_bit_cast(float, __builtin_amdgcn_update_dpp(__builtin_bit_cast(int, (float)(oldv)), __builtin_bit_cast(int, (float)(v)), ctrl, rmask, 0xf, false))
__device__ __forceinline__ float scan_sum64(float v) {
    v += DPPF(0.f, v, 0x111, 0xf); v += DPPF(0.f, v, 0x112, 0xf); v += DPPF(0.f, v, 0x114, 0xf); v += DPPF(0.f, v, 0x118, 0xf);
    v += DPPF(0.f, v, 0x142, 0xa); v += DPPF(0.f, v, 0x143, 0xc);
    return v;
}
__device__ __forceinline__ float scan_max64(float v) {
    v = fmaxf(v, DPPF(-INFINITY, v, 0x111, 0xf)); v = fmaxf(v, DPPF(-INFINITY, v, 0x112, 0xf)); v = fmaxf(v, DPPF(-INFINITY, v, 0x114, 0xf)); v = fmaxf(v, DPPF(-INFINITY, v, 0x118, 0xf));
    v = fmaxf(v, DPPF(-INFINITY, v, 0x142, 0xa)); v = fmaxf(v, DPPF(-INFINITY, v, 0x143, 0xc));
    return v;
}
__device__ __forceinline__ float lane63(float v) { return __builtin_bit_cast(float, __builtin_amdgcn_readlane(__builtin_bit_cast(int, v), 63)); }
__device__ __forceinline__ float wave_sum_u(float v) { return lane63(scan_sum64(v)); }

enum { EPI_ROUTE = 1, EPI_MERGE_A = 2, EPI_MERGE_B = 3, EPI_OUTPROJ = 4, EPI_PQ = 5, EPI_MERGE = 6 };
template <int MODE> struct Epi {
    static constexpr bool PERM = true, AFTER_DRAIN = false, TWO_PASS = (MODE == EPI_MERGE);
    unsigned char* ws; const float* x; float* out; int part = 0;
    __device__ __forceinline__ void mid(pg8::f32x4 (&acc)[2][2][4][2], const pg8::Unit& u, int wr, int wc, int fr, int fq) const {
        using pg8::u32x4;
        const int row0 = u.pm * 256 + wr * 64 + fr, colw = 256 * u.pn + wc * 32 + 8 * fq;
#pragma unroll
        for (int ai = 0; ai < 2; ++ai)
#pragma unroll
            for (int m = 0; m < 4; ++m) {
                const int row = row0 + ai * 128 + m * 16;
#pragma unroll
                for (int bj = 0; bj < 2; ++bj) {
                    typedef unsigned u32x2_t __attribute__((ext_vector_type(2)));
                    const unsigned char* gp = (const unsigned char*)(ws + WS_GAB) + (size_t)row * 2048 + colw + bj * 128;
                    const u32x2_t ga = *(const u32x2_t*)gp, gb = *(const u32x2_t*)(gp + 1024);
                    const f32x2_t a0 = __builtin_amdgcn_cvt_pk_f32_fp8(ga.x, false), a1 = __builtin_amdgcn_cvt_pk_f32_fp8(ga.x, true), a2 = __builtin_amdgcn_cvt_pk_f32_fp8(ga.y, false), a3 = __builtin_amdgcn_cvt_pk_f32_fp8(ga.y, true);
                    const f32x2_t b0 = __builtin_amdgcn_cvt_pk_f32_fp8(gb.x, false), b1 = __builtin_amdgcn_cvt_pk_f32_fp8(gb.x, true), b2 = __builtin_amdgcn_cvt_pk_f32_fp8(gb.y, false), b3 = __builtin_amdgcn_cvt_pk_f32_fp8(gb.y, true);
                    acc[ai][bj][m][0][0] *= a0.x * __builtin_amdgcn_rcpf(b0.x); acc[ai][bj][m][0][1] *= a0.y * __builtin_amdgcn_rcpf(b0.y);
                    acc[ai][bj][m][0][2] *= a1.x * __builtin_amdgcn_rcpf(b1.x); acc[ai][bj][m][0][3] *= a1.y * __builtin_amdgcn_rcpf(b1.y);
                    acc[ai][bj][m][1][0] *= a2.x * __builtin_amdgcn_rcpf(b2.x); acc[ai][bj][m][1][1] *= a2.y * __builtin_amdgcn_rcpf(b2.y);
                    acc[ai][bj][m][1][2] *= a3.x * __builtin_amdgcn_rcpf(b3.x); acc[ai][bj][m][1][3] *= a3.y * __builtin_amdgcn_rcpf(b3.y);
                }
            }
    }
    __device__ __forceinline__ void operator()(const pg8::f32x4 (&acc)[2][2][4][2], const pg8::Unit& u, int wr, int wc, int fr, int fq) const {
        using pg8::f32x4; using pg8::u32x4; using pg8::cvt_pk_bf16;
        const int row0 = u.pm * 256 + wr * 64 + fr;
        const int colw = wc * 32 + 8 * fq;
        unsigned short* obase = nullptr; int ldc = 0, coff = 0; bool sig = false, gab8 = false; float qsc = 1.0f;
        if (MODE == EPI_ROUTE) {
            const int pn = u.pn;
            if (part == 2) {
                qsc = 1.0f / WQ_SCALE;
                if (pn < 6) { obase = (unsigned short*)(ws + WS_QKVA); ldc = 1536; coff = 256 * pn; }
                else if (pn < 10) { obase = (unsigned short*)(ws + WS_QKB); ldc = 1024; coff = 256 * (pn - 6); }
                else if (pn < 12) { obase = (unsigned short*)(ws + WS_VB); ldc = 512; coff = 256 * (pn - 10); }
                else if (pn < 14) { obase = (unsigned short*)(ws + WS_OB); ldc = 512; coff = 256 * (pn - 12); sig = true; }
                else { obase = (unsigned short*)(ws + WS_GAB); ldc = 2048; coff = 256 * (pn - 14); sig = true; gab8 = true; }
            } else if (part == 0) {
                if (pn < 4) { obase = (unsigned short*)(ws + WS_QKVA); ldc = 1536; coff = 256 * pn; }
                else { obase = (unsigned short*)(ws + WS_QKB); ldc = 1024; coff = 256 * (pn - 4); }
            } else {
                qsc = 1.0f / WQ_SCALE;
                if (pn < 2) { obase = (unsigned short*)(ws + WS_QKVA); ldc = 1536; coff = 1024 + 256 * pn; }
                else if (pn < 4) { obase = (unsigned short*)(ws + WS_VB); ldc = 512; coff = 256 * (pn - 2); }
                else if (pn < 6) { obase = (unsigned short*)(ws + WS_OB); ldc = 512; coff = 256 * (pn - 4); sig = true; }
                else { obase = (unsigned short*)(ws + WS_GAB); ldc = 2048; coff = 256 * (pn - 6); sig = true; gab8 = true; }
            }
        } else if (MODE == EPI_MERGE_A || MODE == EPI_MERGE_B || MODE == EPI_MERGE) { obase = (unsigned short*)(ws + WS_Y); ldc = 1024; coff = 256 * u.pn; }
        else if (MODE == EPI_PQ) { obase = (unsigned short*)(ws + WS_PQ); ldc = 2048; coff = 256 * u.pn; }
        else { coff = 256 * u.pn; }
#pragma unroll
        for (int ai = 0; ai < 2; ++ai)
#pragma unroll
            for (int m = 0; m < 4; ++m) {
                const int row = row0 + ai * 128 + m * 16;
#pragma unroll
                for (int bj = 0; bj < 2; ++bj) {
                    const int col = coff + bj * 128 + colw;
                    f32x4 v0 = acc[ai][bj][m][0], v1 = acc[ai][bj][m][1];
                    if (MODE == EPI_ROUTE) {
                        v0 = v0 * qsc; v1 = v1 * qsc;
                        if (sig) {
#pragma unroll
                            for (int e = 0; e < 4; ++e) { v0[e] = sigmoidf_(v0[e]); v1[e] = sigmoidf_(v1[e]); }
                        }
                    } else if (MODE == EPI_MERGE) {
                        typedef unsigned u32x2_t __attribute__((ext_vector_type(2)));
                        const u32x2_t g = *(const u32x2_t*)((const unsigned char*)(ws + WS_GAB) + (size_t)row * 2048 + 1024 + col);
                        const f32x2_t b0 = __builtin_amdgcn_cvt_pk_f32_fp8(g.x, false), b1 = __builtin_amdgcn_cvt_pk_f32_fp8(g.x, true), b2 = __builtin_amdgcn_cvt_pk_f32_fp8(g.y, false), b3 = __builtin_amdgcn_cvt_pk_f32_fp8(g.y, true);
                        v0[0] *= b0.x; v0[1] *= b0.y; v0[2] *= b1.x; v0[3] *= b1.y;
                        v1[0] *= b2.x; v1[1] *= b2.y; v1[2] *= b3.x; v1[3] *= b3.y;
                    } else if (MODE == EPI_MERGE_A || MODE == EPI_MERGE_B) {
                        const u32x4 g = *(const u32x4*)((const unsigned short*)(ws + WS_GAB) + (size_t)row * 2048 + (MODE == EPI_MERGE_B ? 1024 : 0) + col);
                        v0[0] *= bflo(g.x); v0[1] *= bfhi(g.x); v0[2] *= bflo(g.y); v0[3] *= bfhi(g.y);
                        v1[0] *= bflo(g.z); v1[1] *= bfhi(g.z); v1[2] *= bflo(g.w); v1[3] *= bfhi(g.w);
                        if (MODE == EPI_MERGE_B) {
                            const u32x4 y = *(const u32x4*)(obase + (size_t)row * ldc + col);
                            v0[0] += bflo(y.x); v0[1] += bfhi(y.x); v0[2] += bflo(y.y); v0[3] += bfhi(y.y);
                            v1[0] += bflo(y.z); v1[1] += bfhi(y.z); v1[2] += bflo(y.w); v1[3] += bfhi(y.w);
                        }
                    }
                    if (MODE == EPI_OUTPROJ) {
                        const int b = row >> 12;
                        const float* gt = (const float*)(ws + WS_MOD) + b * 6144 + 2048 + col;
                        const float* xr = x + (size_t)row * 1024 + col;
                        const f32x4 g0 = *(const f32x4*)gt, g1 = *(const f32x4*)(gt + 4), x0 = *(const f32x4*)xr, x1 = *(const f32x4*)(xr + 4);
                        const f32x4 r0 = x0 + g0 * v0, r1 = x1 + g1 * v1;
                        u32x4 w; w.x = cvtpk(r0[0], r0[1]); w.y = cvtpk(r0[2], r0[3]); w.z = cvtpk(r1[0], r1[1]); w.w = cvtpk(r1[2], r1[3]);
                        *(u32x4*)((unsigned short*)(ws + WS_X1) + (size_t)row * 1024 + col) = w;
                    } else if (MODE == EPI_ROUTE && gab8) {
                        typedef unsigned u32x2_t __attribute__((ext_vector_type(2)));
#pragma unroll
                        for (int e = 0; e < 4; ++e) { v0[e] = fmaxf(v0[e], 0.015625f); v1[e] = fmaxf(v1[e], 0.015625f); }
                        int p0 = __builtin_amdgcn_cvt_pk_fp8_f32(v0[0], v0[1], 0, false); p0 = __builtin_amdgcn_cvt_pk_fp8_f32(v0[2], v0[3], p0, true);
                        int p1 = __builtin_amdgcn_cvt_pk_fp8_f32(v1[0], v1[1], 0, false); p1 = __builtin_amdgcn_cvt_pk_fp8_f32(v1[2], v1[3], p1, true);
                        *(u32x2_t*)((unsigned char*)obase + (size_t)row * 2048 + col) = (u32x2_t){(unsigned)p0, (unsigned)p1};
                    } else {
                        u32x4 w; w.x = cvt_pk_bf16(v0[0], v0[1]); w.y = cvt_pk_bf16(v0[2], v0[3]); w.z = cvt_pk_bf16(v1[0], v1[1]); w.w = cvt_pk_bf16(v1[2], v1[3]);
                        *(u32x4*)(obase + (size_t)row * ldc + col) = w;
                    }
                }
            }
    }
};

__device__ __forceinline__ void p0_transpose_item(const float* W, int K, int N, int pitch, unsigned short* WT, int row_off, float* scr, int item, int lane) {
    const int nblk = N / 32, kb = item / nblk, nb = item % nblk, k0 = 64 * kb, n0 = 32 * nb;
#pragma unroll 8
    for (int i = 0; i < 32; ++i) { const int kk = 2 * i + (lane >> 5); scr[kk * 33 + (lane & 31)] = W[(size_t)(k0 + kk) * pitch + n0 + (lane & 31)]; }
    LDS_WAIT(); asm volatile("" ::: "memory");
    const int c = lane & 7;
#pragma unroll
    for (int j = 0; j < 4; ++j) { const int n = (lane >> 3) + 8 * j; const float* s = scr + (8 * c) * 33 + n;
        v4u o; o.x = pk2(s[0 * 33], s[1 * 33]); o.y = pk2(s[2 * 33], s[3 * 33]); o.z = pk2(s[4 * 33], s[5 * 33]); o.w = pk2(s[6 * 33], s[7 * 33]);
        *(v4u*)(WT + (size_t)(row_off + n0 + n) * K + k0 + 8 * c) = o; }
    LDS_WAIT(); asm volatile("" ::: "memory");
}

__device__ __forceinline__ void p0_transpose_item_fp8(const float* W, int K, int N, int pitch, unsigned char* WT8, int row_off, float* scr, int item, int lane, float scale) {
    const int nblk = N / 32, kb = item / nblk, nb = item % nblk, k0 = 64 * kb, n0 = 32 * nb;
#pragma unroll 8
    for (int i = 0; i < 32; ++i) { const int kk = 2 * i + (lane >> 5); scr[kk * 33 + (lane & 31)] = W[(size_t)(k0 + kk) * pitch + n0 + (lane & 31)] * scale; }
    LDS_WAIT(); asm volatile("" ::: "memory");
    const int c = lane & 7;
#pragma unroll
    for (int j = 0; j < 4; ++j) { const int n = (lane >> 3) + 8 * j; const float* sp = scr + (8 * c) * 33 + n;
        typedef unsigned u32x2_t __attribute__((ext_vector_type(2)));
        int p0 = __builtin_amdgcn_cvt_pk_fp8_f32(sp[0 * 33], sp[1 * 33], 0, false); p0 = __builtin_amdgcn_cvt_pk_fp8_f32(sp[2 * 33], sp[3 * 33], p0, true);
        int p1 = __builtin_amdgcn_cvt_pk_fp8_f32(sp[4 * 33], sp[5 * 33], 0, false); p1 = __builtin_amdgcn_cvt_pk_fp8_f32(sp[6 * 33], sp[7 * 33], p1, true);
        *(u32x2_t*)(WT8 + (size_t)(row_off + n0 + n) * K + k0 + 8 * c) = (u32x2_t){(unsigned)p0, (unsigned)p1}; }
    LDS_WAIT(); asm volatile("" ::: "memory");
}
__device__ __forceinline__ void p0_cvt_item(const float* src, unsigned short* dst, size_t item, int lane) {
    const f32x4* s = (const f32x4*)(src + item * 512) + lane * 2;
    const f32x4 a = s[0], b = s[1];
    v4u o; o.x = pk2(a.x, a.y); o.y = pk2(a.z, a.w); o.z = pk2(b.x, b.y); o.w = pk2(b.z, b.w);
    *((v4u*)(dst + item * 512) + lane) = o;
}

__device__ __forceinline__ void p0_fp8_row(const float* src, unsigned char* dst, float* sc, int row, int lane) {
    const f32x4* sp = (const f32x4*)(src + (size_t)row * 1024) + lane * 4;
    f32x4 v[4]; float mx = 0.f;
#pragma unroll
    for (int j = 0; j < 4; ++j) { v[j] = sp[j]; mx = fmaxf(mx, fmaxf(fmaxf(fabsf(v[j].x), fabsf(v[j].y)), fmaxf(fabsf(v[j].z), fabsf(v[j].w)))); }
    mx = wave_max(mx);
    const float scale = mx > 0.f ? 240.0f / mx : 1.0f;
    if (lane == 0) sc[row] = mx > 0.f ? mx * (1.0f / 240.0f) : 1.0f;
    v4u o; unsigned w[4];
#pragma unroll
    for (int j = 0; j < 4; ++j) { int p = __builtin_amdgcn_cvt_pk_fp8_f32(v[j].x * scale, v[j].y * scale, 0, false); p = __builtin_amdgcn_cvt_pk_fp8_f32(v[j].z * scale, v[j].w * scale, p, true); w[j] = (unsigned)p; }
    o.x = w[0]; o.y = w[1]; o.z = w[2]; o.w = w[3];
    *((v4u*)(dst + (size_t)row * 1024) + lane) = o;
}

__device__ __forceinline__ void p0_fp4_row(const float* src, unsigned char* dst, float* sc, int row, int lane) {
    const f32x4* sp = (const f32x4*)(src + (size_t)row * 1024) + lane * 4;
    f32x4 v[4]; float mx = 0.f;
#pragma unroll
    for (int j = 0; j < 4; ++j) { v[j] = sp[j]; mx = fmaxf(mx, fmaxf(fmaxf(fabsf(v[j].x), fabsf(v[j].y)), fmaxf(fabsf(v[j].z), fabsf(v[j].w)))); }
    mx = wave_max(mx);
    const float scale = mx > 0.f ? 6.0f / mx : 1.0f;
    if (lane == 0) sc[row] = mx > 0.f ? mx * (1.0f / 6.0f) : 1.0f;
    unsigned w0 = 0u, w1 = 0u;
    w0 = __builtin_amdgcn_cvt_scalef32_pk_fp4_f32(w0, v[0].x * scale, v[0].y * scale, 1.0f, 0); w0 = __builtin_amdgcn_cvt_scalef32_pk_fp4_f32(w0, v[0].z * scale, v[0].w * scale, 1.0f, 1);
    w0 = __builtin_amdgcn_cvt_scalef32_pk_fp4_f32(w0, v[1].x * scale, v[1].y * scale, 1.0f, 2); w0 = __builtin_amdgcn_cvt_scalef32_pk_fp4_f32(w0, v[1].z * scale, v[1].w * scale, 1.0f, 3);
    w1 = __builtin_amdgcn_cvt_scalef32_pk_fp4_f32(w1, v[2].x * scale, v[2].y * scale, 1.0f, 0); w1 = __builtin_amdgcn_cvt_scalef32_pk_fp4_f32(w1, v[2].z * scale, v[2].w * scale, 1.0f, 1);
    w1 = __builtin_amdgcn_cvt_scalef32_pk_fp4_f32(w1, v[3].x * scale, v[3].y * scale, 1.0f, 2); w1 = __builtin_amdgcn_cvt_scalef32_pk_fp4_f32(w1, v[3].z * scale, v[3].w * scale, 1.0f, 3);
    typedef unsigned u32x2_t __attribute__((ext_vector_type(2)));
    *((u32x2_t*)(dst + (size_t)row * 512) + lane) = (u32x2_t){w0, w1};
}
__device__ __forceinline__ void p0_prologue(Frame& F) {
    if (blockIdx.x < 96) {
        float* sc = (float*)F.lds;
        float* red = (float*)(F.lds + 65536);
        const float* c = F.in[1]; const float* w_ada = F.in[2]; const float* b_ada = F.in[3];
        for (int i = F.tid; i < 16 * 1024; i += 512) { const float v = c[i]; sc[i] = v / (1.0f + __expf(-v)); }
        __syncthreads();
        const int n = blockIdx.x * 64 + F.lane;
        float acc[16];
#pragma unroll
        for (int b = 0; b < 16; ++b) acc[b] = 0.f;
        for (int k0 = F.wave * 128; k0 < F.wave * 128 + 128; k0 += 16) {
            float wv[16];
#pragma unroll
            for (int i = 0; i < 16; ++i) wv[i] = w_ada[(size_t)(k0 + i) * 6144 + n];
#pragma unroll
            for (int i = 0; i < 16; ++i)
#pragma unroll
                for (int b = 0; b < 16; ++b) acc[b] += sc[b * 1024 + k0 + i] * wv[i];
        }
#pragma unroll
        for (int b = 0; b < 16; ++b) red[(F.wave * 16 + b) * 64 + F.lane] = acc[b];
        __syncthreads();
        float* MOD = (float*)(F.ws + WS_MOD);
        for (int idx = F.tid; idx < 16 * 64; idx += 512) { const int b = idx >> 6, l = idx & 63; float s = b_ada[blockIdx.x * 64 + l];
#pragma unroll
            for (int w = 0; w < 8; ++w) s += red[(w * 16 + b) * 64 + l];
            MOD[b * 6144 + blockIdx.x * 64 + l] = s; }
        __syncthreads();
    }
    float* scr = (float*)(F.lds + F.wave * 16384);
#if PROJ_ALL_FP8
    for (int it = F.gw; it < 16 * 112 + 16 * 64; it += F.NGW) {
        if (it < 16 * 112) p0_transpose_item_fp8(F.in[5], 1024, 3584, IN_COLS, F.ws + WS_WINQ, 0, scr, it, F.lane, WQ_SCALE);
        else p0_transpose_item_fp8(F.in[5] + 3592, 1024, 2048, IN_COLS, F.ws + WS_WINQ, 3584, scr, it - 16 * 112, F.lane, WQ_SCALE);
    }
#else
    constexpr int I_B = 16 * 32, I_Q1 = 16 * 16, I_Q4 = 16 * 64;
    for (int it = F.gw; it < 2 * I_B + 3 * I_Q1 + I_Q4; it += F.NGW) {
        int r = it;
        if (r < I_B) { p0_transpose_item(F.in[5], 1024, 1024, IN_COLS, (unsigned short*)(F.ws + WS_WIN), 0, scr, r, F.lane); continue; } r -= I_B;
        if (r < I_B) { p0_transpose_item(F.in[5] + 1536, 1024, 1024, IN_COLS, (unsigned short*)(F.ws + WS_WIN), 1024, scr, r, F.lane); continue; } r -= I_B;
        if (r < I_Q1) { p0_transpose_item_fp8(F.in[5] + 1024, 1024, 512, IN_COLS, F.ws + WS_WINQ, 0, scr, r, F.lane, WQ_SCALE); continue; } r -= I_Q1;
        if (r < I_Q1) { p0_transpose_item_fp8(F.in[5] + 2560, 1024, 512, IN_COLS, F.ws + WS_WINQ, 512, scr, r, F.lane, WQ_SCALE); continue; } r -= I_Q1;
        if (r < I_Q1) { p0_transpose_item_fp8(F.in[5] + 3072, 1024, 512, IN_COLS, F.ws + WS_WINQ, 1024, scr, r, F.lane, WQ_SCALE); continue; } r -= I_Q1;
        p0_transpose_item_fp8(F.in[5] + 3592, 1024, 2048, IN_COLS, F.ws + WS_WINQ, 1536, scr, r, F.lane, WQ_SCALE);
    }
#endif
    { float* W8 = (float*)(F.ws + WS_W8); const int g = blockIdx.x * 512 + F.tid; if (g < 8192) { const int j = g >> 10, k = g & 1023; W8[g] = F.in[5][(size_t)k * IN_COLS + 3584 + j]; } }
}

__device__ __forceinline__ void late_weight_copies(Frame& F, int w0, int nw) {
    float* scr = (float*)(F.lds + F.wave * 16384);
    constexpr int I_A = 8 * 32, I_B = 8 * 32, I_O = 16 * 32, I_PQ = 16 * 64;
    for (int it = w0; it < I_A + I_B + I_O + I_PQ; it += nw) {
        int r = it;
        if (r < I_A) { p0_transpose_item(F.in[12], 512, 1024, 1024, (unsigned short*)(F.ws + WS_WA), 0, scr, r, F.lane); continue; } r -= I_A;
        if (r < I_B) { p0_transpose_item(F.in[13], 512, 1024, 1024, (unsigned short*)(F.ws + WS_WB), 0, scr, r, F.lane); continue; } r -= I_B;
        if (r < I_O) { p0_transpose_item(F.in[14], 1024, 1024, 1024, (unsigned short*)(F.ws + WS_WOUT), 0, scr, r, F.lane); continue; } r -= I_O;
        p0_transpose_item(F.in[16], 1024, 2048, 2048, (unsigned short*)(F.ws + WS_WPQ), 0, scr, r, F.lane);
    }
    for (int it = w0; it < 262144 / 512; it += nw) p0_cvt_item(F.in[17], (unsigned short*)(F.ws + WS_SUBK), (size_t)it, F.lane);
    for (int it = w0; it < 2 * 16384; it += nw) {
        if (it < 16384) p0_fp4_row(F.in[18], F.ws + WS_U, (float*)(F.ws + WS_USC), it, F.lane);
        else p0_fp4_row(F.in[19], F.ws + WS_V, (float*)(F.ws + WS_VSC), it - 16384, F.lane);
    }
}

template <bool WITH_GATES, bool BF16_IN = false>
__device__ __forceinline__ void norm_mod_rows(Frame& F, const float* xin, const float* gvec, int sh_off, int sc_off, unsigned short* hout) {
    const float* MOD = (const float*)(F.ws + WS_MOD);
    const float* W8 = (const float*)(F.ws + WS_W8);
    LAS float* w8l = (LAS float*)F.lds;
    if (WITH_GATES) { for (int i = F.tid; i < 8192; i += 512) w8l[i] = W8[i]; __syncthreads(); }
    const int RPW = T / F.NGW;
    const int row0 = F.gw * RPW, b = row0 >> 12;
    LAS f32x4* GmL = (LAS f32x4*)(w8l + 8192); LAS f32x4* ShL = GmL + 256;
    if (F.tid < 256) { const f32x4 g = ((const f32x4*)gvec)[F.tid], sc = ((const f32x4*)(MOD + b * 6144 + sc_off))[F.tid]; GmL[F.tid] = g * (sc + 1.0f); ShL[F.tid] = ((const f32x4*)(MOD + b * 6144 + sh_off))[F.tid]; }
    __syncthreads();
    for (int rg = 0; rg < RPW; rg += 4) {
        f32x4 v[4][4];
#pragma unroll
        for (int r = 0; r < 4; ++r) {
            if (BF16_IN) { typedef unsigned u32x2_t __attribute__((ext_vector_type(2)));
                const u32x2_t* xr = (const u32x2_t*)((const unsigned short*)xin + (size_t)(row0 + rg + r) * 1024) + F.lane;
#pragma unroll
                for (int j = 0; j < 4; ++j) { const u32x2_t w = xr[64 * j]; v[r][j] = (f32x4){bflo(w.x), bfhi(w.x), bflo(w.y), bfhi(w.y)}; }
            } else { const f32x4* xr = (const f32x4*)(xin + (size_t)(row0 + rg + r) * 1024) + F.lane;
#pragma unroll
                for (int j = 0; j < 4; ++j) v[r][j] = xr[64 * j]; } }
#pragma unroll
        for (int r = 0; r < 4; ++r) {
            __builtin_amdgcn_sched_barrier(0);
            const int row = row0 + rg + r;
            float s = 0.f;
#pragma unroll
            for (int j = 0; j < 4; ++j) s += (v[r][j].x * v[r][j].x + v[r][j].y * v[r][j].y) + (v[r][j].z * v[r][j].z + v[r][j].w * v[r][j].w);
            const float rstd = rsqrtf(wave_sum_u(s) * (1.0f / 1024.0f) + EPS);
            float gd[8];
#pragma unroll
            for (int q = 0; q < 8; ++q) gd[q] = 0.f;
            unsigned long long* o8 = (unsigned long long*)(hout + (size_t)row * 1024) + F.lane;
#pragma unroll
            for (int j = 0; j < 4; ++j) {
                const int k4 = F.lane + 64 * j;
                const f32x4 h = (v[r][j] * rstd) * GmL[k4] + ShL[k4];
                if (WITH_GATES) {
#pragma unroll
                    for (int q = 0; q < 8; ++q) { const f32x4 w = ((const LAS f32x4*)(w8l + q * 1024))[k4]; gd[q] += (h.x * w.x + h.y * w.y) + (h.z * w.z + h.w * w.w); }
                }
                if (!(WITH_GATES && PROJ_ALL_FP8)) o8[64 * j] = (unsigned long long)pk2(h.x, h.y) | ((unsigned long long)pk2(h.z, h.w) << 32);
                if (WITH_GATES) { int p8 = __builtin_amdgcn_cvt_pk_fp8_f32(h.x, h.y, 0, false); p8 = __builtin_amdgcn_cvt_pk_fp8_f32(h.z, h.w, p8, true);
                    ((unsigned*)(F.ws + WS_H1Q + (size_t)row * 1024))[k4] = (unsigned)p8; }
            }
            if (WITH_GATES) {
#pragma unroll
                for (int q = 0; q < 8; ++q) gd[q] = wave_sum_u(gd[q]);
                if (F.lane == 0) { float* G = (float*)(F.ws + WS_GATES) + (size_t)row * 8;
#pragma unroll
                    for (int q = 0; q < 8; ++q) G[q] = gd[q] + (q < 4 ? F.in[8][q] : F.in[9][q - 4]); }
            }
        }
    }
}

__device__ __forceinline__ void attn_ref_item(Frame& F, int t, int h) {
    const unsigned short* QKVA = (const unsigned short*)(F.ws + WS_QKVA);
    const float* rel_bias = F.in[10];
    const int lane = F.lane, b = t >> 12, pos = t & 4095, j = pos >> 6;
    const v4u* qrow = (const v4u*)(QKVA + (size_t)t * 1536 + h * 64);
    v4u qv[8];
#pragma unroll
    for (int i = 0; i < 8; ++i) qv[i] = qrow[i];
    float s[9]; float m = -INFINITY;
#pragma unroll
    for (int c = 0; c < 9; ++c) {
        const int kc = j - 8 + c; s[c] = -INFINITY;
        if (kc >= 0) {
            const int kpos = kc * 64 + lane;
            const v4u* krow = (const v4u*)(QKVA + (size_t)(b * 4096 + kpos) * 1536 + 512 + h * 64);
            float d = 0.f;
#pragma unroll
            for (int i = 0; i < 8; ++i) { const v4u kv = krow[i]; d = dot2c(d, qv[i].x, kv.x); d = dot2c(d, qv[i].y, kv.y); d = dot2c(d, qv[i].z, kv.z); d = dot2c(d, qv[i].w, kv.w); }
            int rel = pos - kpos; rel = rel > 128 ? 128 : rel;
            s[c] = d * 0.125f + rel_bias[h * 257 + rel + 128];
            m = fmaxf(m, s[c]);
        }
    }
    m = wave_max(m);
    float l = 0.f;
#pragma unroll
    for (int c = 0; c < 9; ++c) { s[c] = (j - 8 + c >= 0) ? __expf(s[c] - m) : 0.f; l += s[c]; }
    l = wave_sum(l);
    float o = 0.f;
#pragma unroll
    for (int c = 0; c < 9; ++c) {
        const int kc = j - 8 + c;
        if (kc >= 0) {
            const unsigned short* vcol = QKVA + (size_t)(b * 4096 + kc * 64) * 1536 + 1024 + h * 64 + lane;
#pragma unroll 8
            for (int kk = 0; kk < 64; ++kk) { const float pk = __shfl(s[c], kk); o += pk * bf2f(vcol[(size_t)kk * 1536]); }
        }
    }
    ((unsigned short*)(F.ws + WS_YA))[(size_t)t * 512 + h * 64 + lane] = (unsigned short)f2bf(o / l);
}


constexpr int AT_KP = 144, AT_VP = 136;
constexpr int AT_K0 = 0, AT_V0 = 2 * 64 * AT_KP, AT_BIAS = AT_V0 + 2 * 64 * AT_VP;
__device__ __forceinline__ void attn_unit(Frame& F, int b, int h, int j0) {
    const unsigned short* QKVA = (const unsigned short*)(F.ws + WS_QKVA);
    LAS unsigned char* L = (LAS unsigned char*)F.lds;
    LAS float* biasL = (LAS float*)(L + AT_BIAS);
    const int tid = F.tid, lane = F.lane, wave = F.wave, hh = lane >> 5, q32 = lane & 31;
    const int c = j0 + (wave >> 1), qi = 32 * (wave & 1) + q32;
    const size_t tq = (size_t)b * SEQ + c * 64 + qi;
    constexpr float LOG2E = 1.4426950408889634f, C2 = 0.125f * LOG2E;
    if (tid < 257) biasL[tid] = F.in[10][h * 257 + tid] * LOG2E;
    bf16x8 qf[4];
#pragma unroll
    for (int s = 0; s < 4; ++s) qf[s] = *(const bf16x8*)(QKVA + tq * 1536 + h * 64 + 16 * s + 8 * hh);
    const int kc_lo = (j0 - 8 > 0) ? j0 - 8 : 0, nsteps = j0 + 3 - kc_lo + 1;
    const int skey = tid >> 3, sch = tid & 7;
    const unsigned short* ksrc = QKVA + ((size_t)b * SEQ + skey) * 1536 + 512 + h * 64 + sch * 8;
    v4u kreg = *(const v4u*)(ksrc + (size_t)kc_lo * 64 * 1536), vreg = *(const v4u*)(ksrc + (size_t)kc_lo * 64 * 1536 + 512);
    auto stage_write = [&](int buf) {
        *(LAS v4u*)(L + AT_K0 + buf * 64 * AT_KP + skey * AT_KP + sch * 16) = kreg;
        LAS unsigned short* vt = (LAS unsigned short*)(L + AT_V0 + buf * 64 * AT_VP) + skey;
        const unsigned w[4] = {vreg.x, vreg.y, vreg.z, vreg.w};
#pragma unroll
        for (int j = 0; j < 4; ++j) { vt[(8 * sch + 2 * j) * (AT_VP / 2)] = (unsigned short)(w[j] & 0xffffu); vt[(8 * sch + 2 * j + 1) * (AT_VP / 2)] = (unsigned short)(w[j] >> 16); }
    };
    stage_write(0);
    __syncthreads();
    float m_run = -INFINITY, l_run = 0.f;
    f32x16 o0 = {}, o1 = {};
    for (int i = 0; i < nsteps; ++i) {
        const int kc = kc_lo + i, buf = i & 1;
        if (i + 1 < nsteps) { kreg = *(const v4u*)(ksrc + (size_t)(kc + 1) * 64 * 1536); vreg = *(const v4u*)(ksrc + (size_t)(kc + 1) * 64 * 1536 + 512); }
        const int dch = c - kc;
        if (dch >= 0 && dch <= 8) {
            const LAS unsigned char* Kb = L + AT_K0 + buf * 64 * AT_KP + q32 * AT_KP + 16 * hh;
            f32x16 p0 = {}, p1 = {};
#pragma unroll
            for (int s = 0; s < 4; ++s) {
                const bf16x8 a0 = *(const LAS bf16x8*)(Kb + 32 * s), a1 = *(const LAS bf16x8*)(Kb + 32 * AT_KP + 32 * s);
                p0 = __builtin_amdgcn_mfma_f32_32x32x16_bf16(a0, qf[s], p0, 0, 0, 0);
                p1 = __builtin_amdgcn_mfma_f32_32x32x16_bf16(a1, qf[s], p1, 0, 0, 0);
            }
            float mx = -INFINITY;
            if (dch >= 3) {
                const float bc = biasL[256];
#pragma unroll
                for (int r = 0; r < 16; ++r) { p0[r] = p0[r] * C2 + bc; p1[r] = p1[r] * C2 + bc; mx = fmaxf(mx, fmaxf(p0[r], p1[r])); }
            } else {
                const int base = dch * 64 + qi - 4 * hh + 128;
#pragma unroll
                for (int r = 0; r < 16; ++r) { const int ki = (r & 3) + 8 * (r >> 2);
                    int i0 = base - ki, i1 = base - ki - 32; i0 = i0 > 256 ? 256 : i0; i1 = i1 > 256 ? 256 : i1;
                    p0[r] = p0[r] * C2 + biasL[i0]; p1[r] = p1[r] * C2 + biasL[i1]; mx = fmaxf(mx, fmaxf(p0[r], p1[r])); }
            }
            mx = fmaxf(mx, __shfl_xor(mx, 32));
            const float m_new = fmaxf(m_run, mx), alpha = __builtin_amdgcn_exp2f(m_run - m_new);
            m_run = m_new;
            float ls = 0.f;
#pragma unroll
            for (int r = 0; r < 16; ++r) { p0[r] = __builtin_amdgcn_exp2f(p0[r] - m_new); p1[r] = __builtin_amdgcn_exp2f(p1[r] - m_new); ls += p0[r] + p1[r]; }
            l_run = l_run * alpha + ls;
#pragma unroll
            for (int r = 0; r < 16; ++r) { o0[r] *= alpha; o1[r] *= alpha; }
            const LAS unsigned char* Vb = L + AT_V0 + buf * 64 * AT_VP + q32 * AT_VP + 8 * hh;
#pragma unroll
            for (int tt = 0; tt < 2; ++tt)
#pragma unroll
                for (int s = 0; s < 2; ++s) {
                    v4u pb;
                    if (tt == 0) { pb.x = cvtpk(p0[8 * s + 0], p0[8 * s + 1]); pb.y = cvtpk(p0[8 * s + 2], p0[8 * s + 3]); pb.z = cvtpk(p0[8 * s + 4], p0[8 * s + 5]); pb.w = cvtpk(p0[8 * s + 6], p0[8 * s + 7]); }
                    else { pb.x = cvtpk(p1[8 * s + 0], p1[8 * s + 1]); pb.y = cvtpk(p1[8 * s + 2], p1[8 * s + 3]); pb.z = cvtpk(p1[8 * s + 4], p1[8 * s + 5]); pb.w = cvtpk(p1[8 * s + 6], p1[8 * s + 7]); }
                    const bf16x8 bfrag = __builtin_bit_cast(bf16x8, pb);
                    const int koff = (32 * tt + 16 * s) * 2;
#pragma unroll
                    for (int et = 0; et < 2; ++et) {
                        typedef unsigned u32x2_t __attribute__((ext_vector_type(2)));
                        const u32x2_t lo = *(const LAS u32x2_t*)(Vb + et * 32 * AT_VP + koff), hi2 = *(const LAS u32x2_t*)(Vb + et * 32 * AT_VP + koff + 16);
                        v4u av; av.x = lo.x; av.y = lo.y; av.z = hi2.x; av.w = hi2.y;
                        const bf16x8 afrag = __builtin_bit_cast(bf16x8, av);
                        if (et == 0) o0 = __builtin_amdgcn_mfma_f32_32x32x16_bf16(afrag, bfrag, o0, 0, 0, 0);
                        else o1 = __builtin_amdgcn_mfma_f32_32x32x16_bf16(afrag, bfrag, o1, 0, 0, 0);
                    }
                }
        }
        if (i + 1 < nsteps) stage_write(buf ^ 1);
        __syncthreads();
    }
    const float lt = l_run + __shfl_xor(l_run, 32), inv = 1.0f / lt;
    unsigned short* yrow = (unsigned short*)(F.ws + WS_YA) + tq * 512 + h * 64 + 4 * hh;
#pragma unroll
    for (int g = 0; g < 4; ++g) {
        typedef unsigned u32x2_t __attribute__((ext_vector_type(2)));
        u32x2_t w0, w1;
        w0.x = cvtpk(o0[4 * g] * inv, o0[4 * g + 1] * inv); w0.y = cvtpk(o0[4 * g + 2] * inv, o0[4 * g + 3] * inv);
        w1.x = cvtpk(o1[4 * g] * inv, o1[4 * g + 1] * inv); w1.y = cvtpk(o1[4 * g + 2] * inv, o1[4 * g + 3] * inv);
        *(u32x2_t*)(yrow + 8 * g) = w0; *(u32x2_t*)(yrow + 32 + 8 * g) = w1;
    }
}


__device__ __forceinline__ void qk_conv_slice(Frame& F, int b, int h) {
    const unsigned short* QKB = (const unsigned short*)(F.ws + WS_QKB);
    unsigned short* QKC = (unsigned short*)(F.ws + WS_QKC);
    const int cg = F.tid & 31, cgp = (cg < 16 ? 16 * h + cg : 64 + 16 * h + (cg - 16));
    float wv[4][8], bv[8];
#pragma unroll
    for (int jj = 0; jj < 4; ++jj)
#pragma unroll
        for (int c = 0; c < 8; ++c) wv[jj][c] = F.in[6][jj * 1024 + 8 * cgp + c];
#pragma unroll
    for (int c = 0; c < 8; ++c) bv[c] = F.in[7][8 * cgp + c];
    const float osc = (cgp >= 64) ? 0.08838834764831845f : 1.0f;
    for (int rq4 = F.tid >> 5; rq4 < SEQ / 4; rq4 += 16) {
        const size_t r0 = (size_t)b * SEQ + rq4 * 4; const int pos0 = rq4 * 4;
        v4u rq[7];
#pragma unroll
        for (int r = 0; r < 7; ++r) rq[r] = (pos0 - 3 + r >= 0) ? *(const v4u*)(QKB + (r0 - 3 + r) * 1024 + 8 * cgp) : (v4u){0u, 0u, 0u, 0u};
#pragma unroll
        for (int i = 0; i < 4; ++i) {
            float o[8];
#pragma unroll
            for (int c = 0; c < 8; ++c) o[c] = bv[c];
#pragma unroll
            for (int jj = 0; jj < 4; ++jj) { const v4u u = rq[i + jj]; const unsigned w[4] = {u.x, u.y, u.z, u.w};
#pragma unroll
                for (int c2 = 0; c2 < 4; ++c2) { o[2 * c2] += wv[jj][2 * c2] * bflo(w[c2]); o[2 * c2 + 1] += wv[jj][2 * c2 + 1] * bfhi(w[c2]); } }
#pragma unroll
            for (int c = 0; c < 8; ++c) o[c] = osc * o[c] / (1.0f + __expf(-o[c]));
            v4u w; w.x = cvtpk(o[0], o[1]); w.y = cvtpk(o[2], o[3]); w.z = cvtpk(o[4], o[5]); w.w = cvtpk(o[6], o[7]);
            *(v4u*)(QKC + (r0 + i) * 1024 + 8 * cgp) = w;
        }
    }
    asm volatile("s_waitcnt vmcnt(0)" ::: "memory");
    __syncthreads();
}
__device__ __forceinline__ void qk_conv_pass(Frame& F) {
    const unsigned short* QKB = (const unsigned short*)(F.ws + WS_QKB);
    unsigned short* QKC = (unsigned short*)(F.ws + WS_QKC);
    const int gtid = blockIdx.x * 512 + F.tid, cgp = gtid & 127, NTH = F.G * 512;
    float wv[4][8], bv[8];
#pragma unroll
    for (int jj = 0; jj < 4; ++jj)
#pragma unroll
        for (int c = 0; c < 8; ++c) wv[jj][c] = F.in[6][jj * 1024 + 8 * cgp + c];
#pragma unroll
    for (int c = 0; c < 8; ++c) bv[c] = F.in[7][8 * cgp + c];
    const float osc = (cgp >= 64) ? 0.08838834764831845f : 1.0f;
    for (int it = gtid; it < (T / 4) * 128; it += NTH) {
        const int rq4 = it >> 7; const size_t r0 = (size_t)rq4 * 4; const int pos0 = (int)(r0 & 4095);
        v4u rq[7];
#pragma unroll
        for (int r = 0; r < 7; ++r) rq[r] = (pos0 - 3 + r >= 0) ? *(const v4u*)(QKB + (r0 - 3 + r) * 1024 + 8 * cgp) : (v4u){0u, 0u, 0u, 0u};
#pragma unroll
        for (int i = 0; i < 4; ++i) {
            float o[8];
#pragma unroll
            for (int c = 0; c < 8; ++c) o[c] = bv[c];
#pragma unroll
            for (int jj = 0; jj < 4; ++jj) { const v4u u = rq[i + jj]; const unsigned w[4] = {u.x, u.y, u.z, u.w};
#pragma unroll
                for (int c2 = 0; c2 < 4; ++c2) { o[2 * c2] += wv[jj][2 * c2] * bflo(w[c2]); o[2 * c2 + 1] += wv[jj][2 * c2 + 1] * bfhi(w[c2]); } }
#pragma unroll
            for (int c = 0; c < 8; ++c) o[c] = osc * o[c] / (1.0f + __expf(-o[c]));
            v4u w; w.x = cvtpk(o[0], o[1]); w.y = cvtpk(o[2], o[3]); w.z = cvtpk(o[4], o[5]); w.w = cvtpk(o[6], o[7]);
            *(v4u*)(QKC + (r0 + i) * 1024 + 8 * cgp) = w;
        }
    }
}


constexpr int ML_QS = 0, ML_KS = 17408, ML_KWS = 34816, ML_VS = 55296, ML_CT = 75776, ML_YT = 110592, ML_SC = 128000, ML_N = 130688, ML_HSQ = 131712, ML_NG = 132224, ML_QN = 132736, ML_PB = 133120, ML_DSP = 139264;
constexpr int ML_SCF = 336;
constexpr int ML_P = 272, ML_PT = 320;
typedef short s16x4_t __attribute__((ext_vector_type(4)));
__device__ __forceinline__ bf16x8 tr_frag(const LAS unsigned char* tile, int pitch, int rowA, int rowB, int colblk, int lane) {
    const int q = (lane & 15) >> 2, p = lane & 3, ch = (lane >> 4) & 1;
    const LAS unsigned char* a = tile + (rowA + q) * pitch + (colblk + 16 * ch + 4 * p) * 2;
    const LAS unsigned char* c = tile + (rowB + q) * pitch + (colblk + 16 * ch + 4 * p) * 2;
    const s16x4_t lo = __builtin_bit_cast(s16x4_t, __builtin_amdgcn_ds_read_tr16_b64_v4i16((LAS s16x4_t*)a));
    const s16x4_t hi = __builtin_bit_cast(s16x4_t, __builtin_amdgcn_ds_read_tr16_b64_v4i16((LAS s16x4_t*)c));
    return (bf16x8){lo[0], lo[1], lo[2], lo[3], hi[0], hi[1], hi[2], hi[3]};
}
__device__ __forceinline__ void mlstm_unit(Frame& F, int b, int h) {
    LAS unsigned char* L = (LAS unsigned char*)F.lds;
    const unsigned short* VB = (const unsigned short*)(F.ws + WS_VB);
    const unsigned short* OB = (const unsigned short*)(F.ws + WS_OB);
    unsigned short* YB = (unsigned short*)(F.ws + WS_YB);
    const float* GATES = (const float*)(F.ws + WS_GATES);
    const float* ng = F.in[11];
    const int tid = F.tid, lane = F.lane, wave = F.wave, hh = lane >> 5, q32 = lane & 31;
    const int et = wave >> 1, lt = wave & 1, eb = wave & 3, dbp = wave >> 2;
    LAS float* SC = (LAS float*)(L + ML_SC);
    LAS float* NV = (LAS float*)(L + ML_N);
    LAS float* HSQ = (LAS float*)(L + ML_HSQ);
    for (int i = tid; i < 34816 / 4; i += 512) ((LAS unsigned*)(L + ML_CT))[i] = 0u;
    if (tid < 256) NV[tid] = 0.f;
    if (tid < 128) { HSQ[tid] = 0.f; ((LAS float*)(L + ML_NG))[tid] = ng[h * 128 + tid]; }
    f32x16 accC0 = {}, accC1 = {};
    float m_state = 0.f;
    const int sl = tid >> 3, sp = tid & 7;
    const size_t rowb = (size_t)b * SEQ;
    const unsigned short* QKC = (const unsigned short*)(F.ws + WS_QKC);
    const unsigned short* qsrc = QKC + h * 128 + 8 * sp;
    const unsigned short* vsrc = VB + h * 128 + 8 * sp;
    const int fr = tid >> 4, fc = tid & 15;
    v4u rq[2], rk[2], rv[2], rob[2]; float gi = 0.f, gf = 0.f;
    auto load_raw = [&](int j) {
        const size_t tr = rowb + 64 * j + sl;
#pragma unroll
        for (int i = 0; i < 2; ++i) { rq[i] = *(const v4u*)(qsrc + tr * 1024 + 64 * i); rk[i] = *(const v4u*)(qsrc + tr * 1024 + 512 + 64 * i); rv[i] = *(const v4u*)(vsrc + tr * 512 + 64 * i); }
        if (wave == 0) { const float* gp = GATES + (rowb + 64 * j + lane) * 8; gi = gp[h]; gf = gp[4 + h]; }
    };
    auto load_ob = [&](int j) {
#pragma unroll
        for (int i = 0; i < 2; ++i) rob[i] = *(const v4u*)(OB + (rowb + 64 * j + fr + 32 * i) * 512 + h * 128 + 8 * fc);
    };
    auto flush = [&](int j) {
#pragma unroll
        for (int i = 0; i < 2; ++i) { const int r = fr + 32 * i;
            const v4u y = *(const LAS v4u*)(L + ML_YT + r * ML_P + fc * 16); const v4u o = rob[i]; v4u w;
            w.x = cvtpk(bflo(y.x) * bflo(o.x), bfhi(y.x) * bfhi(o.x)); w.y = cvtpk(bflo(y.y) * bflo(o.y), bfhi(y.y) * bfhi(o.y));
            w.z = cvtpk(bflo(y.z) * bflo(o.z), bfhi(y.z) * bfhi(o.z)); w.w = cvtpk(bflo(y.w) * bflo(o.w), bfhi(y.w) * bfhi(o.w));
            *(v4u*)(YB + (rowb + 64 * j + r) * 512 + h * 128 + 8 * fc) = w; }
    };
    auto gates_compute = [&](int buf) {
        LAS float* sc = SC + buf * ML_SCF;
        const float li = gi, lf = fminf(gf, 0.f) - log1pf(__expf(-fabsf(gf)));
        const float a = scan_sum64(lf);
        const float A = lane63(a);
        const float g = A - a + li;
        const float gmax = lane63(scan_max64(g));
        const float m_new = fmaxf(A + m_state, gmax);
        const float ws = li - a;
        const float pm = scan_max64(ws);
        const float mrow = a + fmaxf(m_state, pm);
        sc[lane] = __expf(g - m_new); sc[64 + lane] = ws * 1.4426950408889634f; sc[128 + lane] = (a - mrow) * 1.4426950408889634f; sc[192 + lane] = __expf(a + m_state - mrow); sc[256 + lane] = __expf(-mrow);
        if (lane == 0) sc[320] = __expf(A + m_state - m_new);
        m_state = m_new;
    };
    load_raw(0);
    if (wave == 0) gates_compute(0);
    __syncthreads();
    for (int j = 0; j < 64; ++j) {
        const int cur = j & 1;
        LAS float* sc = SC + cur * ML_SCF;
        {
            LAS float* nq = NV + cur * 128;
            float qp = 0.f;
#pragma unroll
            for (int i = 0; i < 2; ++i) { const f32x4 n0 = *(const LAS f32x4*)(nq + 64 * i + 8 * sp), n1 = *(const LAS f32x4*)(nq + 64 * i + 8 * sp + 4);
                qp += bflo(rq[i].x) * n0.x + bfhi(rq[i].x) * n0.y + bflo(rq[i].y) * n0.z + bfhi(rq[i].y) * n0.w + bflo(rq[i].z) * n1.x + bfhi(rq[i].z) * n1.y + bflo(rq[i].w) * n1.z + bfhi(rq[i].w) * n1.w; }
            qp += __shfl_xor(qp, 1); qp += __shfl_xor(qp, 2); qp += __shfl_xor(qp, 4);
            if (sp == 0) ((LAS float*)(L + ML_QN))[sl] = qp;
        }
        {
            const float wk = sc[sl];
#pragma unroll
            for (int i = 0; i < 2; ++i) {
                *(LAS v4u*)(L + ML_QS + sl * ML_P + (sp + 8 * i) * 16) = rq[i];
                *(LAS v4u*)(L + ML_KS + sl * ML_P + (sp + 8 * i) * 16) = rk[i];
                v4u kw; kw.x = cvtpk(bflo(rk[i].x) * wk, bfhi(rk[i].x) * wk); kw.y = cvtpk(bflo(rk[i].y) * wk, bfhi(rk[i].y) * wk); kw.z = cvtpk(bflo(rk[i].z) * wk, bfhi(rk[i].z) * wk); kw.w = cvtpk(bflo(rk[i].w) * wk, bfhi(rk[i].w) * wk);
                *(LAS v4u*)(L + ML_KWS + sl * ML_PT + (sp + 8 * i) * 16) = kw;
                *(LAS v4u*)(L + ML_VS + sl * ML_PT + (sp + 8 * i) * 16) = rv[i];
            }
        }
        if (j < 63) load_raw(j + 1);
        if (j > 0) load_ob(j - 1);
        __syncthreads();
        const int l = 32 * lt + q32;
        const float u_l = sc[128 + l], wi_l = sc[192 + l], fl_l = sc[256 + l], decay = sc[320];
        LAS float* nold = NV + cur * 128; LAS float* nnew = NV + (cur ^ 1) * 128;
        const float qn = ((const LAS float*)(L + ML_QN))[l];
        const LAS unsigned char* Qb = L + ML_QS + l * ML_P + 16 * hh;
#if ML_SHARE_P
        {
            const int sst = (wave == 3) ? 1 : 0;
            if (wave == 4 || wave == 1 || wave == 3) {
                const int blk = (wave == 4) ? 0 : 1 + sst;
                f32x16 sa = {};
                const LAS unsigned char* Kb = L + ML_KS + (32 * sst + q32) * ML_P + 16 * hh;
#pragma unroll
                for (int ks = 0; ks < 8; ++ks) sa = __builtin_amdgcn_mfma_f32_32x32x16_bf16(*(const LAS bf16x8*)(Kb + 32 * ks), *(const LAS bf16x8*)(Qb + 32 * ks), sa, 0, 0, 0);
                float ds = 0.f;
                const bool full = (wave == 1);
#pragma unroll
                for (int g4 = 0; g4 < 4; ++g4) { const f32x4 w4 = *(const LAS f32x4*)(sc + 64 + 32 * sst + 8 * g4 + 4 * hh); const float wv[4] = {w4.x, w4.y, w4.z, w4.w};
#pragma unroll
                    for (int rr = 0; rr < 4; ++rr) { const int r = 4 * g4 + rr, sidx = 32 * sst + rr + 8 * g4 + 4 * hh;
                        const float e = sa[r] * __builtin_amdgcn_exp2f(u_l + wv[rr]);
                        const float p = (full || sidx <= l) ? e : 0.f; sa[r] = p; ds += p; } }
                ds += __shfl_xor(ds, 32);
#pragma unroll
                for (int s2 = 0; s2 < 2; ++s2) { v4u pbw; pbw.x = cvtpk(sa[8 * s2 + 0], sa[8 * s2 + 1]); pbw.y = cvtpk(sa[8 * s2 + 2], sa[8 * s2 + 3]); pbw.z = cvtpk(sa[8 * s2 + 4], sa[8 * s2 + 5]); pbw.w = cvtpk(sa[8 * s2 + 6], sa[8 * s2 + 7]);
                    *(LAS v4u*)(L + ML_PB + blk * 2048 + s2 * 1024 + lane * 16) = pbw; }
                if (hh == 0) ((LAS float*)(L + ML_DSP))[blk * 32 + q32] = ds;
            }
        }
        f32x16 accH = {};
        { const LAS unsigned char* Cb = L + ML_CT + (32 * et + q32) * ML_P + 16 * hh;
#pragma unroll
          for (int ks = 0; ks < 8; ++ks) accH = __builtin_amdgcn_mfma_f32_32x32x16_bf16(*(const LAS bf16x8*)(Cb + 32 * ks), *(const LAS bf16x8*)(Qb + 32 * ks), accH, 0, 0, 0); }
#pragma unroll
        for (int r = 0; r < 16; ++r) accH[r] *= wi_l;
#else
        float dsum = 0.f;
        v4u pb[2][2];
#pragma unroll
        for (int st = 0; st < 2; ++st) {
            if (st <= lt) {
                f32x16 sa = {};
                const LAS unsigned char* Kb = L + ML_KS + (32 * st + q32) * ML_P + 16 * hh;
#pragma unroll
                for (int ks = 0; ks < 8; ++ks) sa = __builtin_amdgcn_mfma_f32_32x32x16_bf16(*(const LAS bf16x8*)(Kb + 32 * ks), *(const LAS bf16x8*)(Qb + 32 * ks), sa, 0, 0, 0);
#pragma unroll
                for (int r = 0; r < 16; ++r) { const int sidx = 32 * st + (r & 3) + 8 * (r >> 2) + 4 * hh;
                    const float p = (sidx <= l) ? sa[r] * __builtin_amdgcn_exp2f(u_l + sc[64 + sidx]) : 0.f; sa[r] = p; dsum += p; }
#pragma unroll
                for (int s2 = 0; s2 < 2; ++s2) { pb[st][s2].x = cvtpk(sa[8 * s2 + 0], sa[8 * s2 + 1]); pb[st][s2].y = cvtpk(sa[8 * s2 + 2], sa[8 * s2 + 3]); pb[st][s2].z = cvtpk(sa[8 * s2 + 4], sa[8 * s2 + 5]); pb[st][s2].w = cvtpk(sa[8 * s2 + 6], sa[8 * s2 + 7]); }
            }
        }
        dsum += __shfl_xor(dsum, 32);
        f32x16 accH = {};
        { const LAS unsigned char* Cb = L + ML_CT + (32 * et + q32) * ML_P + 16 * hh;
#pragma unroll
          for (int ks = 0; ks < 8; ++ks) accH = __builtin_amdgcn_mfma_f32_32x32x16_bf16(*(const LAS bf16x8*)(Cb + 32 * ks), *(const LAS bf16x8*)(Qb + 32 * ks), accH, 0, 0, 0); }
#pragma unroll
        for (int r = 0; r < 16; ++r) accH[r] *= wi_l;
#pragma unroll
        for (int st = 0; st < 2; ++st) {
            if (st <= lt) {
#pragma unroll
                for (int s2 = 0; s2 < 2; ++s2) {
                    const int ra = 32 * st + 16 * s2 + 4 * hh;
                    accH = __builtin_amdgcn_mfma_f32_32x32x16_bf16(tr_frag(L + ML_VS, ML_PT, ra, ra + 8, 32 * et, lane), __builtin_bit_cast(bf16x8, pb[st][s2]), accH, 0, 0, 0);
                }
            }
        }
#if !ML_SHARE_P
        { const float den = wi_l * qn + dsum, inv = 1.0f / fmaxf(fabsf(den), fl_l); float ssq = 0.f;
#pragma unroll
          for (int r = 0; r < 16; ++r) { accH[r] *= inv; ssq += accH[r] * accH[r]; }
          ssq += __shfl_xor(ssq, 32);
          if (hh == 0) atomicAdd((float*)(HSQ + cur * 64 + l), ssq); }
#endif
#endif
#pragma unroll
        for (int r = 0; r < 16; ++r) { accC0[r] *= decay; accC1[r] *= decay; }
#pragma unroll
        for (int ks = 0; ks < 4; ++ks) { const int ra = 16 * ks + 8 * hh;
            const bf16x8 bvv = tr_frag(L + ML_VS, ML_PT, ra, ra + 4, 32 * eb, lane);
            accC0 = __builtin_amdgcn_mfma_f32_32x32x16_bf16(tr_frag(L + ML_KWS, ML_PT, ra, ra + 4, 64 * dbp, lane), bvv, accC0, 0, 0, 0);
            accC1 = __builtin_amdgcn_mfma_f32_32x32x16_bf16(tr_frag(L + ML_KWS, ML_PT, ra, ra + 4, 64 * dbp + 32, lane), bvv, accC1, 0, 0, 0); }
        if (wave == 2) {
            float ps[8];
#pragma unroll
            for (int c = 0; c < 8; ++c) ps[c] = 0.f;
#pragma unroll
            for (int r = 0; r < 16; ++r) { const v4u k8 = *(const LAS v4u*)(L + ML_KWS + (16 * (lane >> 4) + r) * ML_PT + (lane & 15) * 16);
                ps[0] += bflo(k8.x); ps[1] += bfhi(k8.x); ps[2] += bflo(k8.y); ps[3] += bfhi(k8.y); ps[4] += bflo(k8.z); ps[5] += bfhi(k8.z); ps[6] += bflo(k8.w); ps[7] += bfhi(k8.w); }
#pragma unroll
            for (int c = 0; c < 8; ++c) { ps[c] += __shfl_xor(ps[c], 16); ps[c] += __shfl_xor(ps[c], 32); }
            if (lane < 16) {
#pragma unroll
                for (int c = 0; c < 8; ++c) nnew[8 * lane + c] = decay * nold[8 * lane + c] + ps[c]; }
        }
        if (wave == 0 && j < 63) gates_compute(cur ^ 1);
#if ML_SHARE_P
        __syncthreads();
        {
            const LAS float* dsp = (const LAS float*)(L + ML_DSP);
            const float dsum = (lt == 0) ? dsp[q32] : dsp[32 + q32] + dsp[64 + q32];
#pragma unroll
            for (int st = 0; st < 2; ++st) {
                if (st <= lt) {
                    const int blk = (lt == 0) ? 0 : 1 + st;
#pragma unroll
                    for (int s2 = 0; s2 < 2; ++s2) {
                        const int ra = 32 * st + 16 * s2 + 4 * hh;
                        const v4u pbw = *(const LAS v4u*)(L + ML_PB + blk * 2048 + s2 * 1024 + lane * 16);
                        accH = __builtin_amdgcn_mfma_f32_32x32x16_bf16(tr_frag(L + ML_VS, ML_PT, ra, ra + 8, 32 * et, lane), __builtin_bit_cast(bf16x8, pbw), accH, 0, 0, 0);
                    }
                }
            }
            const float den = wi_l * qn + dsum, inv = 1.0f / fmaxf(fabsf(den), fl_l); float ssq = 0.f;
#pragma unroll
            for (int r = 0; r < 16; ++r) { accH[r] *= inv; ssq += accH[r] * accH[r]; }
            ssq += __shfl_xor(ssq, 32);
            if (hh == 0) atomicAdd((float*)(HSQ + cur * 64 + l), ssq);
        }
#endif
        if (j > 0) flush(j - 1);
        __syncthreads();
        {
            const float rstd = rsqrtf(HSQ[cur * 64 + l] * (1.0f / 128.0f) + EPS);
#pragma unroll
            for (int g4 = 0; g4 < 4; ++g4) {
                typedef unsigned u32x2_t __attribute__((ext_vector_type(2)));
                const int e0 = 32 * et + 8 * g4 + 4 * hh;
                const f32x4 gv = *(const LAS f32x4*)(L + ML_NG + e0 * 4);
                u32x2_t w;
                w.x = cvtpk(accH[4 * g4] * rstd * gv.x, accH[4 * g4 + 1] * rstd * gv.y);
                w.y = cvtpk(accH[4 * g4 + 2] * rstd * gv.z, accH[4 * g4 + 3] * rstd * gv.w);
                *(LAS u32x2_t*)(L + ML_YT + l * ML_P + e0 * 2) = w;
            }
#pragma unroll
            for (int g4 = 0; g4 < 4; ++g4) {
                typedef unsigned u32x2_t __attribute__((ext_vector_type(2)));
                u32x2_t w0, w1;
                w0.x = cvtpk(accC0[4 * g4], accC0[4 * g4 + 1]); w0.y = cvtpk(accC0[4 * g4 + 2], accC0[4 * g4 + 3]);
                w1.x = cvtpk(accC1[4 * g4], accC1[4 * g4 + 1]); w1.y = cvtpk(accC1[4 * g4 + 2], accC1[4 * g4 + 3]);
                *(LAS u32x2_t*)(L + ML_CT + (32 * eb + q32) * ML_P + (64 * dbp + 8 * g4 + 4 * hh) * 2) = w0;
                *(LAS u32x2_t*)(L + ML_CT + (32 * eb + q32) * ML_P + (64 * dbp + 32 + 8 * g4 + 4 * hh) * 2) = w1;
            }
            if (tid < 64) HSQ[(cur ^ 1) * 64 + tid] = 0.f;
        }
    }
    load_ob(63);
    __syncthreads();
    flush(63);
    __syncthreads();
}

__device__ __forceinline__ void mlstm_ref_unit(Frame& F, int b, int h) {
    const unsigned short* QKB = (const unsigned short*)(F.ws + WS_QKB);
    const unsigned short* VB = (const unsigned short*)(F.ws + WS_VB);
    const unsigned short* OB = (const unsigned short*)(F.ws + WS_OB);
    const float* GATES = (const float*)(F.ws + WS_GATES);
    const float* conv_w = F.in[6]; const float* conv_b = F.in[7]; const float* ng = F.in[11];
    float* qs = (float*)F.lds; float* ks = qs + 128; float* vs = ks + 128; float* sc = vs + 128;
    float* part = sc + 16;
    float* red = part + 512;
    const int tid = F.tid, e = tid & 127, dq = tid >> 7;
    float C[32];
#pragma unroll
    for (int i = 0; i < 32; ++i) C[i] = 0.f;
    float nst = 0.f;
    float cw[4] = {0.f, 0.f, 0.f, 0.f}; float cb = 0.f; int ccol = 0;
    if (tid < 256) { ccol = (tid < 128 ? 0 : 512) + h * 128 + (tid & 127);
#pragma unroll
        for (int j = 0; j < 4; ++j) cw[j] = conv_w[j * 1024 + ccol]; cb = conv_b[ccol]; }
    const float gsc = ng[h * 128 + e];
    for (int tok = 0; tok < SEQ; ++tok) {
        const size_t t = (size_t)b * SEQ + tok;
        if (tid < 256) {
            float a = cb;
#pragma unroll
            for (int j = 0; j < 4; ++j) { const int tt = tok - 3 + j; if (tt >= 0) a += cw[j] * bf2f(QKB[((size_t)b * SEQ + tt) * 1024 + ccol]); }
            a = a / (1.0f + __expf(-a));
            if (tid < 128) qs[tid] = a; else ks[tid - 128] = a * 0.08838834764831845f;
        } else if (tid < 384) { vs[tid - 256] = bf2f(VB[t * 512 + h * 128 + (tid - 256)]); }
        else if (tid == 384) { sc[0] = sigmoidf_(GATES[t * 8 + 4 + h]); sc[1] = __expf(GATES[t * 8 + h]); }
        __syncthreads();
        const float fg = sc[0], ig = sc[1], ve = vs[e];
        float acc = 0.f;
#pragma unroll
        for (int i = 0; i < 32; ++i) { const int d = dq * 32 + i; C[i] = fg * C[i] + (ig * ks[d]) * ve; acc += qs[d] * C[i]; }
        part[dq * 128 + e] = acc;
        if (tid < 128) { nst = fg * nst + ig * ks[tid]; const float qn = wave_sum(qs[tid] * nst); if (F.lane == 0) red[F.wave] = qn; }
        __syncthreads();
        float hv = 0.f;
        if (tid < 128) { const float num = (part[e] + part[128 + e]) + (part[256 + e] + part[384 + e]); const float den = red[0] + red[1];
            hv = num / fmaxf(fabsf(den), 1.0f); const float ss = wave_sum(hv * hv); if (F.lane == 0) red[2 + F.wave] = ss; }
        __syncthreads();
        if (tid < 128) { const float rstd = rsqrtf((red[2] + red[3]) * (1.0f / 128.0f) + EPS);
            const float y = hv * rstd * gsc * bf2f(OB[t * 512 + h * 128 + e]);
            ((unsigned short*)(F.ws + WS_YB))[t * 512 + h * 128 + e] = (unsigned short)f2bf(y); }
        __syncthreads();
    }
}

__device__ __forceinline__ void argmax_step(float& bv, int& bi) {
#pragma unroll
    for (int o = 1; o < 64; o <<= 1) { const float ov = __shfl_xor(bv, o); const int oi = __shfl_xor(bi, o); if (ov > bv || (ov == bv && oi < bi)) { bv = ov; bi = oi; } }
}
__device__ __forceinline__ void peer_route_ref(Frame& F) {
    const unsigned short* PQ = (const unsigned short*)(F.ws + WS_PQ);
    const unsigned short* SUBK = (const unsigned short*)(F.ws + WS_SUBK);
    unsigned* ROUTE = (unsigned*)(F.ws + WS_ROUTE);
    unsigned char* wl = F.lds + F.wave * 8192;
    unsigned short* ql = (unsigned short*)wl;
    float* tv = (float*)(wl + 4096);
    int* ti = (int*)(wl + 4096 + 1024);
    const int lane = F.lane;
    for (int t = F.gw; t < T; t += F.NGW) {
        { const v4u* src = (const v4u*)(PQ + (size_t)t * 2048); v4u* dst = (v4u*)ql;
#pragma unroll
          for (int i = 0; i < 4; ++i) dst[lane + 64 * i] = src[lane + 64 * i]; }
        LDS_WAIT(); asm volatile("" ::: "memory");
        for (int g = 0; g < 16; ++g) {
            const v4u* k0 = (const v4u*)(SUBK + (size_t)(g * 128 + lane) * 128);
            const v4u* k1 = (const v4u*)(SUBK + (size_t)(g * 128 + 64 + lane) * 128);
            const v4u* qg = (const v4u*)(ql + g * 128);
            float s0 = 0.f, s1 = 0.f;
#pragma unroll 4
            for (int ch = 0; ch < 16; ++ch) { const v4u q = qg[ch], a = k0[ch], c = k1[ch];
                s0 = dot2c(s0, q.x, a.x); s0 = dot2c(s0, q.y, a.y); s0 = dot2c(s0, q.z, a.z); s0 = dot2c(s0, q.w, a.w);
                s1 = dot2c(s1, q.x, c.x); s1 = dot2c(s1, q.y, c.y); s1 = dot2c(s1, q.z, c.z); s1 = dot2c(s1, q.w, c.w); }
            float myv = 0.f; int myi = 0;
            for (int it = 0; it < 16; ++it) {
                float bv; int bi; if (s0 >= s1) { bv = s0; bi = lane; } else { bv = s1; bi = lane + 64; }
                argmax_step(bv, bi);
                if (it == lane) { myv = bv; myi = bi; }
                if (bi == lane) s0 = -INFINITY; if (bi == lane + 64) s1 = -INFINITY;
            }
            if (lane < 16) { tv[g * 16 + lane] = myv; ti[g * 16 + lane] = myi; }
        }
        LDS_WAIT(); asm volatile("" ::: "memory");
        for (int h = 0; h < 8; ++h) {
            float cv[4];
#pragma unroll
            for (int r = 0; r < 4; ++r) cv[r] = tv[(2 * h) * 16 + (lane >> 2)] + tv[(2 * h + 1) * 16 + 4 * (lane & 3) + r];
            float myv = -INFINITY; int myc = 0;
            for (int it = 0; it < 16; ++it) {
                float bv = cv[0]; int bi = 4 * lane;
#pragma unroll
                for (int r = 1; r < 4; ++r) if (cv[r] > bv) { bv = cv[r]; bi = 4 * lane + r; }
                argmax_step(bv, bi);
                if (it == lane) { myv = bv; myc = bi; }
#pragma unroll
                for (int r = 0; r < 4; ++r) if (bi == 4 * lane + r) cv[r] = -INFINITY;
            }
            const float mx = __shfl(myv, 0);
            float ex = lane < 16 ? __expf(myv - mx) : 0.f;
            const float sum = wave_sum(ex);
            if (lane < 16) { const int e = ti[(2 * h) * 16 + (myc >> 4)] * 128 + ti[(2 * h + 1) * 16 + (myc & 15)];
                ROUTE[(size_t)t * 128 + h * 16 + lane] = ((unsigned)e << 16) | f2bf(ex / sum); }
        }
        LDS_WAIT(); asm volatile("" ::: "memory");
    }
}


__device__ __forceinline__ void sort_insert16(float (&a)[16], float x) {
#pragma unroll
    for (int k = 15; k >= 1; --k) a[k] = __builtin_amdgcn_fmed3f(a[k - 1], x, a[k]);
    a[0] = fmaxf(a[0], x);
}
__device__ __forceinline__ void merge_halves16(float (&a)[16]) {
    float c[16];
#pragma unroll
    for (int k = 0; k < 16; ++k) c[k] = __shfl_xor(a[k], 32);
#pragma unroll
    for (int k = 0; k < 16; ++k) a[k] = fmaxf(a[k], c[15 - k]);
#pragma unroll
    for (int st = 8; st >= 1; st >>= 1)
#pragma unroll
        for (int i = 0; i < 16; ++i) if ((i & st) == 0) { const float hi = fmaxf(a[i], a[i + st]), lo = fminf(a[i], a[i + st]); a[i] = hi; a[i + st] = lo; }
}
__device__ __forceinline__ void peer_route_mfma(Frame& F) {
    const unsigned short* PQ = (const unsigned short*)(F.ws + WS_PQ);
    const unsigned short* SUBK = (const unsigned short*)(F.ws + WS_SUBK);
    unsigned* ROUTE = (unsigned*)(F.ws + WS_ROUTE);
    constexpr int SKP = 272;
    LAS unsigned char* L = (LAS unsigned char*)F.lds;
    LAS unsigned* lst = (LAS unsigned*)(L + 2 * 128 * SKP) + F.wave * 1024;
    const int lane = F.lane, hh = lane >> 5, q32 = lane & 31, tid = F.tid;
    for (int tile = F.gw; tile < T / 32; tile += F.NGW) {
    const size_t t = (size_t)tile * 32 + q32;
    for (int h = 0; h < 8; ++h) {
        __syncthreads();
#pragma unroll
        for (int i = 0; i < 8; ++i) { const int pc = tid + 512 * i, row = pc >> 4, ch = pc & 15;
            *(LAS v4u*)(L + row * SKP + ch * 16) = *(const v4u*)(SUBK + ((size_t)(2 * h) * 128 + row) * 128 + ch * 8); }
        __syncthreads();
        float kk[2][16];
#pragma unroll
        for (int p = 0; p < 2; ++p) {
            const int g = 2 * h + p;
            bf16x8 bq[8];
#pragma unroll
            for (int ks = 0; ks < 8; ++ks) bq[ks] = *(const bf16x8*)(PQ + t * 2048 + g * 128 + 16 * ks + 8 * hh);
            float a[16];
#pragma unroll
            for (int k = 0; k < 16; ++k) a[k] = -INFINITY;
#pragma unroll
            for (int nt = 0; nt < 4; ++nt) {
                f32x16 acc = {};
                const LAS unsigned char* arow = L + (p * 128 + 32 * nt + q32) * SKP + 16 * hh;
#pragma unroll
                for (int ks = 0; ks < 8; ++ks) acc = __builtin_amdgcn_mfma_f32_32x32x16_bf16(*(const LAS bf16x8*)(arow + 32 * ks), bq[ks], acc, 0, 0, 0);
#pragma unroll
                for (int r = 0; r < 16; ++r) { const int nconst = 32 * nt + (r & 3) + 8 * (r >> 2);
                    const float sv = acc[r];
                    const unsigned key = (__float_as_uint(sv) & 0xFFFFFF80u) | (unsigned)(127 - nconst - 4 * hh);
                    sort_insert16(a, __builtin_bit_cast(float, key)); }
            }
            merge_halves16(a);
#pragma unroll
            for (int k = 0; k < 16; ++k) { kk[p][k] = a[k]; lst[(p * 16 + k) * 32 + q32] = __builtin_bit_cast(unsigned, a[k]); }
        }
        float c2[16];
#pragma unroll
        for (int k = 0; k < 16; ++k) c2[k] = -INFINITY;
#pragma unroll
        for (int i = 0; i < 16; ++i)
#pragma unroll
            for (int j = 0; j < 16; ++j) if ((i + 1) * (j + 1) <= 16) {
                const float sm = kk[0][i] + kk[1][j];
                const unsigned key = (__builtin_bit_cast(unsigned, sm) & 0xFFFFFF00u) | (unsigned)(255 - (i * 16 + j));
                sort_insert16(c2, __builtin_bit_cast(float, key)); }
        LDS_WAIT(); asm volatile("" ::: "memory");
        float ex[16]; float sum = 0.f;
#pragma unroll
        for (int k = 0; k < 16; ++k) { ex[k] = __expf(c2[k] - c2[0]); sum += ex[k]; }
        const float inv = 1.0f / sum;
        unsigned outw[16];
#pragma unroll
        for (int k = 0; k < 16; ++k) { const unsigned pidx = 255u - (__builtin_bit_cast(unsigned, c2[k]) & 255u);
            const unsigned n0 = 127u - (lst[(pidx >> 4) * 32 + q32] & 127u), n1 = 127u - (lst[(16 + (pidx & 15u)) * 32 + q32] & 127u);
            outw[k] = ((n0 * 128u + n1) << 16) | f2bf(ex[k] * inv); }
        v4u w0, w1;
        w0.x = hh ? outw[8] : outw[0]; w0.y = hh ? outw[9] : outw[1]; w0.z = hh ? outw[10] : outw[2]; w0.w = hh ? outw[11] : outw[3];
        w1.x = hh ? outw[12] : outw[4]; w1.y = hh ? outw[13] : outw[5]; w1.z = hh ? outw[14] : outw[6]; w1.w = hh ? outw[15] : outw[7];
        v4u* dst = (v4u*)(ROUTE + t * 128 + h * 16 + 8 * hh);
        dst[0] = w0; dst[1] = w1;
        LDS_WAIT(); asm volatile("" ::: "memory");
    }
    }
}

__device__ __forceinline__ float gelu_tanh(float x) { const float z = 0.7978845608028654f * (x + 0.044715f * x * x * x); const float th = 1.0f - 2.0f / (1.0f + __expf(2.0f * z)); return 0.5f * x * (1.0f + th); }
__device__ __forceinline__ void peer_gather(Frame& F) {
    const unsigned short* H2 = (const unsigned short*)(F.ws + WS_H2);
    const unsigned short* U = (const unsigned short*)(F.ws + WS_U);
    const unsigned short* V = (const unsigned short*)(F.ws + WS_V);
    const unsigned* ROUTE = (const unsigned*)(F.ws + WS_ROUTE);
    const float* MOD = (const float*)(F.ws + WS_MOD);
    const float* fg = F.in[20];
    float* pp = (float*)(F.lds + F.wave * (64 * 65 * 4));
    const int lane = F.lane;
    for (int t = F.gw; t < T; t += F.NGW) {
        const int b = t >> 12;
        const v4u ha = ((const v4u*)(H2 + (size_t)t * 1024))[lane], hb = ((const v4u*)(H2 + (size_t)t * 1024))[64 + lane];
        const unsigned r0 = ROUTE[(size_t)t * 128 + lane], r1 = ROUTE[(size_t)t * 128 + 64 + lane];
        float coef0, coef1;
#pragma unroll
        for (int half = 0; half < 2; ++half) {
            const unsigned rr = half ? r1 : r0;
            for (int k = 0; k < 64; k += 4) {
                v4u ua[4], ub[4];
#pragma unroll
                for (int q = 0; q < 4; ++q) { const unsigned id = __builtin_amdgcn_readlane(rr, k + q) >> 16; const v4u* row = (const v4u*)(U + (size_t)id * 1024); ua[q] = row[lane]; ub[q] = row[64 + lane]; }
#pragma unroll
                for (int q = 0; q < 4; ++q) { float d = 0.f;
                    d = dot2c(d, ua[q].x, ha.x); d = dot2c(d, ua[q].y, ha.y); d = dot2c(d, ua[q].z, ha.z); d = dot2c(d, ua[q].w, ha.w);
                    d = dot2c(d, ub[q].x, hb.x); d = dot2c(d, ub[q].y, hb.y); d = dot2c(d, ub[q].z, hb.z); d = dot2c(d, ub[q].w, hb.w);
                    pp[(k + q) * 65 + lane] = d; }
            }
            LDS_WAIT(); asm volatile("" ::: "memory");
            float tot = 0.f;
#pragma unroll 8
            for (int i = 0; i < 64; ++i) tot += pp[lane * 65 + i];
            LDS_WAIT(); asm volatile("" ::: "memory");
            const float cf = bflo(rr) * gelu_tanh(tot);
            if (half) coef1 = cf; else coef0 = cf;
        }
        float o[16];
#pragma unroll
        for (int i = 0; i < 16; ++i) o[i] = 0.f;
#pragma unroll
        for (int half = 0; half < 2; ++half) {
            const unsigned rr = half ? r1 : r0; const float cfv = half ? coef1 : coef0;
            for (int k = 0; k < 64; k += 4) {
                v4u va[4], vb[4]; float cs[4];
#pragma unroll
                for (int q = 0; q < 4; ++q) { const unsigned id = __builtin_amdgcn_readlane(rr, k + q) >> 16; cs[q] = __builtin_bit_cast(float, __builtin_amdgcn_readlane(__builtin_bit_cast(unsigned, cfv), k + q));
                    const v4u* row = (const v4u*)(V + (size_t)id * 1024); va[q] = row[lane]; vb[q] = row[64 + lane]; }
#pragma unroll
                for (int q = 0; q < 4; ++q) { const float c = cs[q];
                    o[0] += c * bflo(va[q].x); o[1] += c * bfhi(va[q].x); o[2] += c * bflo(va[q].y); o[3] += c * bfhi(va[q].y);
                    o[4] += c * bflo(va[q].z); o[5] += c * bfhi(va[q].z); o[6] += c * bflo(va[q].w); o[7] += c * bfhi(va[q].w);
                    o[8] += c * bflo(vb[q].x); o[9] += c * bfhi(vb[q].x); o[10] += c * bflo(vb[q].y); o[11] += c * bfhi(vb[q].y);
                    o[12] += c * bflo(vb[q].z); o[13] += c * bfhi(vb[q].z); o[14] += c * bflo(vb[q].w); o[15] += c * bfhi(vb[q].w); }
            }
        }
        float* xrow = F.out + (size_t)t * 1024;
        const float* gt2 = MOD + b * 6144 + 5120;
        float x2[16]; float ss = 0.f;
#pragma unroll
        for (int c4 = 0; c4 < 4; ++c4) { const int e0 = (c4 < 2 ? 8 * lane + 4 * c4 : 512 + 8 * lane + 4 * (c4 - 2));
            const f32x4 xv = *(const f32x4*)(xrow + e0), gv = *(const f32x4*)(gt2 + e0);
#pragma unroll
            for (int i = 0; i < 4; ++i) { const float v = xv[i] + gv[i] * o[4 * c4 + i]; x2[4 * c4 + i] = v; ss += v * v; } }
        const float rstd = rsqrtf(wave_sum(ss) * (1.0f / 1024.0f) + EPS);
#pragma unroll
        for (int c4 = 0; c4 < 4; ++c4) { const int e0 = (c4 < 2 ? 8 * lane + 4 * c4 : 512 + 8 * lane + 4 * (c4 - 2));
            const f32x4 gv = *(const f32x4*)(fg + e0); f32x4 ov;
#pragma unroll
            for (int i = 0; i < 4; ++i) ov[i] = x2[4 * c4 + i] * rstd * gv[i];
            *(f32x4*)(xrow + e0) = ov; }
    }
}


__device__ __forceinline__ void peer_gather_fp8(Frame& F) {
    const unsigned short* H2 = (const unsigned short*)(F.ws + WS_H2);
    const unsigned char* U = F.ws + WS_U; const unsigned char* V = F.ws + WS_V;
    const float* USC = (const float*)(F.ws + WS_USC); const float* VSC = (const float*)(F.ws + WS_VSC);
    const unsigned* ROUTE = (const unsigned*)(F.ws + WS_ROUTE);
    const float* MOD = (const float*)(F.ws + WS_MOD);
    const float* fg = F.in[20];
    LAS float* pp = (LAS float*)F.lds + F.wave * (64 * 65);
    const int lane = F.lane;
    for (int t = F.gw; t < T; t += F.NGW) {
        const int b = t >> 12;
        f32x2_t hf[8];
        { const v4u ha = ((const v4u*)(H2 + (size_t)t * 1024))[2 * lane], hb = ((const v4u*)(H2 + (size_t)t * 1024))[2 * lane + 1];
          hf[0] = (f32x2_t){bflo(ha.x), bfhi(ha.x)}; hf[1] = (f32x2_t){bflo(ha.y), bfhi(ha.y)}; hf[2] = (f32x2_t){bflo(ha.z), bfhi(ha.z)}; hf[3] = (f32x2_t){bflo(ha.w), bfhi(ha.w)};
          hf[4] = (f32x2_t){bflo(hb.x), bfhi(hb.x)}; hf[5] = (f32x2_t){bflo(hb.y), bfhi(hb.y)}; hf[6] = (f32x2_t){bflo(hb.z), bfhi(hb.z)}; hf[7] = (f32x2_t){bflo(hb.w), bfhi(hb.w)}; }
        const unsigned r0 = ROUTE[(size_t)t * 128 + lane], r1 = ROUTE[(size_t)t * 128 + 64 + lane];
        const float su0 = USC[r0 >> 16], su1 = USC[r1 >> 16], sv0 = VSC[r0 >> 16], sv1 = VSC[r1 >> 16];
        float coef0 = 0.f, coef1 = 0.f;
#define LOAD8(dst, tab, rr, k0) do { _Pragma("unroll") for (int q = 0; q < 8; ++q) { const unsigned id = (__builtin_amdgcn_readlane(rr, (k0) + q) >> 16) & DBG_IDMASK; dst[q] = ((const v4u*)((tab) + (size_t)id * 1024))[lane]; } } while (0)
#define UDOT8(src, k0) do { _Pragma("unroll") for (int q = 0; q < 8; ++q) { const unsigned w[4] = {src[q].x, src[q].y, src[q].z, src[q].w}; f32x2_t acc = {0.f, 0.f}; \
            _Pragma("unroll") for (int j = 0; j < 4; ++j) { acc = __builtin_elementwise_fma(__builtin_amdgcn_cvt_pk_f32_fp8(w[j], false), hf[2 * j], acc); acc = __builtin_elementwise_fma(__builtin_amdgcn_cvt_pk_f32_fp8(w[j], true), hf[2 * j + 1], acc); } \
            pp[((k0) + q) * 65 + lane] = acc.x + acc.y; } } while (0)
#pragma unroll
        for (int half = 0; half < 2; ++half) {
            const unsigned rr = half ? r1 : r0;
            v4u ra[8], rb[8];
            LOAD8(ra, U, rr, 0);
            for (int kb = 0; kb < 64; kb += 16) {
                LOAD8(rb, U, rr, kb + 8);
                UDOT8(ra, kb);
                if (kb + 16 < 64) LOAD8(ra, U, rr, kb + 16);
                UDOT8(rb, kb + 8);
            }
            LDS_WAIT(); asm volatile("" ::: "memory");
            float tot = 0.f;
#pragma unroll 8
            for (int i = 0; i < 64; ++i) tot += pp[lane * 65 + i];
            LDS_WAIT(); asm volatile("" ::: "memory");
            const float cf = bflo(rr) * gelu_tanh(tot * (half ? su1 : su0)) * (half ? sv1 : sv0);
            if (half) coef1 = cf; else coef0 = cf;
        }
        f32x2_t o[8];
#pragma unroll
        for (int i = 0; i < 8; ++i) o[i] = (f32x2_t){0.f, 0.f};
#define VACC8(src, cfv, k0) do { _Pragma("unroll") for (int q = 0; q < 8; ++q) { const unsigned w[4] = {src[q].x, src[q].y, src[q].z, src[q].w}; \
            const float c = __uint_as_float(__builtin_amdgcn_readlane(__float_as_uint(cfv), (k0) + q)); const f32x2_t cc = {c, c}; \
            _Pragma("unroll") for (int j = 0; j < 4; ++j) { o[2 * j] = __builtin_elementwise_fma(__builtin_amdgcn_cvt_pk_f32_fp8(w[j], false), cc, o[2 * j]); o[2 * j + 1] = __builtin_elementwise_fma(__builtin_amdgcn_cvt_pk_f32_fp8(w[j], true), cc, o[2 * j + 1]); } } } while (0)
#pragma unroll
        for (int half = 0; half < 2; ++half) {
            const unsigned rr = half ? r1 : r0; const float cfv = half ? coef1 : coef0;
            v4u ra[8], rb[8];
            LOAD8(ra, V, rr, 0);
            for (int kb = 0; kb < 64; kb += 16) {
                LOAD8(rb, V, rr, kb + 8);
                VACC8(ra, cfv, kb);
                if (kb + 16 < 64) LOAD8(ra, V, rr, kb + 16);
                VACC8(rb, cfv, kb + 8);
            }
        }
#undef LOAD8
#undef UDOT8
#undef VACC8
        float* xrow = F.out + (size_t)t * 1024 + 16 * lane;
        const float* gt2 = MOD + b * 6144 + 5120 + 16 * lane;
        f32x4 x2[4]; float ss = 0.f;
#pragma unroll
        for (int c4 = 0; c4 < 4; ++c4) { const f32x4 xv = ((const f32x4*)xrow)[c4], gv = ((const f32x4*)gt2)[c4];
            f32x4 ov; ov.x = o[2 * c4].x; ov.y = o[2 * c4].y; ov.z = o[2 * c4 + 1].x; ov.w = o[2 * c4 + 1].y;
            x2[c4] = xv + gv * ov; ss += (x2[c4].x * x2[c4].x + x2[c4].y * x2[c4].y) + (x2[c4].z * x2[c4].z + x2[c4].w * x2[c4].w); }
        const float rstd = rsqrtf(wave_sum(ss) * (1.0f / 1024.0f) + EPS);
#pragma unroll
        for (int c4 = 0; c4 < 4; ++c4) { const f32x4 gv = ((const f32x4*)(fg + 16 * lane))[c4]; ((f32x4*)xrow)[c4] = x2[c4] * rstd * gv; }
    }
}


typedef unsigned u32x8_t __attribute__((ext_vector_type(8)));
typedef float f32x8_t __attribute__((ext_vector_type(8)));
__device__ __forceinline__ f32x2_t dot16_fp8(const v4u row, const f32x2_t (&h)[8]) {
    const unsigned w[4] = {row.x, row.y, row.z, row.w}; f32x2_t acc = {0.f, 0.f};
#pragma unroll
    for (int j = 0; j < 4; ++j) { acc = __builtin_elementwise_fma(__builtin_amdgcn_cvt_pk_f32_fp8(w[j], false), h[2 * j], acc); acc = __builtin_elementwise_fma(__builtin_amdgcn_cvt_pk_f32_fp8(w[j], true), h[2 * j + 1], acc); }
    return acc;
}
__device__ __forceinline__ void axpy16_fp8(const v4u row, const float c, f32x2_t (&o)[8]) {
    const unsigned w[4] = {row.x, row.y, row.z, row.w}; const f32x2_t cc = {c, c};
#pragma unroll
    for (int j = 0; j < 4; ++j) { o[2 * j] = __builtin_elementwise_fma(__builtin_amdgcn_cvt_pk_f32_fp8(w[j], false), cc, o[2 * j]); o[2 * j + 1] = __builtin_elementwise_fma(__builtin_amdgcn_cvt_pk_f32_fp8(w[j], true), cc, o[2 * j + 1]); }
}
__device__ __forceinline__ void load_h16(const unsigned short* H2, size_t t, int lane, f32x2_t (&hf)[8]) {
    const v4u ha = ((const v4u*)(H2 + t * 1024))[2 * lane], hb = ((const v4u*)(H2 + t * 1024))[2 * lane + 1];
    hf[0] = (f32x2_t){bflo(ha.x), bfhi(ha.x)}; hf[1] = (f32x2_t){bflo(ha.y), bfhi(ha.y)}; hf[2] = (f32x2_t){bflo(ha.z), bfhi(ha.z)}; hf[3] = (f32x2_t){bflo(ha.w), bfhi(ha.w)};
    hf[4] = (f32x2_t){bflo(hb.x), bfhi(hb.x)}; hf[5] = (f32x2_t){bflo(hb.y), bfhi(hb.y)}; hf[6] = (f32x2_t){bflo(hb.z), bfhi(hb.z)}; hf[7] = (f32x2_t){bflo(hb.w), bfhi(hb.w)};
}
__device__ __forceinline__ void peer_gather_sweep(Frame& F) {
    const unsigned short* H2 = (const unsigned short*)(F.ws + WS_H2);
    const unsigned char* U = F.ws + WS_U; const unsigned char* V = F.ws + WS_V;
    const float* USC = (const float*)(F.ws + WS_USC); const float* VSC = (const float*)(F.ws + WS_VSC);
    const unsigned* ROUTE = (const unsigned*)(F.ws + WS_ROUTE);
    const float* MOD = (const float*)(F.ws + WS_MOD);
    const float* fg = F.in[20];
    LAS float* pp = (LAS float*)F.lds + F.wave * (64 * 65);
    const int lane = F.lane;
    for (int bt = F.gw; bt < T / 4; bt += F.NGW) {
        const size_t tb = (size_t)bt * 4; const int b = (int)(tb >> 12);
        unsigned keys[8];
#pragma unroll
        for (int tk = 0; tk < 4; ++tk) { const unsigned r0 = ROUTE[(tb + tk) * 128 + lane], r1 = ROUTE[(tb + tk) * 128 + 64 + lane];
            keys[2 * tk] = ((r0 >> 16) << 18) | ((unsigned)tk << 16) | (r0 & 0xffffu); keys[2 * tk + 1] = ((r1 >> 16) << 18) | ((unsigned)tk << 16) | (r1 & 0xffffu); }
#pragma unroll
        for (int k = 2; k <= SW_SORT_MAX; k <<= 1) {
#pragma unroll
            for (int j = k >> 1; j > 0; j >>= 1) {
                if (j >= 64) { const int jr = j >> 6;
#pragma unroll
                    for (int r = 0; r < 8; ++r) if ((r & jr) == 0) { const bool asc = ((r * 64) & k) == 0; const unsigned a = keys[r], c = keys[r | jr], lo = a < c ? a : c, hi = a < c ? c : a; keys[r] = asc ? lo : hi; keys[r | jr] = asc ? hi : lo; }
                } else {
#pragma unroll
                    for (int r = 0; r < 8; ++r) { const unsigned o = (unsigned)__shfl_xor((int)keys[r], j); const bool asc = (((r * 64 + lane) & k) == 0), lower = (lane & j) == 0;
                        const unsigned mn = keys[r] < o ? keys[r] : o, mx = keys[r] < o ? o : keys[r]; keys[r] = (asc == lower) ? mn : mx; }
                }
            }
        }
        u32x8_t kv; kv[0] = keys[0]; kv[1] = keys[1]; kv[2] = keys[2]; kv[3] = keys[3]; kv[4] = keys[4]; kv[5] = keys[5]; kv[6] = keys[6]; kv[7] = keys[7];
        f32x8_t cfv = {};
        {
            f32x2_t h0[8], h1[8], h2[8], h3[8];
            load_h16(H2, tb, lane, h0); load_h16(H2, tb + 1, lane, h1); load_h16(H2, tb + 2, lane, h2); load_h16(H2, tb + 3, lane, h3);
            for (int c = 0; c < 8; ++c) {
                const unsigned kc = kv[c];
                v4u ra[4], rb[4];
#define SW_LOAD4(dst, tab, k0) do { _Pragma("unroll") for (int q = 0; q < 4; ++q) { const unsigned id = (unsigned)__builtin_amdgcn_readlane(kc, (k0) + q) >> 18; dst[q] = ((const v4u*)((tab) + (size_t)id * 1024))[lane]; } } while (0)
#define SW_UDOT4(src, k0) do { _Pragma("unroll") for (int q = 0; q < 4; ++q) { const unsigned tk = ((unsigned)__builtin_amdgcn_readlane(kc, (k0) + q) >> 16) & 3u; f32x2_t acc; \
                    if (tk == 0) acc = dot16_fp8(src[q], h0); else if (tk == 1) acc = dot16_fp8(src[q], h1); else if (tk == 2) acc = dot16_fp8(src[q], h2); else acc = dot16_fp8(src[q], h3); \
                    pp[((k0) + q) * 65 + lane] = acc.x + acc.y; } } while (0)
                SW_LOAD4(ra, U, 0);
                for (int kb = 0; kb < 64; kb += 8) {
                    SW_LOAD4(rb, U, kb + 4);
                    SW_UDOT4(ra, kb);
                    if (kb + 8 < 64) SW_LOAD4(ra, U, kb + 8);
                    SW_UDOT4(rb, kb + 4);
                }
#undef SW_UDOT4
                LDS_WAIT(); asm volatile("" ::: "memory");
                float tot = 0.f;
#pragma unroll 8
                for (int i = 0; i < 64; ++i) tot += pp[lane * 65 + i];
                LDS_WAIT(); asm volatile("" ::: "memory");
                const unsigned myid = kc >> 18;
                cfv[c] = bflo(kc) * gelu_tanh(tot * USC[myid]) * VSC[myid];
            }
        }
        f32x2_t o0[8], o1[8], o2[8], o3[8];
#pragma unroll
        for (int i = 0; i < 8; ++i) { o0[i] = (f32x2_t){0.f, 0.f}; o1[i] = o0[i]; o2[i] = o0[i]; o3[i] = o0[i]; }
        for (int c = 0; c < 8; ++c) {
            const unsigned kc = kv[c]; const unsigned cfb = __float_as_uint(cfv[c]);
            v4u ra[4], rb[4];
#define SW_VACC4(src, k0) do { _Pragma("unroll") for (int q = 0; q < 4; ++q) { const unsigned tk = ((unsigned)__builtin_amdgcn_readlane(kc, (k0) + q) >> 16) & 3u; const float cf = __uint_as_float(__builtin_amdgcn_readlane(cfb, (k0) + q)); \
                if (tk == 0) axpy16_fp8(src[q], cf, o0); else if (tk == 1) axpy16_fp8(src[q], cf, o1); else if (tk == 2) axpy16_fp8(src[q], cf, o2); else axpy16_fp8(src[q], cf, o3); } } while (0)
            SW_LOAD4(ra, V, 0);
            for (int kb = 0; kb < 64; kb += 8) {
                SW_LOAD4(rb, V, kb + 4);
                SW_VACC4(ra, kb);
                if (kb + 8 < 64) SW_LOAD4(ra, V, kb + 8);
                SW_VACC4(rb, kb + 4);
            }
#undef SW_VACC4
#undef SW_LOAD4
        }
#define SW_FIN(tk, oo) do { float* xrow = F.out + (tb + (tk)) * 1024 + 16 * lane; const float* gt2 = MOD + b * 6144 + 5120 + 16 * lane; f32x4 x2[4]; float ss = 0.f; \
            _Pragma("unroll") for (int c4 = 0; c4 < 4; ++c4) { const f32x4 xv = ((const f32x4*)xrow)[c4], gv = ((const f32x4*)gt2)[c4]; f32x4 ov; ov.x = oo[2 * c4].x; ov.y = oo[2 * c4].y; ov.z = oo[2 * c4 + 1].x; ov.w = oo[2 * c4 + 1].y; \
                x2[c4] = xv + gv * ov; ss += (x2[c4].x * x2[c4].x + x2[c4].y * x2[c4].y) + (x2[c4].z * x2[c4].z + x2[c4].w * x2[c4].w); } \
            const float rstd = rsqrtf(wave_sum(ss) * (1.0f / 1024.0f) + EPS); \
            _Pragma("unroll") for (int c4 = 0; c4 < 4; ++c4) { const f32x4 gv = ((const f32x4*)(fg + 16 * lane))[c4]; ((f32x4*)xrow)[c4] = x2[c4] * rstd * gv; } } while (0)
        SW_FIN(0, o0); SW_FIN(1, o1); SW_FIN(2, o2); SW_FIN(3, o3);
#undef SW_FIN
    }
}


__device__ __forceinline__ f32x2_t dot16_fp4(unsigned wx, unsigned wy, const f32x2_t (&h)[8]) {
    f32x2_t acc = {0.f, 0.f};
    acc = __builtin_elementwise_fma(__builtin_amdgcn_cvt_scalef32_pk_f32_fp4(wx, 1.0f, 0), h[0], acc); acc = __builtin_elementwise_fma(__builtin_amdgcn_cvt_scalef32_pk_f32_fp4(wx, 1.0f, 1), h[1], acc);
    acc = __builtin_elementwise_fma(__builtin_amdgcn_cvt_scalef32_pk_f32_fp4(wx, 1.0f, 2), h[2], acc); acc = __builtin_elementwise_fma(__builtin_amdgcn_cvt_scalef32_pk_f32_fp4(wx, 1.0f, 3), h[3], acc);
    acc = __builtin_elementwise_fma(__builtin_amdgcn_cvt_scalef32_pk_f32_fp4(wy, 1.0f, 0), h[4], acc); acc = __builtin_elementwise_fma(__builtin_amdgcn_cvt_scalef32_pk_f32_fp4(wy, 1.0f, 1), h[5], acc);
    acc = __builtin_elementwise_fma(__builtin_amdgcn_cvt_scalef32_pk_f32_fp4(wy, 1.0f, 2), h[6], acc); acc = __builtin_elementwise_fma(__builtin_amdgcn_cvt_scalef32_pk_f32_fp4(wy, 1.0f, 3), h[7], acc);
    return acc;
}
__device__ __forceinline__ void axpy16_fp4(unsigned wx, unsigned wy, const float c, f32x2_t (&o)[8]) {
    const f32x2_t cc = {c, c};
    o[0] = __builtin_elementwise_fma(__builtin_amdgcn_cvt_scalef32_pk_f32_fp4(wx, 1.0f, 0), cc, o[0]); o[1] = __builtin_elementwise_fma(__builtin_amdgcn_cvt_scalef32_pk_f32_fp4(wx, 1.0f, 1), cc, o[1]);
    o[2] = __builtin_elementwise_fma(__builtin_amdgcn_cvt_scalef32_pk_f32_fp4(wx, 1.0f, 2), cc, o[2]); o[3] = __builtin_elementwise_fma(__builtin_amdgcn_cvt_scalef32_pk_f32_fp4(wx, 1.0f, 3), cc, o[3]);
    o[4] = __builtin_elementwise_fma(__builtin_amdgcn_cvt_scalef32_pk_f32_fp4(wy, 1.0f, 0), cc, o[4]); o[5] = __builtin_elementwise_fma(__builtin_amdgcn_cvt_scalef32_pk_f32_fp4(wy, 1.0f, 1), cc, o[5]);
    o[6] = __builtin_elementwise_fma(__builtin_amdgcn_cvt_scalef32_pk_f32_fp4(wy, 1.0f, 2), cc, o[6]); o[7] = __builtin_elementwise_fma(__builtin_amdgcn_cvt_scalef32_pk_f32_fp4(wy, 1.0f, 3), cc, o[7]);
}

__device__ __forceinline__ float dot16_fp4_bf16(unsigned wx, unsigned wy, const v4u ha, const v4u hb) {
    float acc = 0.f;
    acc = __builtin_amdgcn_fdot2_f32_bf16(__builtin_amdgcn_cvt_scalef32_pk_bf16_fp4(wx, 1.0f, 0), __builtin_bit_cast(bf16x2_t, ha.x), acc, false);
    acc = __builtin_amdgcn_fdot2_f32_bf16(__builtin_amdgcn_cvt_scalef32_pk_bf16_fp4(wx, 1.0f, 1), __builtin_bit_cast(bf16x2_t, ha.y), acc, false);
    acc = __builtin_amdgcn_fdot2_f32_bf16(__builtin_amdgcn_cvt_scalef32_pk_bf16_fp4(wx, 1.0f, 2), __builtin_bit_cast(bf16x2_t, ha.z), acc, false);
    acc = __builtin_amdgcn_fdot2_f32_bf16(__builtin_amdgcn_cvt_scalef32_pk_bf16_fp4(wx, 1.0f, 3), __builtin_bit_cast(bf16x2_t, ha.w), acc, false);
    acc = __builtin_amdgcn_fdot2_f32_bf16(__builtin_amdgcn_cvt_scalef32_pk_bf16_fp4(wy, 1.0f, 0), __builtin_bit_cast(bf16x2_t, hb.x), acc, false);
    acc = __builtin_amdgcn_fdot2_f32_bf16(__builtin_amdgcn_cvt_scalef32_pk_bf16_fp4(wy, 1.0f, 1), __builtin_bit_cast(bf16x2_t, hb.y), acc, false);
    acc = __builtin_amdgcn_fdot2_f32_bf16(__builtin_amdgcn_cvt_scalef32_pk_bf16_fp4(wy, 1.0f, 2), __builtin_bit_cast(bf16x2_t, hb.z), acc, false);
    acc = __builtin_amdgcn_fdot2_f32_bf16(__builtin_amdgcn_cvt_scalef32_pk_bf16_fp4(wy, 1.0f, 3), __builtin_bit_cast(bf16x2_t, hb.w), acc, false);
    return acc;
}
__device__ __forceinline__ void peer_gather_fp4(Frame& F) {
    constexpr int GB = PEER_GB;
    typedef unsigned u32x2_t __attribute__((ext_vector_type(2)));
    const unsigned short* H2 = (const unsigned short*)(F.ws + WS_H2);
    const unsigned char* U = F.ws + WS_U; const unsigned char* V = F.ws + WS_V;
    const float* USC = (const float*)(F.ws + WS_USC); const float* VSC = (const float*)(F.ws + WS_VSC);
    const unsigned* ROUTE = (const unsigned*)(F.ws + WS_ROUTE);
    const float* MOD = (const float*)(F.ws + WS_MOD);
    const float* fg = F.in[20];
    LAS float* pp = (LAS float*)F.lds + F.wave * (64 * 65);
    const int lane = F.lane;
#define LOAD8(dst, tab, rr, k0) do { _Pragma("unroll") for (int q = 0; q < GB; ++q) { const unsigned id = (unsigned)__builtin_amdgcn_readlane(rr, (k0) + q) >> 16; dst[q] = ((const u32x2_t*)((tab) + (size_t)id * 512))[lane]; } } while (0)
    for (int tile = F.gw; tile < T / 32; tile += F.NGW) {
    unsigned r0n = ROUTE[(size_t)tile * 32 * 128 + lane], r1n = ROUTE[(size_t)tile * 32 * 128 + 64 + lane];
    for (int t = tile * 32; t < tile * 32 + 32; ++t) {
        const int b = t >> 12;
        const unsigned r0 = r0n, r1 = r1n;
        if (t + 1 < tile * 32 + 32) { r0n = ROUTE[(size_t)(t + 1) * 128 + lane]; r1n = ROUTE[(size_t)(t + 1) * 128 + 64 + lane]; }
        const float su0 = USC[r0 >> 16], su1 = USC[r1 >> 16], sv0 = VSC[r0 >> 16], sv1 = VSC[r1 >> 16];
        float coef0 = 0.f, coef1 = 0.f;
        {
            typedef int v8i_t __attribute__((ext_vector_type(8)));
            f32x2_t hf[8];
            load_h16(H2, (size_t)t, lane, hf);
            float mx = 0.f;
#pragma unroll
            for (int i2 = 0; i2 < 8; ++i2) mx = fmaxf(mx, fmaxf(fabsf(hf[i2].x), fabsf(hf[i2].y)));
            const float sc1 = 6.0f / fmaxf(lane63(scan_max64(mx)), 1e-30f);
            unsigned q1x = 0u, q1y = 0u;
            q1x = __builtin_amdgcn_cvt_scalef32_pk_fp4_f32(q1x, hf[0].x * sc1, hf[0].y * sc1, 1.0f, 0); q1x = __builtin_amdgcn_cvt_scalef32_pk_fp4_f32(q1x, hf[1].x * sc1, hf[1].y * sc1, 1.0f, 1);
            q1x = __builtin_amdgcn_cvt_scalef32_pk_fp4_f32(q1x, hf[2].x * sc1, hf[2].y * sc1, 1.0f, 2); q1x = __builtin_amdgcn_cvt_scalef32_pk_fp4_f32(q1x, hf[3].x * sc1, hf[3].y * sc1, 1.0f, 3);
            q1y = __builtin_amdgcn_cvt_scalef32_pk_fp4_f32(q1y, hf[4].x * sc1, hf[4].y * sc1, 1.0f, 0); q1y = __builtin_amdgcn_cvt_scalef32_pk_fp4_f32(q1y, hf[5].x * sc1, hf[5].y * sc1, 1.0f, 1);
            q1y = __builtin_amdgcn_cvt_scalef32_pk_fp4_f32(q1y, hf[6].x * sc1, hf[6].y * sc1, 1.0f, 2); q1y = __builtin_amdgcn_cvt_scalef32_pk_fp4_f32(q1y, hf[7].x * sc1, hf[7].y * sc1, 1.0f, 3);
            f32x2_t rs[8];
            rs[0] = hf[0] * sc1 - __builtin_amdgcn_cvt_scalef32_pk_f32_fp4(q1x, 1.0f, 0); rs[1] = hf[1] * sc1 - __builtin_amdgcn_cvt_scalef32_pk_f32_fp4(q1x, 1.0f, 1);
            rs[2] = hf[2] * sc1 - __builtin_amdgcn_cvt_scalef32_pk_f32_fp4(q1x, 1.0f, 2); rs[3] = hf[3] * sc1 - __builtin_amdgcn_cvt_scalef32_pk_f32_fp4(q1x, 1.0f, 3);
            rs[4] = hf[4] * sc1 - __builtin_amdgcn_cvt_scalef32_pk_f32_fp4(q1y, 1.0f, 0); rs[5] = hf[5] * sc1 - __builtin_amdgcn_cvt_scalef32_pk_f32_fp4(q1y, 1.0f, 1);
            rs[6] = hf[6] * sc1 - __builtin_amdgcn_cvt_scalef32_pk_f32_fp4(q1y, 1.0f, 2); rs[7] = hf[7] * sc1 - __builtin_amdgcn_cvt_scalef32_pk_f32_fp4(q1y, 1.0f, 3);
            float mr = 0.f;
#pragma unroll
            for (int i2 = 0; i2 < 8; ++i2) mr = fmaxf(mr, fmaxf(fabsf(rs[i2].x), fabsf(rs[i2].y)));
            const float sc2 = 6.0f / fmaxf(lane63(scan_max64(mr)), 1e-30f);
            unsigned q2x = 0u, q2y = 0u;
            q2x = __builtin_amdgcn_cvt_scalef32_pk_fp4_f32(q2x, rs[0].x * sc2, rs[0].y * sc2, 1.0f, 0); q2x = __builtin_amdgcn_cvt_scalef32_pk_fp4_f32(q2x, rs[1].x * sc2, rs[1].y * sc2, 1.0f, 1);
            q2x = __builtin_amdgcn_cvt_scalef32_pk_fp4_f32(q2x, rs[2].x * sc2, rs[2].y * sc2, 1.0f, 2); q2x = __builtin_amdgcn_cvt_scalef32_pk_fp4_f32(q2x, rs[3].x * sc2, rs[3].y * sc2, 1.0f, 3);
            q2y = __builtin_amdgcn_cvt_scalef32_pk_fp4_f32(q2y, rs[4].x * sc2, rs[4].y * sc2, 1.0f, 0); q2y = __builtin_amdgcn_cvt_scalef32_pk_fp4_f32(q2y, rs[5].x * sc2, rs[5].y * sc2, 1.0f, 1);
            q2y = __builtin_amdgcn_cvt_scalef32_pk_fp4_f32(q2y, rs[6].x * sc2, rs[6].y * sc2, 1.0f, 2); q2y = __builtin_amdgcn_cvt_scalef32_pk_fp4_f32(q2y, rs[7].x * sc2, rs[7].y * sc2, 1.0f, 3);
            LAS unsigned char* wl = (LAS unsigned char*)pp;
            *(LAS u32x2_t*)(wl + 8 * lane) = (u32x2_t){q1x, q1y}; *(LAS u32x2_t*)(wl + 512 + 8 * lane) = (u32x2_t){q2x, q2y};
            LDS_WAIT(); asm volatile("" ::: "memory");
            const int g = lane >> 4;
            v8i_t B1[8], B2[8];
#pragma unroll
            for (int s2 = 0; s2 < 8; ++s2) { const v4u b1 = *(const LAS v4u*)(wl + 64 * s2 + 16 * g), b2 = *(const LAS v4u*)(wl + 512 + 64 * s2 + 16 * g);
                B1[s2] = (v8i_t){(int)b1.x, (int)b1.y, (int)b1.z, (int)b1.w, 0, 0, 0, 0}; B2[s2] = (v8i_t){(int)b2.x, (int)b2.y, (int)b2.z, (int)b2.w, 0, 0, 0, 0}; }
            const float inv1 = 1.0f / sc1, inv12 = inv1 / sc2;
            LAS float* ttl = (LAS float*)(wl + 1024);
            v4u A0[8], A1[8];
#define LOADG(dst, eg) do { const unsigned idv = (unsigned)__shfl((int)((eg) < 4 ? r0 : r1), 16 * ((eg) & 3) + (lane & 15)) >> 16; const unsigned char* p_ = U + (size_t)idv * 512 + 16 * g; \
                _Pragma("unroll") for (int s2 = 0; s2 < 8; ++s2) dst[s2] = *(const v4u*)(p_ + 64 * s2); } while (0)
#define SCOREG(src, eg) do { f32x4 c1 = {0.f, 0.f, 0.f, 0.f}, c2 = {0.f, 0.f, 0.f, 0.f}; \
                _Pragma("unroll") for (int s2 = 0; s2 < 8; ++s2) { const v8i_t a8 = (v8i_t){(int)src[s2].x, (int)src[s2].y, (int)src[s2].z, (int)src[s2].w, 0, 0, 0, 0}; \
                    c1 = __builtin_amdgcn_mfma_scale_f32_16x16x128_f8f6f4(a8, B1[s2], c1, 4, 4, 0, 0, 0, 0); c2 = __builtin_amdgcn_mfma_scale_f32_16x16x128_f8f6f4(a8, B2[s2], c2, 4, 4, 0, 0, 0, 0); } \
                if ((lane & 15) == 0) { *(LAS f32x4*)(ttl + 16 * (eg) + 4 * g) = c1 * inv1 + c2 * inv12; } } while (0)
            LOADG(A0, 0);
#pragma unroll
            for (int eg = 0; eg < 8; eg += 2) {
                LOADG(A1, eg + 1);
                SCOREG(A0, eg);
                if (eg + 2 < 8) LOADG(A0, eg + 2);
                SCOREG(A1, eg + 1);
            }
#undef LOADG
#undef SCOREG
            LDS_WAIT(); asm volatile("" ::: "memory");
            const float tot0 = ttl[lane], tot1 = ttl[64 + lane];
            LDS_WAIT(); asm volatile("" ::: "memory");
            coef0 = bflo(r0) * gelu_tanh(tot0 * su0) * sv0;
            coef1 = bflo(r1) * gelu_tanh(tot1 * su1) * sv1;
        }
        f32x2_t o[8];
#pragma unroll
        for (int i = 0; i < 8; ++i) o[i] = (f32x2_t){0.f, 0.f};
#define VACC8(src, cfv, k0) do { _Pragma("unroll") for (int q = 0; q < GB; ++q) { \
            const float c = __uint_as_float(__builtin_amdgcn_readlane(__float_as_uint(cfv), (k0) + q)); axpy16_fp4(src[q].x, src[q].y, c, o); } } while (0)
#pragma unroll
        for (int half = 0; half < 2; ++half) {
            const unsigned rr = half ? r1 : r0; const float cfv = half ? coef1 : coef0;
            u32x2_t ra[GB], rb[GB];
            LOAD8(ra, V, rr, 0);
            for (int kb = 0; kb < 64; kb += 2 * GB) {
                LOAD8(rb, V, rr, kb + GB);
                VACC8(ra, cfv, kb);
                if (kb + 2 * GB < 64) LOAD8(ra, V, rr, kb + 2 * GB);
                VACC8(rb, cfv, kb + GB);
            }
        }
#undef VACC8
        float* xrow = F.out + (size_t)t * 1024 + 16 * lane;
        const float* gt2 = MOD + b * 6144 + 5120 + 16 * lane;
        const v4u xa = ((const v4u*)((const unsigned short*)(F.ws + WS_X1) + (size_t)t * 1024))[2 * lane], xb = ((const v4u*)((const unsigned short*)(F.ws + WS_X1) + (size_t)t * 1024))[2 * lane + 1];
        const f32x4 xin4[4] = {(f32x4){bflo(xa.x), bfhi(xa.x), bflo(xa.y), bfhi(xa.y)}, (f32x4){bflo(xa.z), bfhi(xa.z), bflo(xa.w), bfhi(xa.w)}, (f32x4){bflo(xb.x), bfhi(xb.x), bflo(xb.y), bfhi(xb.y)}, (f32x4){bflo(xb.z), bfhi(xb.z), bflo(xb.w), bfhi(xb.w)}};
        f32x4 x2[4]; float ss = 0.f;
#pragma unroll
        for (int c4 = 0; c4 < 4; ++c4) { const f32x4 xv = xin4[c4], gv = ((const f32x4*)gt2)[c4];
            f32x4 ov; ov.x = o[2 * c4].x; ov.y = o[2 * c4].y; ov.z = o[2 * c4 + 1].x; ov.w = o[2 * c4 + 1].y;
            x2[c4] = xv + gv * ov; ss += (x2[c4].x * x2[c4].x + x2[c4].y * x2[c4].y) + (x2[c4].z * x2[c4].z + x2[c4].w * x2[c4].w); }
        const float rstd = rsqrtf(wave_sum_u(ss) * (1.0f / 1024.0f) + EPS);
#pragma unroll
        for (int c4 = 0; c4 < 4; ++c4) { const f32x4 gv = ((const f32x4*)(fg + 16 * lane))[c4]; ((f32x4*)xrow)[c4] = x2[c4] * rstd * gv; }
    }
    }
#undef LOAD8
}


__device__ __forceinline__ void peer_gather_pipe(Frame& F) {
    typedef unsigned u32x2_t __attribute__((ext_vector_type(2)));
    typedef int v8i_t __attribute__((ext_vector_type(8)));
    const unsigned short* H2 = (const unsigned short*)(F.ws + WS_H2);
    const unsigned char* U = F.ws + WS_U; const unsigned char* V = F.ws + WS_V;
    const float* USC = (const float*)(F.ws + WS_USC); const float* VSC = (const float*)(F.ws + WS_VSC);
    const unsigned* ROUTE = (const unsigned*)(F.ws + WS_ROUTE);
    const float* MOD = (const float*)(F.ws + WS_MOD);
    const float* fg = F.in[20];
    LAS unsigned char* wl = (LAS unsigned char*)F.lds + F.wave * 2048;
    LAS float* ttl = (LAS float*)(wl + 1024);
    const int lane = F.lane, g = lane >> 4;
    v8i_t B1[8], B2[8]; float inv1 = 0.f, inv12 = 0.f;
    auto prep = [&](const v4u ha, const v4u hb) {
        f32x2_t hf[8];
        hf[0] = (f32x2_t){bflo(ha.x), bfhi(ha.x)}; hf[1] = (f32x2_t){bflo(ha.y), bfhi(ha.y)}; hf[2] = (f32x2_t){bflo(ha.z), bfhi(ha.z)}; hf[3] = (f32x2_t){bflo(ha.w), bfhi(ha.w)};
        hf[4] = (f32x2_t){bflo(hb.x), bfhi(hb.x)}; hf[5] = (f32x2_t){bflo(hb.y), bfhi(hb.y)}; hf[6] = (f32x2_t){bflo(hb.z), bfhi(hb.z)}; hf[7] = (f32x2_t){bflo(hb.w), bfhi(hb.w)};
        float mx = 0.f;
#pragma unroll
        for (int i2 = 0; i2 < 8; ++i2) mx = fmaxf(mx, fmaxf(fabsf(hf[i2].x), fabsf(hf[i2].y)));
        const float sc1 = 6.0f / fmaxf(lane63(scan_max64(mx)), 1e-30f);
        unsigned q1x = 0u, q1y = 0u;
        q1x = __builtin_amdgcn_cvt_scalef32_pk_fp4_f32(q1x, hf[0].x * sc1, hf[0].y * sc1, 1.0f, 0); q1x = __builtin_amdgcn_cvt_scalef32_pk_fp4_f32(q1x, hf[1].x * sc1, hf[1].y * sc1, 1.0f, 1);
        q1x = __builtin_amdgcn_cvt_scalef32_pk_fp4_f32(q1x, hf[2].x * sc1, hf[2].y * sc1, 1.0f, 2); q1x = __builtin_amdgcn_cvt_scalef32_pk_fp4_f32(q1x, hf[3].x * sc1, hf[3].y * sc1, 1.0f, 3);
        q1y = __builtin_amdgcn_cvt_scalef32_pk_fp4_f32(q1y, hf[4].x * sc1, hf[4].y * sc1, 1.0f, 0); q1y = __builtin_amdgcn_cvt_scalef32_pk_fp4_f32(q1y, hf[5].x * sc1, hf[5].y * sc1, 1.0f, 1);
        q1y = __builtin_amdgcn_cvt_scalef32_pk_fp4_f32(q1y, hf[6].x * sc1, hf[6].y * sc1, 1.0f, 2); q1y = __builtin_amdgcn_cvt_scalef32_pk_fp4_f32(q1y, hf[7].x * sc1, hf[7].y * sc1, 1.0f, 3);
        f32x2_t rs[8];
        rs[0] = hf[0] * sc1 - __builtin_amdgcn_cvt_scalef32_pk_f32_fp4(q1x, 1.0f, 0); rs[1] = hf[1] * sc1 - __builtin_amdgcn_cvt_scalef32_pk_f32_fp4(q1x, 1.0f, 1);
        rs[2] = hf[2] * sc1 - __builtin_amdgcn_cvt_scalef32_pk_f32_fp4(q1x, 1.0f, 2); rs[3] = hf[3] * sc1 - __builtin_amdgcn_cvt_scalef32_pk_f32_fp4(q1x, 1.0f, 3);
        rs[4] = hf[4] * sc1 - __builtin_amdgcn_cvt_scalef32_pk_f32_fp4(q1y, 1.0f, 0); rs[5] = hf[5] * sc1 - __builtin_amdgcn_cvt_scalef32_pk_f32_fp4(q1y, 1.0f, 1);
        rs[6] = hf[6] * sc1 - __builtin_amdgcn_cvt_scalef32_pk_f32_fp4(q1y, 1.0f, 2); rs[7] = hf[7] * sc1 - __builtin_amdgcn_cvt_scalef32_pk_f32_fp4(q1y, 1.0f, 3);
        float mr = 0.f;
#pragma unroll
        for (int i2 = 0; i2 < 8; ++i2) mr = fmaxf(mr, fmaxf(fabsf(rs[i2].x), fabsf(rs[i2].y)));
        const float sc2 = 6.0f / fmaxf(lane63(scan_max64(mr)), 1e-30f);
        unsigned q2x = 0u, q2y = 0u;
        q2x = __builtin_amdgcn_cvt_scalef32_pk_fp4_f32(q2x, rs[0].x * sc2, rs[0].y * sc2, 1.0f, 0); q2x = __builtin_amdgcn_cvt_scalef32_pk_fp4_f32(q2x, rs[1].x * sc2, rs[1].y * sc2, 1.0f, 1);
        q2x = __builtin_amdgcn_cvt_scalef32_pk_fp4_f32(q2x, rs[2].x * sc2, rs[2].y * sc2, 1.0f, 2); q2x = __builtin_amdgcn_cvt_scalef32_pk_fp4_f32(q2x, rs[3].x * sc2, rs[3].y * sc2, 1.0f, 3);
        q2y = __builtin_amdgcn_cvt_scalef32_pk_fp4_f32(q2y, rs[4].x * sc2, rs[4].y * sc2, 1.0f, 0); q2y = __builtin_amdgcn_cvt_scalef32_pk_fp4_f32(q2y, rs[5].x * sc2, rs[5].y * sc2, 1.0f, 1);
        q2y = __builtin_amdgcn_cvt_scalef32_pk_fp4_f32(q2y, rs[6].x * sc2, rs[6].y * sc2, 1.0f, 2); q2y = __builtin_amdgcn_cvt_scalef32_pk_fp4_f32(q2y, rs[7].x * sc2, rs[7].y * sc2, 1.0f, 3);
        *(LAS u32x2_t*)(wl + 8 * lane) = (u32x2_t){q1x, q1y}; *(LAS u32x2_t*)(wl + 512 + 8 * lane) = (u32x2_t){q2x, q2y};
        LDS_WAIT(); asm volatile("" ::: "memory");
#pragma unroll
        for (int s2 = 0; s2 < 8; ++s2) { const v4u b1 = *(const LAS v4u*)(wl + 64 * s2 + 16 * g), b2 = *(const LAS v4u*)(wl + 512 + 64 * s2 + 16 * g);
            B1[s2] = (v8i_t){(int)b1.x, (int)b1.y, (int)b1.z, (int)b1.w, 0, 0, 0, 0}; B2[s2] = (v8i_t){(int)b2.x, (int)b2.y, (int)b2.z, (int)b2.w, 0, 0, 0, 0}; }
        LDS_WAIT(); asm volatile("" ::: "memory");
        inv1 = 1.0f / sc1; inv12 = inv1 / sc2;
    };
#define PLOADG(dst, ra_, rb_, eg) do { const unsigned idv = (unsigned)__shfl((int)((eg) < 4 ? ra_ : rb_), 16 * ((eg) & 3) + (lane & 15)) >> 16; const unsigned char* p_ = U + (size_t)idv * 512 + 16 * g; \
        _Pragma("unroll") for (int s2 = 0; s2 < 8; ++s2) dst[s2] = *(const v4u*)(p_ + 64 * s2); } while (0)
#define PSCOREG(src, eg) do { f32x4 c1 = {0.f, 0.f, 0.f, 0.f}, c2 = {0.f, 0.f, 0.f, 0.f}; \
        _Pragma("unroll") for (int s2 = 0; s2 < 8; ++s2) { const v8i_t a8 = (v8i_t){(int)src[s2].x, (int)src[s2].y, (int)src[s2].z, (int)src[s2].w, 0, 0, 0, 0}; \
            c1 = __builtin_amdgcn_mfma_scale_f32_16x16x128_f8f6f4(a8, B1[s2], c1, 4, 4, 0, 0, 0, 0); c2 = __builtin_amdgcn_mfma_scale_f32_16x16x128_f8f6f4(a8, B2[s2], c2, 4, 4, 0, 0, 0, 0); } \
        if ((lane & 15) == 0) { *(LAS f32x4*)(ttl + 16 * (eg) + 4 * g) = c1 * inv1 + c2 * inv12; } } while (0)
#define PLOADV(dst, rr, k0) do { _Pragma("unroll") for (int q = 0; q < 8; ++q) { const unsigned id = (unsigned)__builtin_amdgcn_readlane(rr, (k0) + q) >> 16; dst[q] = ((const u32x2_t*)(V + (size_t)id * 512))[lane]; } } while (0)
#define PVACC(src, cfv, k0) do { _Pragma("unroll") for (int q = 0; q < 8; ++q) { const float c = __uint_as_float(__builtin_amdgcn_readlane(__float_as_uint(cfv), (k0) + q)); axpy16_fp4(src[q].x, src[q].y, c, o); } } while (0)
    for (int tile = F.gw; tile < T / 32; tile += F.NGW) {
        const int t0 = tile * 32, t1 = t0 + 32;
        unsigned r0c = ROUTE[(size_t)t0 * 128 + lane], r1c = ROUTE[(size_t)t0 * 128 + 64 + lane];
        unsigned r0n = ROUTE[(size_t)(t0 + 1) * 128 + lane], r1n = ROUTE[(size_t)(t0 + 1) * 128 + 64 + lane];
        v4u han = ((const v4u*)(H2 + (size_t)(t0 + 1) * 1024))[2 * lane], hbn = ((const v4u*)(H2 + (size_t)(t0 + 1) * 1024))[2 * lane + 1];
        float coef0c, coef1c;
        {
            const v4u ha = ((const v4u*)(H2 + (size_t)t0 * 1024))[2 * lane], hb = ((const v4u*)(H2 + (size_t)t0 * 1024))[2 * lane + 1];
            const float su0 = USC[r0c >> 16], su1 = USC[r1c >> 16], sv0 = VSC[r0c >> 16], sv1 = VSC[r1c >> 16];
            prep(ha, hb);
            v4u A0[8], A1[8];
            PLOADG(A0, r0c, r1c, 0);
#pragma unroll
            for (int eg = 0; eg < 8; eg += 2) { PLOADG(A1, r0c, r1c, eg + 1); PSCOREG(A0, eg); if (eg + 2 < 8) PLOADG(A0, r0c, r1c, eg + 2); PSCOREG(A1, eg + 1); }
            LDS_WAIT(); asm volatile("" ::: "memory");
            const float tot0 = ttl[lane], tot1 = ttl[64 + lane];
            LDS_WAIT(); asm volatile("" ::: "memory");
            coef0c = bflo(r0c) * gelu_tanh(tot0 * su0) * sv0; coef1c = bflo(r1c) * gelu_tanh(tot1 * su1) * sv1;
        }
        for (int t = t0; t < t1; ++t) {
            const int b = t >> 12;
            const int t2 = (t + 2 < t1) ? t + 2 : t1 - 1;
            const unsigned r0nn = ROUTE[(size_t)t2 * 128 + lane], r1nn = ROUTE[(size_t)t2 * 128 + 64 + lane];
            const v4u hann = ((const v4u*)(H2 + (size_t)t2 * 1024))[2 * lane], hbnn = ((const v4u*)(H2 + (size_t)t2 * 1024))[2 * lane + 1];
            const float su0 = USC[r0n >> 16], su1 = USC[r1n >> 16], sv0 = VSC[r0n >> 16], sv1 = VSC[r1n >> 16];
            const bool has_next = (t + 1 < t1);
            v4u A0[8];
            if (has_next) { prep(han, hbn);
                PLOADG(A0, r0n, r1n, 0); }
            f32x2_t o[8];
#pragma unroll
            for (int i2 = 0; i2 < 8; ++i2) o[i2] = (f32x2_t){0.f, 0.f};
            u32x2_t va[8], vb[8];
            PLOADV(va, r0c, 0);
#pragma unroll 1
            for (int kk = 0; kk < 4; ++kk) {
                const unsigned rr = (kk < 2) ? r0c : r1c, rr2 = (kk + 1 < 2) ? r0c : r1c; const float cfv = (kk < 2) ? coef0c : coef1c; const int kb = 32 * (kk & 1);
                PLOADV(vb, rr, kb + 8);
                PVACC(va, cfv, kb);
                PLOADV(va, rr, kb + 16);
                if (has_next) { PSCOREG(A0, 2 * kk);
                    PLOADG(A0, r0n, r1n, 2 * kk + 1); }
                PVACC(vb, cfv, kb + 8);
                PLOADV(vb, rr, kb + 24);
                PVACC(va, cfv, kb + 16);
                if (kk < 3) PLOADV(va, rr2, (kb + 32) & 63);
                if (has_next) { PSCOREG(A0, 2 * kk + 1);
                    if (kk < 3) PLOADG(A0, r0n, r1n, 2 * kk + 2); }
                PVACC(vb, cfv, kb + 24);
            }
            float coef0n, coef1n;
            {
                LDS_WAIT(); asm volatile("" ::: "memory");
                const float tot0 = ttl[lane], tot1 = ttl[64 + lane];
                LDS_WAIT(); asm volatile("" ::: "memory");
                coef0n = bflo(r0n) * gelu_tanh(tot0 * su0) * sv0; coef1n = bflo(r1n) * gelu_tanh(tot1 * su1) * sv1;
            }
            float* xrow = F.out + (size_t)t * 1024 + 16 * lane;
            const float* gt2 = MOD + b * 6144 + 5120 + 16 * lane;
            const v4u xa = ((const v4u*)((const unsigned short*)(F.ws + WS_X1) + (size_t)t * 1024))[2 * lane], xb = ((const v4u*)((const unsigned short*)(F.ws + WS_X1) + (size_t)t * 1024))[2 * lane + 1];
            const f32x4 xin4[4] = {(f32x4){bflo(xa.x), bfhi(xa.x), bflo(xa.y), bfhi(xa.y)}, (f32x4){bflo(xa.z), bfhi(xa.z), bflo(xa.w), bfhi(xa.w)}, (f32x4){bflo(xb.x), bfhi(xb.x), bflo(xb.y), bfhi(xb.y)}, (f32x4){bflo(xb.z), bfhi(xb.z), bflo(xb.w), bfhi(xb.w)}};
            f32x4 x2[4]; float ss = 0.f;
#pragma unroll
            for (int c4 = 0; c4 < 4; ++c4) { const f32x4 xv = xin4[c4], gv = ((const f32x4*)gt2)[c4];
                f32x4 ov; ov.x = o[2 * c4].x; ov.y = o[2 * c4].y; ov.z = o[2 * c4 + 1].x; ov.w = o[2 * c4 + 1].y;
                x2[c4] = xv + gv * ov; ss += (x2[c4].x * x2[c4].x + x2[c4].y * x2[c4].y) + (x2[c4].z * x2[c4].z + x2[c4].w * x2[c4].w); }
            const float rstd = rsqrtf(wave_sum_u(ss) * (1.0f / 1024.0f) + EPS);
#pragma unroll
            for (int c4 = 0; c4 < 4; ++c4) { const f32x4 gv = ((const f32x4*)(fg + 16 * lane))[c4]; ((f32x4*)xrow)[c4] = x2[c4] * rstd * gv; }
            r0c = r0n; r1c = r1n; r0n = r0nn; r1n = r1nn; han = hann; hbn = hbnn; coef0c = coef0n; coef1c = coef1n;
        }
    }
#undef PLOADG
#undef PSCOREG
#undef PLOADV
#undef PVACC
}

constexpr int N_PHASES = 12;
#ifndef PEER_FP8
#define PEER_FP8 1
#endif
#ifndef USE_ROUTE_REF
#define USE_ROUTE_REF 0
#endif
#ifndef USE_MLSTM_REF
#define USE_MLSTM_REF 0
#endif
#ifndef USE_ATTN_REF
#define USE_ATTN_REF 0
#endif
#ifndef MK_ONE_LAUNCH
#define MK_ONE_LAUNCH 0
#endif
__global__ void __launch_bounds__(NWAVES * 64, 2) fwd_kernel(Args args) {
    extern __shared__ __attribute__((aligned(16))) unsigned char lds[];
    Frame F;
    F.lds = lds; F.tid = threadIdx.x; F.lane = F.tid & 63; F.wave = __builtin_amdgcn_readfirstlane(F.tid >> 6);
    F.G = gridDim.x; F.gw = blockIdx.x * NWAVES + F.wave; F.NGW = F.G * NWAVES;
#pragma unroll
    for (int i = 0; i < 21; ++i) F.in[i] = args.in[i];
    F.out = args.out; F.ws = args.ws;
    LAS unsigned char* ldsl = (LAS unsigned char*)lds;
    volatile LAS unsigned* MISC = (volatile LAS unsigned*)(ldsl + MISC_OFF);
    for (int u = F.tid; u < (LDS_BYTES - MISC_OFF) / 4; u += NWAVES * 64) ((LAS unsigned*)(ldsl + MISC_OFF))[u] = 0u;
    __syncthreads();
    unsigned* ctl = (unsigned*)(F.ws + WS_CTL);
    XcdBarrier bar; bar.bar = ctl + CW_BAR; bar.x = 0; bar.st = nullptr;
    const bool one = (args.ph_hi - args.ph_lo) > 1;
    if (one) bar = xcd_barrier_post(ctl + CW_BAR, MISC + 8);
    const int lo = args.ph_lo, hi = args.ph_hi;
#define IN(k) (lo <= (k) && (k) < hi)
#ifdef DBG_TIME
    unsigned long long dbg_t0 = __builtin_amdgcn_s_memrealtime(), dbg_t1 = 0;
#define SEAM(k) do { if (IN(k) && IN((k) + 1)) xcd_barrier(bar); if ((k) + 1 == DBG_TIME) dbg_t0 = __builtin_amdgcn_s_memrealtime(); if ((k) == DBG_TIME) dbg_t1 = __builtin_amdgcn_s_memrealtime(); } while (0)
#else
#define SEAM(k) do { if (IN(k) && IN((k) + 1)) xcd_barrier(bar); } while (0)
#endif
    if (IN(0)) { p0_prologue(F); } SEAM(0);
    if (IN(1)) { norm_mod_rows<true>(F, F.in[0], F.in[4], 0, 1024, (unsigned short*)(F.ws + WS_H1)); } SEAM(1);
#if PROJ_ALL_FP8
    if (IN(2)) { pg8::Gemm g{(const pg8::bf16_t*)(F.ws + WS_H1Q), (const pg8::bf16_t*)(F.ws + WS_WINQ), T, NPROJ_ALL, 512};
        pg8::StaticOrder S; S.init(T, NPROJ_ALL, F.G, (int)blockIdx.x);
        Epi<EPI_ROUTE> E{F.ws, F.in[0], F.out, 2}; pg8::gemm_phase<Epi<EPI_ROUTE>, pg8::StaticOrder, true, true, true>(ldsl, g, S, E); } SEAM(2);
#else
    if (IN(2)) {
        { pg8::Gemm g{(const pg8::bf16_t*)(F.ws + WS_H1), (const pg8::bf16_t*)(F.ws + WS_WIN), T, NPROJ_B, 1024}; pg8::StaticOrder S; S.init(T, NPROJ_B, F.G, (int)blockIdx.x);
          Epi<EPI_ROUTE> E{F.ws, F.in[0], F.out, 0}; pg8::gemm_phase<Epi<EPI_ROUTE>, pg8::StaticOrder, true, true>(ldsl, g, S, E); }
        { pg8::Gemm g{(const pg8::bf16_t*)(F.ws + WS_H1Q), (const pg8::bf16_t*)(F.ws + WS_WINQ), T, NPROJ_Q, 512};
          pg8::StaticOrder S; S.init(T, NPROJ_Q, F.G, (int)blockIdx.x);
          Epi<EPI_ROUTE> E{F.ws, F.in[0], F.out, 1}; pg8::gemm_phase<Epi<EPI_ROUTE>, pg8::StaticOrder, true, true, true>(ldsl, g, S, E); }
    } SEAM(2);
#endif
    if (IN(3)) { qk_conv_pass(F); } SEAM(3);
    if (IN(4)) {
#if USE_MLSTM_REF
        if (blockIdx.x < 64) mlstm_ref_unit(F, blockIdx.x >> 2, blockIdx.x & 3);
#else
#ifndef DBG_SKIP_MLSTM
        if (blockIdx.x < 64) mlstm_unit(F, blockIdx.x >> 2, blockIdx.x & 3);
#else
        if (0) {}
#endif
#endif
        else {
#if USE_ATTN_REF
            const int nw = (F.G - 64) * NWAVES, w0 = (blockIdx.x - 64) * NWAVES + F.wave; for (int it = w0; it < T * 8; it += nw) attn_ref_item(F, it >> 3, it & 7);
#else
#ifndef DBG_SKIP_ATTN
            for (int u = blockIdx.x - 64; u < 2048; u += F.G - 64) { attn_unit(F, u >> 7, (u >> 4) & 7, 4 * (u & 15)); }
#endif
            late_weight_copies(F, (blockIdx.x - 64) * NWAVES + F.wave, (F.G - 64) * NWAVES);
#endif
        }
    } SEAM(4);
    if (IN(5)) { pg8::Gemm g{(const pg8::bf16_t*)(F.ws + WS_YA), (const pg8::bf16_t*)(F.ws + WS_WA), T, 1024, 512, (const pg8::bf16_t*)(F.ws + WS_YB), (const pg8::bf16_t*)(F.ws + WS_WB)};
        pg8::TwoPassOrder S; S.init(T, 1024, F.G, (int)blockIdx.x);
        Epi<EPI_MERGE> E{F.ws, F.in[0], F.out}; pg8::gemm_phase<Epi<EPI_MERGE>, pg8::TwoPassOrder, true, true>(ldsl, g, S, E); }
    SEAM(6);
    if (IN(7)) { pg8::Gemm g{(const pg8::bf16_t*)(F.ws + WS_Y), (const pg8::bf16_t*)(F.ws + WS_WOUT), T, 1024, 1024}; pg8::StaticOrder S; S.init(T, 1024, F.G, (int)blockIdx.x);
        Epi<EPI_OUTPROJ> E{F.ws, F.in[0], F.out}; pg8::gemm_phase<Epi<EPI_OUTPROJ>, pg8::StaticOrder, true, true>(ldsl, g, S, E); } SEAM(7);
    if (IN(8)) { norm_mod_rows<false, true>(F, (const float*)(F.ws + WS_X1), F.in[15], 3072, 4096, (unsigned short*)(F.ws + WS_H2)); } SEAM(8);
    if (IN(9)) { pg8::Gemm g{(const pg8::bf16_t*)(F.ws + WS_H2), (const pg8::bf16_t*)(F.ws + WS_WPQ), T, 2048, 1024}; pg8::StaticOrder S; S.init(T, 2048, F.G, (int)blockIdx.x);
        Epi<EPI_PQ> E{F.ws, F.in[0], F.out}; pg8::gemm_phase<Epi<EPI_PQ>, pg8::StaticOrder, true, true>(ldsl, g, S, E); } SEAM(9);
#if USE_ROUTE_REF
    if (IN(10)) { peer_route_ref(F); } SEAM(10);
#else
    if (IN(10)) { peer_route_mfma(F); asm volatile("s_waitcnt vmcnt(0)" ::: "memory"); __syncthreads(); }
#endif
#if PEER_FP4 && PEER_PIPE
    if (IN(11)) { peer_gather_pipe(F); }
#elif PEER_FP4
    if (IN(11)) { peer_gather_fp4(F); }
#elif PEER_FP8 && PEER_SWEEP
    if (IN(11)) { peer_gather_sweep(F); }
#elif PEER_FP8
    if (IN(11)) { peer_gather_fp8(F); }
#else
    if (IN(11)) { peer_gather(F); }
#endif
#ifdef DBG_TIME
    if (DBG_TIME == 11 || DBG_TIME == 99) dbg_t1 = __builtin_amdgcn_s_memrealtime();
    __syncthreads();
    if (blockIdx.x == 0 && F.tid == 0) { asm volatile("s_waitcnt vmcnt(0)" ::: "memory"); F.out[0] = (float)((dbg_t1 - dbg_t0) / DBG_TQ) * (float)(DBG_TQ / 1000); }
#endif
#ifdef DBG_DUMP
    if (hi < N_PHASES) { xcd_barrier(bar);
        for (int t = F.gw; t < T; t += F.NGW) { float* o = F.out + (size_t)t * 1024;
            for (int c = F.lane; c < 1024; c += 64) { float v = 0.f;
                if (DBG_DUMP == 8) v = bf2f(((const unsigned short*)(F.ws + WS_H2))[(size_t)t * 1024 + c]);
                if (DBG_DUMP == 9) v = bf2f(((const unsigned short*)(F.ws + WS_PQ))[(size_t)t * 2048 + c]) + 3.0f * bf2f(((const unsigned short*)(F.ws + WS_PQ))[(size_t)t * 2048 + 1024 + c]);
                if (DBG_DUMP == 10) v = (float)(((const unsigned*)(F.ws + WS_ROUTE))[(size_t)t * 128 + (c & 127)] >> ((c & 128) ? 16 : 0) & 0xffff) * (1.0f / 4096.0f);
                o[c] = v; } } }
#endif
#undef IN
#undef SEAM
}

extern "C" void kernel_launch(void* const* d_in, const int* in_sizes, int n_in, void* d_out, int out_size, void* d_ws, size_t ws_size, hipStream_t stream) {
    static int grid = 0;
    if (grid == 0) {
        if (n_in != 21 || out_size != T * DM || ws_size < WS_END) { fprintf(stderr, "kernel_launch: unexpected shapes (n_in %d, out %d, ws %zu); nothing launched\n", n_in, out_size, ws_size); grid = -1; return; }
        int dev = 0, cus = 0;
        if (hipGetDevice(&dev) != hipSuccess || hipDeviceGetAttribute(&cus, hipDeviceAttributeMultiprocessorCount, dev) != hipSuccess) { grid = -1; return; }
        if (hipFuncSetAttribute((const void*)fwd_kernel, hipFuncAttributeMaxDynamicSharedMemorySize, LDS_BYTES) != hipSuccess) { fprintf(stderr, "kernel_launch: hipFuncSetAttribute failed\n"); grid = -1; return; }
        int per_cu = 0;
        if (hipOccupancyMaxActiveBlocksPerMultiprocessor(&per_cu, (const void*)fwd_kernel, NWAVES * 64, LDS_BYTES) != hipSuccess || per_cu < 1) fprintf(stderr, "kernel_launch: occupancy query reports %d\n", per_cu);
        (void)hipGetLastError();
        grid = cus < 256 ? cus : 256;
    }
    if (grid < 0) return;
    (void)hipMemsetAsync((char*)d_ws + WS_CTL, 0, CTL_ZERO_BYTES, stream);
    Args a{};
    for (int i = 0; i < 21; ++i) a.in[i] = (const float*)d_in[i];
    a.out = (float*)d_out; a.ws = (unsigned char*)d_ws;
#if MK_ONE_LAUNCH
#ifndef DBG_STOP
#define DBG_STOP N_PHASES
#endif
    a.ph_lo = 0; a.ph_hi = DBG_STOP; a.li = 0;
    hipLaunchKernelGGL(fwd_kernel, dim3(grid), dim3(NWAVES * 64), LDS_BYTES, stream, a);
#else
    for (int li = 0; li < N_PHASES; ++li) { a.ph_lo = li; a.ph_hi = li + 1; a.li = li; hipLaunchKernelGGL(fwd_kernel, dim3(grid), dim3(NWAVES * 64), LDS_BYTES, stream, a); }
#endif
}
```
